# Optimizing an MI355X kernel written in HIP

```python
import math, functools
import jax, jax.numpy as jnp
from jax import lax
import numpy as np

D_MODEL = 1024
BATCH = 8
SEQ = 8192
DEPTH = 2

GRID_W = 64
CTX_LEN = 256
CHUNK = 64
CONV_W = 5
EPS = 1e-6
MIN_LOWER = 1e-30

SSD_HEADS = 8
SSD_HEAD_DIM = 64
SSD_WIDTH = SSD_HEADS * SSD_HEAD_DIM
SSD_GROUPS = 2
SSD_STATE = 128
SSD_CONV_DIM = SSD_WIDTH + 2 * SSD_GROUPS * SSD_STATE

HGRN_HEADS = 4
HGRN_KEY_DIM = 64
HGRN_HEAD_DIM = 64
HGRN_KEY_WIDTH = HGRN_HEADS * HGRN_KEY_DIM
HGRN_WIDTH = HGRN_HEADS * HGRN_HEAD_DIM

GDN_HEADS = 4
GDN_KEY_DIM = 64
GDN_HEAD_DIM = 64
GDN_KEY_WIDTH = GDN_HEADS * GDN_KEY_DIM
GDN_WIDTH = GDN_HEADS * GDN_HEAD_DIM
GDN_CONV_DIM = 2 * GDN_KEY_WIDTH + GDN_WIDTH

MIX_WIDTH = SSD_WIDTH + HGRN_WIDTH + GDN_WIDTH
SSD_IN = SSD_WIDTH + SSD_CONV_DIM + 2 * SSD_HEADS
HGRN_IN = 3 * HGRN_KEY_WIDTH + 2 * HGRN_WIDTH
GDN_IN = GDN_CONV_DIM + 4 * GDN_HEADS + GDN_WIDTH
IN_COLS = SSD_IN + HGRN_IN + GDN_IN

N_EXPERTS = 64
TOP_K = 8
EXPERT_DIM = 256
SHARED_DIM = 256
ROUTED_SCALE = 2.5
EXPERT_BLOCK = 128

kernel_name = 'hybrid_ssd_hgrn2_gdn_moe_diffusion_prefix'


def _split(u, sizes):
    return jnp.split(u, [int(s) for s in np.cumsum(sizes)[:-1]], axis=-1)


def _masked_exp(diff, mask):
    return jnp.where(mask, jnp.exp(jnp.where(mask, diff, 0.0)), 0.0)


def _rmsnorm(x, w):
    x32 = x.astype(jnp.float32)
    y = x32 * lax.rsqrt(jnp.mean(x32 * x32, axis=-1, keepdims=True) + EPS)
    return (y * w.astype(jnp.float32)).astype(x.dtype)


def _group_rms(t, group, w):
    shp = t.shape
    tg = t.reshape(*shp[:-1], shp[-1] // group, group)
    tg = tg * lax.rsqrt(jnp.mean(tg * tg, axis=-1, keepdims=True) + EPS) * w
    return tg.reshape(shp)


def _l2norm(t):
    return t * lax.rsqrt(jnp.sum(t * t, axis=-1, keepdims=True) + 1e-6)


def _dwconv(u, w):
    half = CONV_W // 2
    n = u.shape[-2]
    up = jnp.pad(u, [(0, 0)] * (u.ndim - 2) + [(half, half), (0, 0)])
    return sum(up[..., j:j + n, :] * w[j] for j in range(CONV_W))


def _grid_conv(u, w, rows):
    bsz, n, ch = u.shape
    return _dwconv(u.reshape(bsz, rows, GRID_W, ch), w).reshape(bsz, n, ch)


def _two_way(scan_fn, ctx_fwd, ctx_bwd, lat_fwd, lat_bwd, state0):
    rev = lambda args: tuple(jnp.flip(a, axis=1) for a in args)
    yc_f, sc_f = scan_fn(*ctx_fwd, state0)
    yc_b, sc_b = scan_fn(*rev(ctx_bwd), state0)
    yl_f, _ = scan_fn(*lat_fwd, sc_f)
    yl_b, _ = scan_fn(*rev(lat_bwd), sc_b)
    return yc_f + jnp.flip(yc_b, axis=1), yl_f + jnp.flip(yl_b, axis=1)


def _ssd_scan(xdt, da, bm, cm, h0):
    bsz, n, nh, p = xdt.shape
    g, ns = bm.shape[2], bm.shape[3]
    r = nh // g
    nc = n // CHUNK
    xc = xdt.reshape(bsz, nc, CHUNK, g, r, p)
    acs = jnp.cumsum(da.reshape(bsz, nc, CHUNK, g, r), axis=2)
    bc = bm.reshape(bsz, nc, CHUNK, g, ns)
    cc = cm.reshape(bsz, nc, CHUNK, g, ns)
    causal = jnp.tril(jnp.ones((CHUNK, CHUNK), dtype=bool))[:, :, None, None]
    decay = _masked_exp(acs[:, :, :, None] - acs[:, :, None], causal)
    cb = jnp.einsum('bctgn,bcsgn->bctsg', cc, bc)
    y_diag = jnp.einsum('bctsg,bctsgr,bcsgrp->bctgrp', cb, decay, xc)
    states = jnp.einsum('bcsgn,bcsgr,bcsgrp->bcgrpn', bc, jnp.exp(acs[:, :, -1:] - acs), xc)
    chunk_decay = jnp.exp(acs[:, :, -1])

    def step(h, inp):
        st, dec = inp
        return dec[..., None, None] * h + st, h

    h_fin, h_in = lax.scan(step, h0.reshape(bsz, g, r, p, ns),
                           (jnp.moveaxis(states, 1, 0), jnp.moveaxis(chunk_decay, 1, 0)))
    y_off = jnp.einsum('bctgn,bcgrpn,bctgr->bctgrp', cc, jnp.moveaxis(h_in, 0, 1), jnp.exp(acs))
    return (y_diag + y_off).reshape(bsz, n, nh, p), h_fin.reshape(bsz, nh, p, ns)


def _ssd_mixer(u_ctx, u_lat, lat_conv, conv_w, conv_b, dt_bias, a_log, d_skip, norm_w):
    a = -jnp.exp(a_log.astype(jnp.float32))

    def prep(u, conv):
        z, xbc, dt_f, dt_b = _split(u, [SSD_WIDTH, SSD_CONV_DIM, SSD_HEADS, SSD_HEADS])
        xbc = jax.nn.silu(conv(xbc, conv_w) + conv_b)
        xs, bm, cm = _split(xbc, [SSD_WIDTH, SSD_GROUPS * SSD_STATE, SSD_GROUPS * SSD_STATE])
        bsz, n = u.shape[:2]
        xs = xs.reshape(bsz, n, SSD_HEADS, SSD_HEAD_DIM)
        bm = bm.reshape(bsz, n, SSD_GROUPS, SSD_STATE)
        cm = cm.reshape(bsz, n, SSD_GROUPS, SSD_STATE)
        dtf = jax.nn.softplus(dt_f + dt_bias[0])
        dtb = jax.nn.softplus(dt_b + dt_bias[1])
        fwd = (xs * dtf[..., None], dtf * a[0], bm, cm)
        bwd = (xs * dtb[..., None], dtb * a[1], bm, cm)
        return z, xs, fwd, bwd

    zc, xc, cf, cb = prep(u_ctx, _dwconv)
    zl, xl, lf, lb = prep(u_lat, lat_conv)
    h0 = jnp.zeros((u_lat.shape[0], SSD_HEADS, SSD_HEAD_DIM, SSD_STATE), jnp.float32)
    yc, yl = _two_way(_ssd_scan, cf, cb, lf, lb, h0)

    def out(y, xs, z):
        y = (y + d_skip[:, None] * xs).reshape(z.shape)
        return _group_rms(y * jax.nn.silu(z), SSD_WIDTH // SSD_GROUPS, norm_w.reshape(SSD_GROUPS, -1))

    return out(yc, xc, zc), out(yl, xl, zl)


def _hgrn2_scan(q, logf, k, v, s0):
    bsz, n, nh, dk = q.shape
    dv = v.shape[-1]
    nc = n // CHUNK
    chunks = lambda t: jnp.moveaxis(t.reshape(bsz, nc, CHUNK, *t.shape[2:]), 1, 0)
    causal = jnp.tril(jnp.ones((CHUNK, CHUNK), dtype=bool))[None, :, :, None, None]

    def step(s, inp):
        qc, gc, kc, vc = inp
        b = jnp.cumsum(gc, axis=1)
        w = _masked_exp(b[:, :, None] - b[:, None, :], causal)
        att = jnp.einsum('bthk,bshk,btshk->bhts', qc, kc, w)
        o = jnp.einsum('bhts,bshv->bthv', att, vc) + jnp.einsum('bthk,bhkv->bthv', qc * jnp.exp(b), s)
        b_last = b[:, -1]
        s = jnp.exp(b_last)[..., None] * s + jnp.einsum('bshk,bshv->bhkv', kc * jnp.exp(b_last[:, None] - b), vc)
        return s, o

    s_fin, o = lax.scan(step, s0, (chunks(q), chunks(logf), chunks(k), chunks(v)))
    return jnp.moveaxis(o, 0, 1).reshape(bsz, n, nh, dv), s_fin


def _hgrn_mixer(u_ctx, u_lat, lower, norm_w):
    log_lower = jnp.log(jnp.maximum(lower, MIN_LOWER))

    def gate(fr):
        logf = jnp.logaddexp(jax.nn.log_sigmoid(fr), log_lower + jax.nn.log_sigmoid(-fr))
        return logf, (1.0 - lower) * jax.nn.sigmoid(-fr)

    def prep(u):
        q, f_f, f_b, i, g = _split(u, [HGRN_KEY_WIDTH, HGRN_KEY_WIDTH, HGRN_KEY_WIDTH, HGRN_WIDTH, HGRN_WIDTH])
        bsz, n = u.shape[:2]
        heads = lambda t, d: t.reshape(bsz, n, HGRN_HEADS, d)
        q = heads(jax.nn.silu(q), HGRN_KEY_DIM)
        i = heads(i, HGRN_HEAD_DIM)
        lf, kf = gate(f_f)
        lbw, kb = gate(f_b)
        fwd = (q, heads(lf, HGRN_KEY_DIM), heads(kf, HGRN_KEY_DIM), i)
        bwd = (q, heads(lbw, HGRN_KEY_DIM), heads(kb, HGRN_KEY_DIM), i)
        return g, fwd, bwd

    gc, cf, cb = prep(u_ctx)
    gl, lf, lb = prep(u_lat)
    s0 = jnp.zeros((u_lat.shape[0], HGRN_HEADS, HGRN_KEY_DIM, HGRN_HEAD_DIM), jnp.float32)
    oc, ol = _two_way(_hgrn2_scan, cf, cb, lf, lb, s0)
    out = lambda o, g: _group_rms(o.reshape(g.shape), HGRN_HEAD_DIM, norm_w) * jax.nn.silu(g)
    return out(oc, gc), out(ol, gl)


def _gdn_scan(q, k, v, g, beta, s0):
    bsz, n, nh, dk = q.shape
    dv = v.shape[-1]
    nc = n // CHUNK

    def to_chunks(t):
        return jnp.moveaxis(t.reshape(bsz, nc, CHUNK, nh, *t.shape[3:]), 3, 2)

    qc, kc, vc, bc = to_chunks(q), to_chunks(k), to_chunks(v), to_chunks(beta)
    gam = jnp.cumsum(to_chunks(g), axis=-1)
    incl = jnp.tril(jnp.ones((CHUNK, CHUNK), dtype=bool))
    strict = jnp.tril(jnp.ones((CHUNK, CHUNK), dtype=bool), k=-1)
    decay = _masked_exp(gam[..., :, None] - gam[..., None, :], incl)
    kb = kc * bc[..., None]
    a_strict = jnp.where(strict, jnp.einsum('bchtk,bchsk->bchts', kb, kc) * decay, 0.0)
    lhs = a_strict + jnp.eye(CHUNK, dtype=a_strict.dtype)
    rhs = jnp.concatenate([vc * bc[..., None], kb * jnp.exp(gam)[..., None]], axis=-1)
    sol = lax.linalg.triangular_solve(lhs, rhs, left_side=True, lower=True, unit_diagonal=True)
    u, w = sol[..., :dv], sol[..., dv:]
    qk = jnp.einsum('bchtk,bchsk->bchts', qc, kc) * decay
    qg = qc * jnp.exp(gam)[..., None]
    kend = kc * jnp.exp(gam[..., -1:] - gam)[..., None]
    dec = jnp.exp(gam[..., -1])

    def step(s, inp):
        u_c, w_c, qk_c, qg_c, ke_c, d_c = inp
        v_new = u_c - jnp.einsum('bhtk,bhkv->bhtv', w_c, s)
        o = jnp.einsum('bhtk,bhkv->bhtv', qg_c, s) + jnp.einsum('bhts,bhsv->bhtv', qk_c, v_new)
        s = d_c[..., None, None] * s + jnp.einsum('bhsk,bhsv->bhkv', ke_c, v_new)
        return s, o

    mv = lambda t: jnp.moveaxis(t, 1, 0)
    s_fin, o = lax.scan(step, s0, (mv(u), mv(w), mv(qk), mv(qg), mv(kend), mv(dec)))
    o = jnp.moveaxis(jnp.moveaxis(o, 0, 1), 2, 3).reshape(bsz, n, nh, dv)
    return o, s_fin


def _gdn_mixer(u_ctx, u_lat, lat_conv, conv_w, dt_bias, a_log, norm_w):
    a = jnp.exp(a_log.astype(jnp.float32))

    def prep(u, conv):
        qkv, a_f, a_b, b_f, b_b, g = _split(u, [GDN_CONV_DIM, GDN_HEADS, GDN_HEADS, GDN_HEADS, GDN_HEADS, GDN_WIDTH])
        q, k, v = _split(jax.nn.silu(conv(qkv, conv_w)), [GDN_KEY_WIDTH, GDN_KEY_WIDTH, GDN_WIDTH])
        bsz, n = u.shape[:2]
        q = _l2norm(q.reshape(bsz, n, GDN_HEADS, GDN_KEY_DIM)) * GDN_KEY_DIM ** -0.5
        k = _l2norm(k.reshape(bsz, n, GDN_HEADS, GDN_KEY_DIM))
        v = v.reshape(bsz, n, GDN_HEADS, GDN_HEAD_DIM)
        g_f = -a[0] * jax.nn.softplus(a_f + dt_bias[0])
        g_b = -a[1] * jax.nn.softplus(a_b + dt_bias[1])
        return g, (q, k, v, g_f, jax.nn.sigmoid(b_f)), (q, k, v, g_b, jax.nn.sigmoid(b_b))

    gc, cf, cb = prep(u_ctx, _dwconv)
    gl, lf, lb = prep(u_lat, lat_conv)
    s0 = jnp.zeros((u_lat.shape[0], GDN_HEADS, GDN_KEY_DIM, GDN_HEAD_DIM), jnp.float32)
    oc, ol = _two_way(_gdn_scan, cf, cb, lf, lb, s0)
    out = lambda o, g: _group_rms(o.reshape(g.shape), GDN_HEAD_DIM, norm_w) * jax.nn.silu(g)
    return out(oc, gc), out(ol, gl)


def _routed_experts(h, router_w, router_bias, w_gate, w_up, w_down):
    n_tok, dm = h.shape
    n_assign = n_tok * TOP_K
    scores = jax.nn.sigmoid(jnp.dot(h.astype(jnp.float32), router_w.astype(jnp.float32)))
    _, idx = lax.top_k(scores + router_bias.astype(jnp.float32), TOP_K)
    gate = jnp.take_along_axis(scores, idx, axis=-1)
    gate = gate / jnp.sum(gate, axis=-1, keepdims=True) * ROUTED_SCALE
    flat_e = idx.reshape(-1)
    order = jnp.argsort(flat_e)
    e_sorted = flat_e[order]
    token = order // TOP_K
    counts = jnp.bincount(flat_e, length=N_EXPERTS)
    padded = (counts + EXPERT_BLOCK - 1) // EXPERT_BLOCK * EXPERT_BLOCK
    pad_end = jnp.cumsum(padded)
    slot = (pad_end - padded)[e_sorted] + jnp.arange(n_assign) - (jnp.cumsum(counts) - counts)[e_sorted]
    n_blocks = -(-n_assign // EXPERT_BLOCK) + N_EXPERTS
    buf = jnp.zeros((n_blocks * EXPERT_BLOCK, dm), h.dtype).at[slot].set(h[token])
    block_expert = jnp.minimum(
        jnp.searchsorted(pad_end, jnp.arange(n_blocks) * EXPERT_BLOCK, side='right'), N_EXPERTS - 1)

    def expert_block(args):
        xb, e = args
        return (jax.nn.silu(xb @ w_gate[e]) * (xb @ w_up[e])) @ w_down[e]

    out = lax.map(expert_block, (buf.reshape(n_blocks, EXPERT_BLOCK, dm), block_expert))
    out = out.reshape(n_blocks * EXPERT_BLOCK, dm)
    contrib = out[slot] * gate.reshape(-1)[order][:, None].astype(out.dtype)
    return jnp.zeros_like(h).at[token].add(contrib)


def _moe(h, router_w, router_bias, w_gate, w_up, w_down, sh_gate, sh_up, sh_down):
    routed = lax.map(lambda hs: _routed_experts(hs, router_w, router_bias, w_gate, w_up, w_down), h)
    shared = (jax.nn.silu(h @ sh_gate) * (h @ sh_up)) @ sh_down
    return routed + shared


def setup_inputs(seed: int = 0) -> dict:
    key = jax.random.key(seed)
    ks = jax.random.split(key, 31)
    nrm = lambda k, shape, scale: jax.random.normal(k, shape, jnp.float32) * scale

    def dt_bias(k, shape):
        dt = jnp.exp(jax.random.uniform(k, shape, jnp.float32) * (math.log(0.1) - math.log(1e-3)) + math.log(1e-3))
        return dt + jnp.log(-jnp.expm1(-dt))

    def a_log(k, shape):
        return jnp.log(jax.random.uniform(k, shape, jnp.float32, minval=1.0, maxval=16.0))

    L = DEPTH
    return {
        'x': nrm(ks[0], (BATCH, SEQ, D_MODEL), 1.0),
        'c': nrm(ks[1], (BATCH, D_MODEL), 1.0),
        'ctx': nrm(ks[2], (BATCH, CTX_LEN, D_MODEL), 1.0),
        'c_ctx': nrm(ks[3], (D_MODEL,), 1.0),
        'w_mod': nrm(ks[4], (L, D_MODEL, 6 * D_MODEL), 0.5 * D_MODEL ** -0.5),
        'b_mod': nrm(ks[5], (L, 6 * D_MODEL), 0.02),
        'norm_mix': 1.0 + nrm(ks[6], (L, D_MODEL), 0.02),
        'w_in': nrm(ks[7], (L, D_MODEL, IN_COLS), D_MODEL ** -0.5),
        'ssd_conv_w': nrm(ks[8], (L, CONV_W, SSD_CONV_DIM), CONV_W ** -0.5),
        'ssd_conv_b': nrm(ks[9], (L, SSD_CONV_DIM), 0.02),
        'ssd_dt_bias': dt_bias(ks[10], (L, 2, SSD_HEADS)),
        'ssd_a_log': a_log(ks[11], (L, 2, SSD_HEADS)),
        'ssd_d': 1.0 + nrm(ks[12], (L, SSD_HEADS), 0.02),
        'ssd_norm': 1.0 + nrm(ks[13], (L, SSD_WIDTH), 0.02),
        'hgrn_lb': nrm(ks[14], (L, HGRN_KEY_WIDTH), 0.1),
        'hgrn_norm': 1.0 + nrm(ks[15], (L, HGRN_HEAD_DIM), 0.02),
        'gdn_conv_w': nrm(ks[16], (L, CONV_W, GDN_CONV_DIM), CONV_W ** -0.5),
        'gdn_dt_bias': dt_bias(ks[17], (L, 2, GDN_HEADS)),
        'gdn_a_log': a_log(ks[18], (L, 2, GDN_HEADS)),
        'gdn_norm': 1.0 + nrm(ks[19], (L, GDN_HEAD_DIM), 0.02),
        'w_out': nrm(ks[20], (L, MIX_WIDTH, D_MODEL), MIX_WIDTH ** -0.5),
        'norm_ffn': 1.0 + nrm(ks[21], (L, D_MODEL), 0.02),
        'router_w': nrm(ks[22], (L, D_MODEL, N_EXPERTS), D_MODEL ** -0.5),
        'router_bias': nrm(ks[23], (L, N_EXPERTS), 0.01),
        'exp_gate': nrm(ks[24], (L, N_EXPERTS, D_MODEL, EXPERT_DIM), D_MODEL ** -0.5),
        'exp_up': nrm(ks[25], (L, N_EXPERTS, D_MODEL, EXPERT_DIM), D_MODEL ** -0.5),
        'exp_down': nrm(ks[26], (L, N_EXPERTS, EXPERT_DIM, D_MODEL), EXPERT_DIM ** -0.5),
        'sh_gate': nrm(ks[27], (L, D_MODEL, SHARED_DIM), D_MODEL ** -0.5),
        'sh_up': nrm(ks[28], (L, D_MODEL, SHARED_DIM), D_MODEL ** -0.5),
        'sh_down': nrm(ks[29], (L, SHARED_DIM, D_MODEL), SHARED_DIM ** -0.5),
        'norm_final': 1.0 + nrm(ks[30], (D_MODEL,), 0.02),
    }


def reference(x, c, ctx, c_ctx, w_mod, b_mod, norm_mix, w_in, ssd_conv_w, ssd_conv_b, ssd_dt_bias,
              ssd_a_log, ssd_d, ssd_norm, hgrn_lb, hgrn_norm, gdn_conv_w, gdn_dt_bias, gdn_a_log, gdn_norm,
              w_out, norm_ffn, router_w, router_bias, exp_gate, exp_up, exp_down, sh_gate, sh_up, sh_down,
              norm_final):
    rows = x.shape[1] // GRID_W
    lat_conv = functools.partial(_grid_conv, rows=rows)
    p_lb = jax.nn.softmax(hgrn_lb.astype(jnp.float32), axis=0)
    lower_all = jnp.cumsum(p_lb, axis=0) - p_lb[0]
    s_lat = jax.nn.silu(c)
    s_ctx = jax.nn.silu(c_ctx)[None]
    h, hc = x, ctx
    for l in range(DEPTH):
        mod_l = (s_lat @ w_mod[l] + b_mod[l])[:, None, :]
        mod_c = (s_ctx @ w_mod[l] + b_mod[l])[:, None, :]
        sh_m, sc_m, g_m, sh_f, sc_f, g_f = jnp.split(mod_l, 6, axis=-1)
        csh_m, csc_m, cg_m, csh_f, csc_f, cg_f = jnp.split(mod_c, 6, axis=-1)

        a_l = _rmsnorm(h, norm_mix[l]) * (1.0 + sc_m) + sh_m
        a_c = _rmsnorm(hc, norm_mix[l]) * (1.0 + csc_m) + csh_m
        u_l = (a_l @ w_in[l]).astype(jnp.float32)
        u_c = (a_c @ w_in[l]).astype(jnp.float32)
        ssd_c, hg_c, gd_c = _split(u_c, [SSD_IN, HGRN_IN, GDN_IN])
        ssd_l, hg_l, gd_l = _split(u_l, [SSD_IN, HGRN_IN, GDN_IN])
        ys_c, ys_l = _ssd_mixer(ssd_c, ssd_l, lat_conv, ssd_conv_w[l], ssd_conv_b[l], ssd_dt_bias[l],
                                ssd_a_log[l], ssd_d[l], ssd_norm[l])
        yh_c, yh_l = _hgrn_mixer(hg_c, hg_l, lower_all[l], hgrn_norm[l])
        yg_c, yg_l = _gdn_mixer(gd_c, gd_l, lat_conv, gdn_conv_w[l], gdn_dt_bias[l], gdn_a_log[l], gdn_norm[l])
        y_l = jnp.concatenate([ys_l, yh_l, yg_l], axis=-1).astype(h.dtype)
        h = h + g_m * (y_l @ w_out[l])

        f_l = _rmsnorm(h, norm_ffn[l]) * (1.0 + sc_f) + sh_f
        h = h + g_f * _moe(f_l, router_w[l], router_bias[l], exp_gate[l], exp_up[l], exp_down[l],
                           sh_gate[l], sh_up[l], sh_down[l])

        if l < DEPTH - 1:
            y_c = jnp.concatenate([ys_c, yh_c, yg_c], axis=-1).astype(hc.dtype)
            hc = hc + cg_m * (y_c @ w_out[l])
            f_c = _rmsnorm(hc, norm_ffn[l]) * (1.0 + csc_f) + csh_f
            hc = hc + cg_f * _moe(f_c, router_w[l], router_bias[l], exp_gate[l], exp_up[l], exp_down[l],
                                  sh_gate[l], sh_up[l], sh_down[l])
    return _rmsnorm(h, norm_final)
```

```cpp
#include <hip/hip_runtime.h>
#include <stdint.h>
#include <stdio.h>

#ifndef MK_ONE_LAUNCH
#define MK_ONE_LAUNCH 0
#endif

#define LAS __attribute__((address_space(3)))
typedef unsigned short bf16_t;
typedef short bf16x8 __attribute__((ext_vector_type(8)));
typedef float f32x4 __attribute__((ext_vector_type(4)));
typedef unsigned u32x4 __attribute__((ext_vector_type(4)));
typedef unsigned u32x2 __attribute__((ext_vector_type(2)));

constexpr int D = 1024, NBATCH = 8, SEQ = 8192, CTXL = 256, TPS = SEQ + CTXL;
constexpr int NROW = NBATCH * TPS;
constexpr int NPAN = NROW / 256;
constexpr int UC = 3872;
constexpr int NWIN = 4096;
constexpr int GRID = 256, NTHR = 512;
constexpr float EPS = 1e-6f;
constexpr int C_Z = 0, C_X = 512, C_B = 1024, C_C = 1280, C_DT = 1536;
constexpr int C_HQ = 1552, C_HF = 1808, C_HI = 2320, C_HG = 2576;
constexpr int C_GQ = 2832, C_GK = 3088, C_GV = 3344, C_GA = 3600, C_GB = 3608, C_GG = 3616;
constexpr int NSEG = 193;
constexpr int MAXPROWS = 9 * NROW + NSEG * 256;

constexpr size_t al256(size_t x) { return (x + 255) & ~(size_t)255; }
constexpr size_t OFF_BAR = 0;
constexpr size_t OFF_MOD = 16384;
constexpr size_t OFF_WINT = al256(OFF_MOD + (size_t)2 * 9 * 6144 * 4);
constexpr size_t OFF_WOUTT = OFF_WINT + (size_t)2 * NWIN * D * 2;
constexpr size_t OFF_SH1T = OFF_WOUTT + (size_t)2 * D * D * 2;
constexpr size_t OFF_SH2T = OFF_SH1T + (size_t)2 * 512 * D * 2;
constexpr size_t OFF_RT = OFF_SH2T + (size_t)2 * D * 256 * 2;
constexpr size_t ACT_BYTES = (size_t)NROW * D * 2;
constexpr size_t OFF_HB = OFF_RT + (size_t)2 * 256 * D * 2;
constexpr size_t OFF_AB = OFF_HB + ACT_BYTES;
constexpr size_t OFF_Y2 = OFF_AB + ACT_BYTES;
constexpr size_t OFF_UB = OFF_Y2 + ACT_BYTES;
constexpr size_t UB_BYTES = (size_t)NROW * UC * 2;
constexpr size_t WS_END = OFF_UB + UB_BYTES;
constexpr size_t OFF_W1T = OFF_Y2;
constexpr size_t OFF_W2T = OFF_W1T + (size_t)64 * 512 * D * 2;
static_assert(OFF_W2T + (size_t)64 * D * 256 * 2 <= OFF_UB, "expert weights overflow");
constexpr size_t OFF_SC = OFF_UB;
constexpr size_t OFF_TOKE = OFF_SC + (size_t)NROW * 64 * 4;
constexpr size_t OFF_TOKG = OFF_TOKE + (size_t)NROW * 8 * 4;
constexpr size_t OFF_TOKLR = OFF_TOKG + (size_t)NROW * 8 * 4;
constexpr size_t OFF_BCNT = OFF_TOKLR + (size_t)NROW * 12 * 4;
constexpr size_t OFF_SEGP = OFF_BCNT + (size_t)256 * 256 * 4;
constexpr size_t OFF_RINFO = OFF_SEGP + 1024;
constexpr size_t OFF_RGATE = al256(OFF_RINFO + (size_t)MAXPROWS * 4);
constexpr size_t OFF_HACT = al256(OFF_RGATE + (size_t)MAXPROWS * 4);
constexpr size_t OFF_B2 = al256(OFF_HACT + (size_t)MAXPROWS * 512);
static_assert(OFF_B2 + ACT_BYTES <= WS_END, "MoE scratch overflow");

constexpr int LDS_STAGE = 131072;
constexpr int LDS_BARW = LDS_STAGE;
constexpr int LDS_TAB = LDS_STAGE + 1024;
constexpr int LDS_BYTES = LDS_STAGE + 16384;

struct P {
    const float *x, *c, *ctx, *c_ctx, *w_mod, *b_mod, *norm_mix, *w_in, *ssd_conv_w, *ssd_conv_b, *ssd_dt_bias, *ssd_a_log, *ssd_d, *ssd_norm,
        *hgrn_lb, *hgrn_norm, *gdn_conv_w, *gdn_dt_bias, *gdn_a_log, *gdn_norm, *w_out, *norm_ffn, *router_w, *router_bias, *exp_gate, *exp_up,
        *exp_down, *sh_gate, *sh_up, *sh_down, *norm_final;
    float* out;
    unsigned char* ws;
};

__device__ __forceinline__ float bf2f(bf16_t v) { return __uint_as_float((unsigned)v << 16); }
__device__ __forceinline__ float bflo(unsigned v) { return __uint_as_float(v << 16); }
__device__ __forceinline__ float bfhi(unsigned v) { return __uint_as_float(v & 0xffff0000u); }
__device__ __forceinline__ unsigned pk2(float lo, float hi) { unsigned r; asm volatile("v_cvt_pk_bf16_f32 %0, %1, %2" : "=v"(r) : "v"(lo), "v"(hi)); return r; }
__device__ __forceinline__ bf16_t f2bf(float f) { return (bf16_t)(pk2(f, 0.f) & 0xffffu); }
__device__ __forceinline__ float sigmoidf_(float x) { return 1.f / (1.f + __expf(-x)); }
__device__ __forceinline__ float siluf_(float x) { return x / (1.f + __expf(-x)); }
__device__ __forceinline__ float softplusf_(float x) { return fmaxf(x, 0.f) + log1pf(__expf(-fabsf(x))); }
__device__ __forceinline__ float wave_sum(float v) {
#pragma unroll
    for (int o = 1; o < 64; o <<= 1) v += __shfl_xor(v, o);
    return v;
}
__device__ __forceinline__ int row_b(int row) { return row / TPS; }
__device__ __forceinline__ int row_pos(int row) { return row % TPS; }
__device__ __forceinline__ int mod_idx(int row) { return (row % TPS) < CTXL ? 8 : row / TPS; }
__device__ __forceinline__ const float* src_row_f32(const P& p, int row) {
    const int b = row / TPS, pos = row - b * TPS;
    return pos < CTXL ? p.ctx + ((size_t)b * CTXL + pos) * D : p.x + ((size_t)b * SEQ + (pos - CTXL)) * D;
}
__device__ __forceinline__ void unpack8(const u32x4 v, float (&f)[8]) {
    f[0] = bflo(v.x); f[1] = bfhi(v.x); f[2] = bflo(v.y); f[3] = bfhi(v.y); f[4] = bflo(v.z); f[5] = bfhi(v.z); f[6] = bflo(v.w); f[7] = bfhi(v.w);
}
__device__ __forceinline__ u32x4 pack8(const float (&f)[8]) { u32x4 o; o.x = pk2(f[0], f[1]); o.y = pk2(f[2], f[3]); o.z = pk2(f[4], f[5]); o.w = pk2(f[6], f[7]); return o; }

#define XB_TMO      128
#define XB_XCNT(j)  (256  + 64 * (j))
#define XB_XSUB(j)  (1280 + 64 * (j))
#define XB_XGEN(j)  (2304 + 64 * (j))
#define XB_TOP      3328
#define XB_TOPGEN   3392
#define XCD_BAR_WORDS 3456
#define XB_SPIN_CAP (1u << 18)
__device__ __forceinline__ unsigned xb_ld(unsigned* p)              { return __hip_atomic_load(p, __ATOMIC_RELAXED, __HIP_MEMORY_SCOPE_AGENT); }
__device__ __forceinline__ unsigned xb_add(unsigned* p, unsigned v) { return __hip_atomic_fetch_add(p, v, __ATOMIC_RELAXED, __HIP_MEMORY_SCOPE_AGENT); }
__device__ __forceinline__ unsigned xb_xcc_id() { return (unsigned)__builtin_amdgcn_s_getreg((3 << 11) | 20) & 0xFu; }
#define XB_SPIN(cond, bar) do { unsigned _sp = 0; while (cond) { __builtin_amdgcn_s_sleep(1); \
    if ((++_sp & 255u) == 0u) { if (xb_ld(&(bar)[XB_TMO])) break; if (_sp > XB_SPIN_CAP) { atomicAdd(&(bar)[XB_TMO], 1u); break; } } } } while (0)
struct XcdBarrier { unsigned* bar; unsigned x; volatile LAS unsigned* st; };
__device__ __forceinline__ XcdBarrier xcd_barrier_post(unsigned* bar, volatile LAS unsigned* st) {
    XcdBarrier b; b.bar = bar; b.x = xb_xcc_id(); b.st = st;
    if (threadIdx.x == 0) (void)xb_add(&bar[XB_XCNT(b.x)], 1u);
    return b;
}
__device__ __forceinline__ void xcd_barrier_complete(unsigned* bar, unsigned x, unsigned& nloc, unsigned& nx) {
    const unsigned G = gridDim.x * gridDim.y * gridDim.z;
    unsigned sum, cnt, mine, sp = 0u;
    for (;;) {
        sum = 0u; cnt = 0u; mine = 0u;
#pragma unroll
        for (unsigned j = 0; j < 16; ++j) { const unsigned c = xb_ld(&bar[XB_XCNT(j)]); sum += c; cnt += (c > 0u) ? 1u : 0u; mine = (j == x) ? c : mine; }
        if (sum == G) break;
        __builtin_amdgcn_s_sleep(1);
        if ((++sp & 255u) == 0u) { if (xb_ld(&bar[XB_TMO])) break; if (sp > XB_SPIN_CAP) { atomicAdd(&bar[XB_TMO], 1u); break; } }
    }
    nloc = mine > 0u ? mine : 1u; nx = cnt > 0u ? cnt : 1u;
}
__device__ __forceinline__ void xcd_barrier(const XcdBarrier& b) {
    asm volatile("s_waitcnt vmcnt(0)" ::: "memory");
    __syncthreads();
    if (threadIdx.x == 0) {
        unsigned* bar = b.bar;
        __builtin_amdgcn_s_waitcnt(0);
        unsigned nloc = b.st[0], nx = b.st[1];
        if (nloc == 0u) { xcd_barrier_complete(bar, b.x, nloc, nx); b.st[0] = nloc; b.st[1] = nx; }
        const unsigned old = xb_add(&bar[XB_XSUB(b.x)], 1u);
        const unsigned gen = old / nloc;
        if (old + 1u == (gen + 1u) * nloc) {
            __builtin_amdgcn_fence(__ATOMIC_RELEASE, "agent");
            asm volatile("s_waitcnt vmcnt(0)" ::: "memory");
            const unsigned og = xb_add(&bar[XB_TOP], 1u);
            const unsigned tg = og / nx;
            if (og + 1u == (tg + 1u) * nx) xb_add(&bar[XB_TOPGEN], 1u);
            else XB_SPIN(xb_ld(&bar[XB_TOPGEN]) == tg, bar);
            __builtin_amdgcn_fence(__ATOMIC_ACQUIRE, "agent");
            xb_add(&bar[XB_XGEN(b.x)], 1u);
            asm volatile("s_waitcnt vmcnt(0)" ::: "memory");
        } else {
            XB_SPIN(xb_ld(&bar[XB_XGEN(b.x)]) == gen, bar);
            __builtin_amdgcn_fence(__ATOMIC_ACQUIRE, "agent");
            asm volatile("s_waitcnt vmcnt(0)" ::: "memory");
        }
    }
    __syncthreads();
}

namespace pg8 {
constexpr int BM = 256, BK = 64, HALF = 128, HTB = HALF * BK * 2, STAGE_BYTES = 8 * HTB;
__device__ __forceinline__ int lds_byte(int r, int c) { const int st = (r >> 4) * 2 + (c >> 5), rr = r & 15, cc = c & 31, ob = rr * 64 + cc * 2; return st * 1024 + (ob ^ (((ob >> 9) & 1) << 5)); }
__device__ __forceinline__ void stage_rc(int b, int& R, int& C) { const int st = b / 1024, sb = b % 1024, swz = sb ^ (((sb >> 9) & 1) << 5); R = (st >> 1) * 16 + swz / 64; C = (st & 1) * 32 + (swz % 64) / 2; }
__device__ __forceinline__ int perm32(int rho) { const int n = rho >> 4, i = rho & 15; return 8 * (i >> 2) + 4 * n + (i & 3); }
struct Unit { int pm, pn, aux; };

template <class Epi, class Sched>
__device__ __forceinline__ void gemm_phase(LAS unsigned char* lds, const bf16_t* Abase, const int K, const Sched& S, const Epi& E) {
    const int tid = threadIdx.x, wid = __builtin_amdgcn_readfirstlane(tid >> 6), lane = tid & 63, wr = wid >> 2, wc = wid & 3, fr = lane & 15, fq = lane >> 4;
    const int nt = K / BK;
    int RA[2], CA[2]; unsigned voffB[2];
#pragma unroll
    for (int i = 0; i < 2; ++i) { int R, C; stage_rc(tid * 16 + i * 8192, R, C); const int Rb = Epi::PERM ? ((R & ~31) + perm32(R & 31)) : R;
        RA[i] = R; CA[i] = C; voffB[i] = (unsigned)(Rb * K + C) * 2u; }
    const size_t kstep = (size_t)(BK * 2);
    const size_t hstep = (size_t)HALF * K * 2;
    const unsigned ldsw = (unsigned)wid * 1024u;
    const int aoff = lds_byte(wr * 64 + fr, fq * 8), boff = lds_byte(wc * 32 + fr, fq * 8);
#define PG8_SA(b, h) (((b) * 2 + (h)) * HTB)
#define PG8_SB(b, h) ((4 + (b) * 2 + (h)) * HTB)
#define PG8_STAGE(bufoff, gbase, voff) do { _Pragma("unroll") for (int _i = 0; _i < 2; ++_i) \
        __builtin_amdgcn_global_load_lds((const unsigned*)((const char*)(gbase) + (voff)[_i]), (LAS unsigned*)(lds + (bufoff) + ldsw + _i * 8192), 16, 0, 0); } while (0)
#define PG8_LDA(dst, b, h) do { _Pragma("unroll") for (int m = 0; m < 4; ++m) _Pragma("unroll") for (int k = 0; k < 2; ++k) dst[m][k] = *(const LAS bf16x8*)(lds + PG8_SA(b, h) + aoff + m * 2048 + k * 1024); } while (0)
#define PG8_LDB(dst, b, h) do { _Pragma("unroll") for (int n = 0; n < 2; ++n) _Pragma("unroll") for (int k = 0; k < 2; ++k) dst[n][k] = *(const LAS bf16x8*)(lds + PG8_SB(b, h) + boff + n * 2048 + k * 1024); } while (0)
#define PG8_MMA(ai, bj, At, Bt) do { __builtin_amdgcn_s_setprio(1); _Pragma("unroll") for (int m = 0; m < 4; ++m) _Pragma("unroll") for (int n = 0; n < 2; ++n) _Pragma("unroll") for (int k = 0; k < 2; ++k) \
        acc[ai][bj][m][n] = __builtin_amdgcn_mfma_f32_16x16x32_bf16(Bt[n][k], At[m][k], acc[ai][bj][m][n], 0, 0, 0); __builtin_amdgcn_s_setprio(0); } while (0)
#define PG8_WAIT_V(n) asm volatile("s_waitcnt vmcnt(" #n ")" ::: "memory")
#define PG8_WAIT_L(n) asm volatile("s_waitcnt lgkmcnt(" #n ")" ::: "memory")
#define PG8_BAR __builtin_amdgcn_s_barrier()
#define PG8_SCHED __builtin_amdgcn_sched_barrier(0)
    Unit cur, nxt; int ui = 0;
    if (!S.next(0, cur)) return;
    f32x4 acc[2][2][4][2];
#pragma unroll
    for (int a = 0; a < 2; ++a)
#pragma unroll
        for (int b = 0; b < 2; ++b)
#pragma unroll
            for (int m = 0; m < 4; ++m)
#pragma unroll
                for (int n = 0; n < 2; ++n) acc[a][b][m][n] = (f32x4){0.f, 0.f, 0.f, 0.f};
    bf16x8 At[4][2], B0[2][2], B1[2][2];
    unsigned cvA[2][2], nvA[2][2];
    S.avoff(cur, RA, CA, cvA);
    const char* gA = (const char*)Abase;
    const char* cB = S.bptr(cur);
    PG8_STAGE(PG8_SB(0, 0), cB, voffB); PG8_STAGE(PG8_SA(0, 0), gA, cvA[0]); PG8_STAGE(PG8_SB(0, 1), cB + hstep, voffB); PG8_STAGE(PG8_SA(0, 1), gA, cvA[1]);
    if (wr == 1) PG8_BAR;
    PG8_WAIT_V(4); PG8_BAR;
    PG8_STAGE(PG8_SB(1, 0), cB + kstep, voffB); PG8_STAGE(PG8_SA(1, 0), gA + kstep, cvA[0]); PG8_STAGE(PG8_SB(1, 1), cB + hstep + kstep, voffB);
    PG8_WAIT_V(6); PG8_BAR;
    for (;;) {
        const bool has_next = S.next(ui + 1, nxt);
        const char* nB = has_next ? S.bptr(nxt) : cB;
        if (has_next) S.avoff(nxt, RA, CA, nvA);
        else {
#pragma unroll
            for (int h = 0; h < 2; ++h)
#pragma unroll
                for (int i = 0; i < 2; ++i) nvA[h][i] = cvA[h][i];
        }
        for (int t = 0; t < nt; t += 2) {
            const bool last = (t == nt - 2);
            const char* a1 = gA + (size_t)(t + 1) * kstep;
            const char* a2 = last ? gA : gA + (size_t)(t + 2) * kstep; const char* b2 = last ? nB : cB + (size_t)(t + 2) * kstep;
            const char* a3 = a2 + kstep; const char* b3 = b2 + kstep;
            unsigned v2[2][2];
#pragma unroll
            for (int h = 0; h < 2; ++h)
#pragma unroll
                for (int i = 0; i < 2; ++i) v2[h][i] = last ? nvA[h][i] : cvA[h][i];
            PG8_LDB(B0, 0, 0); PG8_SCHED; PG8_LDA(At, 0, 0); PG8_STAGE(PG8_SA(1, 1), a1, cvA[1]);
            PG8_WAIT_L(8); PG8_BAR; PG8_WAIT_L(0); PG8_MMA(0, 0, At, B0); PG8_BAR; PG8_SCHED;
            PG8_LDB(B1, 0, 1); PG8_STAGE(PG8_SB(0, 0), b2, voffB);
            PG8_BAR; PG8_WAIT_L(0); PG8_MMA(0, 1, At, B1); PG8_BAR;
            PG8_LDA(At, 0, 1); PG8_STAGE(PG8_SA(0, 0), a2, v2[0]);
            PG8_BAR; PG8_WAIT_L(0); PG8_MMA(1, 0, At, B0); PG8_BAR; PG8_SCHED;
            PG8_STAGE(PG8_SB(0, 1), b2 + hstep, voffB);
            PG8_WAIT_V(6); PG8_BAR; PG8_MMA(1, 1, At, B1); PG8_BAR;
            PG8_LDB(B0, 1, 0); PG8_SCHED; PG8_LDA(At, 1, 0); PG8_STAGE(PG8_SA(0, 1), a2, v2[1]);
            PG8_WAIT_L(8); PG8_BAR; PG8_WAIT_L(0); PG8_MMA(0, 0, At, B0); PG8_BAR; PG8_SCHED;
            PG8_LDB(B1, 1, 1); PG8_STAGE(PG8_SB(1, 0), b3, voffB);
            PG8_BAR; PG8_WAIT_L(0); PG8_MMA(0, 1, At, B1); PG8_BAR;
            PG8_LDA(At, 1, 1); PG8_STAGE(PG8_SA(1, 0), a3, v2[0]);
            PG8_BAR; PG8_WAIT_L(0); PG8_MMA(1, 0, At, B0); PG8_BAR; PG8_SCHED;
            PG8_STAGE(PG8_SB(1, 1), b3 + hstep, voffB);
            PG8_WAIT_V(6); PG8_BAR; PG8_MMA(1, 1, At, B1); PG8_BAR;
        }
        E(acc, cur, wr, wc, fr, fq);
        if (!has_next) break;
#pragma unroll
        for (int a = 0; a < 2; ++a)
#pragma unroll
            for (int b = 0; b < 2; ++b)
#pragma unroll
                for (int m = 0; m < 4; ++m)
#pragma unroll
                    for (int n = 0; n < 2; ++n) acc[a][b][m][n] = (f32x4){0.f, 0.f, 0.f, 0.f};
        cur = nxt; cB = nB; ++ui;
#pragma unroll
        for (int h = 0; h < 2; ++h)
#pragma unroll
            for (int i = 0; i < 2; ++i) cvA[h][i] = nvA[h][i];
    }
    PG8_WAIT_V(0);
    if (wr == 0) PG8_BAR;
    PG8_BAR;
#undef PG8_SA
#undef PG8_SB
#undef PG8_STAGE
#undef PG8_LDA
#undef PG8_LDB
#undef PG8_MMA
#undef PG8_WAIT_V
#undef PG8_WAIT_L
#undef PG8_BAR
#undef PG8_SCHED
}
}
using pg8::Unit;

struct SchedDense {
    const bf16_t* Bt; int K, nN, nUnits, G, c, latOnly;
    __device__ __forceinline__ bool next(int i, Unit& u) const {
        const int L = i * G + c; if (L >= nUnits) return false;
        const int q = L / nN; u.pn = L - q * nN; u.pm = latOnly ? (q >> 5) * 33 + 1 + (q & 31) : q; u.aux = 0; return true;
    }
    __device__ __forceinline__ void avoff(const Unit& u, const int (&R)[2], const int (&C)[2], unsigned (&v)[2][2]) const {
#pragma unroll
        for (int h = 0; h < 2; ++h)
#pragma unroll
            for (int i = 0; i < 2; ++i) v[h][i] = (unsigned)((u.pm * 256 + h * 128 + R[i]) * K + C[i]) * 2u;
    }
    __device__ __forceinline__ const char* bptr(const Unit& u) const { return (const char*)Bt + (size_t)u.pn * 256 * K * 2; }
};
__device__ __forceinline__ int seg_find(const LAS int* segpan, int pp) {
    int lo = 0, hi = NSEG;
    while (hi - lo > 1) { const int mid = (lo + hi) >> 1; if (segpan[mid] <= pp) lo = mid; else hi = mid; }
    return lo;
}
struct SchedS1 {
    const LAS int* segpan; const int* rinfo; const bf16_t* w1t; const bf16_t* sh1t; int nUnits, G, c;
    __device__ __forceinline__ bool next(int i, Unit& u) const {
        const int L = i * G + c; if (L >= nUnits) return false;
        const int pp = L >> 1; u.pn = L & 1; u.pm = pp; const int s = seg_find(segpan, pp); u.aux = s < 192 ? (s & 63) : 64; return true;
    }
    __device__ __forceinline__ void avoff(const Unit& u, const int (&R)[2], const int (&C)[2], unsigned (&v)[2][2]) const {
#pragma unroll
        for (int h = 0; h < 2; ++h)
#pragma unroll
            for (int i = 0; i < 2; ++i) { const int info = rinfo[u.pm * 256 + h * 128 + R[i]]; const int tok = info < 0 ? 0 : (info >> 4); v[h][i] = (unsigned)(tok * D + C[i]) * 2u; }
    }
    __device__ __forceinline__ const char* bptr(const Unit& u) const {
        return u.aux < 64 ? (const char*)w1t + ((size_t)u.aux * 512 + u.pn * 256) * D * 2 : (const char*)sh1t + (size_t)u.pn * 256 * D * 2;
    }
};
struct SchedS2 {
    const LAS int* segpan; const bf16_t* w2t; const bf16_t* sh2t; int P0, nUnits, G, c;
    __device__ __forceinline__ bool next(int i, Unit& u) const {
        const int L = i * G + c; if (L >= nUnits) return false;
        const int pp = P0 + (L >> 2); u.pn = L & 3; u.pm = pp; const int s = seg_find(segpan, pp); u.aux = s < 192 ? (s & 63) : 64; return true;
    }
    __device__ __forceinline__ void avoff(const Unit& u, const int (&R)[2], const int (&C)[2], unsigned (&v)[2][2]) const {
#pragma unroll
        for (int h = 0; h < 2; ++h)
#pragma unroll
            for (int i = 0; i < 2; ++i) v[h][i] = (unsigned)((u.pm * 256 + h * 128 + R[i]) * 256 + C[i]) * 2u;
    }
    __device__ __forceinline__ const char* bptr(const Unit& u) const {
        return u.aux < 64 ? (const char*)w2t + ((size_t)u.aux * 1024 + u.pn * 256) * 256 * 2 : (const char*)sh2t + (size_t)u.pn * 256 * 256 * 2;
    }
};

struct EpiU {
    static constexpr bool PERM = true;
    bf16_t* U;
    __device__ __forceinline__ void operator()(const f32x4 (&acc)[2][2][4][2], const Unit& u, int wr, int wc, int fr, int fq) const {
        const int row0 = u.pm * 256 + wr * 64 + fr, col0 = u.pn * 256 + wc * 32 + 8 * fq;
#pragma unroll
        for (int ai = 0; ai < 2; ++ai)
#pragma unroll
            for (int m = 0; m < 4; ++m) { bf16_t* rowp = U + (size_t)(row0 + ai * 128 + m * 16) * UC;
#pragma unroll
                for (int bj = 0; bj < 2; ++bj) { const int col = col0 + bj * 128;
                    if (col < UC) { const f32x4 v0 = acc[ai][bj][m][0], v1 = acc[ai][bj][m][1];
                        u32x4 o; o.x = pk2(v0[0], v0[1]); o.y = pk2(v0[2], v0[3]); o.z = pk2(v1[0], v1[1]); o.w = pk2(v1[2], v1[3]);
                        *(u32x4*)(rowp + col) = o; } } }
    }
};
struct EpiRes {
    static constexpr bool PERM = true;
    const P* p; bf16_t* HB; const float* mod;
    int layer;
    __device__ __forceinline__ void operator()(const f32x4 (&acc)[2][2][4][2], const Unit& u, int wr, int wc, int fr, int fq) const {
        const int row0 = u.pm * 256 + wr * 64 + fr, col0 = u.pn * 256 + wc * 32 + 8 * fq;
        const int mi = (u.pm % 33 == 0) ? 8 : u.pm / 33;
        const float* gm = mod + (size_t)mi * 6144 + 2048;
#pragma unroll
        for (int bj = 0; bj < 2; ++bj) { const int col = col0 + bj * 128;
            const f32x4 g0 = *(const f32x4*)(gm + col), g1 = *(const f32x4*)(gm + col + 4);
#pragma unroll
            for (int ai = 0; ai < 2; ++ai)
#pragma unroll
                for (int m = 0; m < 4; ++m) { const int row = row0 + ai * 128 + m * 16;
                    float o[8];
                    if (layer == 0) { const float* xr = src_row_f32(*p, row) + col; const f32x4 a = *(const f32x4*)xr, b = *(const f32x4*)(xr + 4);
                        o[0] = a[0]; o[1] = a[1]; o[2] = a[2]; o[3] = a[3]; o[4] = b[0]; o[5] = b[1]; o[6] = b[2]; o[7] = b[3]; }
                    else { const u32x4 hv = *(const u32x4*)(HB + (size_t)row * D + col); unpack8(hv, o); }
                    const f32x4 v0 = acc[ai][bj][m][0], v1 = acc[ai][bj][m][1];
#pragma unroll
                    for (int j = 0; j < 4; ++j) { o[j] += g0[j] * v0[j]; o[4 + j] += g1[j] * v1[j]; }
                    *(u32x4*)(HB + (size_t)row * D + col) = pack8(o); } }
    }
};
struct EpiRouter {
    static constexpr bool PERM = false;
    float* SC;
    __device__ __forceinline__ void operator()(const f32x4 (&acc)[2][2][4][2], const Unit& u, int wr, int wc, int fr, int fq) const {
        if (wc >= 2) return;
        const int row0 = u.pm * 256 + wr * 64 + fr, col0 = wc * 32 + 4 * fq;
#pragma unroll
        for (int ai = 0; ai < 2; ++ai)
#pragma unroll
            for (int m = 0; m < 4; ++m)
#pragma unroll
                for (int n = 0; n < 2; ++n) { const f32x4 v = acc[ai][0][m][n]; f32x4 o;
#pragma unroll
                    for (int j = 0; j < 4; ++j) o[j] = sigmoidf_(v[j]);
                    *(f32x4*)(SC + (size_t)(row0 + ai * 128 + m * 16) * 64 + col0 + n * 16) = o; }
    }
};
struct EpiGLU {
    static constexpr bool PERM = true;
    bf16_t* H; const float* rgate;
    __device__ __forceinline__ void operator()(const f32x4 (&acc)[2][2][4][2], const Unit& u, int wr, int wc, int fr, int fq) const {
        const int row0 = u.pm * 256 + wr * 64 + fr, col0 = u.pn * 128 + wc * 32 + 8 * fq;
        float rg[8];
#pragma unroll
        for (int i = 0; i < 8; ++i) rg[i] = rgate[row0 + (i >> 2) * 128 + (i & 3) * 16];
#pragma unroll
        for (int ai = 0; ai < 2; ++ai)
#pragma unroll
            for (int m = 0; m < 4; ++m) { float o[8];
#pragma unroll
                for (int n = 0; n < 2; ++n)
#pragma unroll
                    for (int j = 0; j < 4; ++j) o[n * 4 + j] = rg[ai * 4 + m] * siluf_(acc[ai][0][m][n][j]) * acc[ai][1][m][n][j];
                *(u32x4*)(H + (size_t)(row0 + ai * 128 + m * 16) * 256 + col0) = pack8(o); }
    }
};
struct EpiMoE {
    static constexpr bool PERM = true;
    const int* rinfo; const float* mod; unsigned char* ws; int pass;
    __device__ __forceinline__ void operator()(const f32x4 (&acc)[2][2][4][2], const Unit& u, int wr, int wc, int fr, int fq) const {
        const int r0 = u.pm * 256 + wr * 64 + fr, col0 = u.pn * 256 + wc * 32 + 8 * fq;
        int inf[8];
#pragma unroll
        for (int i = 0; i < 8; ++i) inf[i] = rinfo[r0 + (i >> 2) * 128 + (i & 3) * 16];
#pragma unroll
        for (int ai = 0; ai < 2; ++ai)
#pragma unroll
            for (int m = 0; m < 4; ++m) { const int info = inf[ai * 4 + m];
                if (info >= 0) { const int tok = info >> 4, k = info & 15, j3 = k % 3;
                    const size_t boff = j3 == 0 ? OFF_HB : (j3 == 1 ? OFF_AB : OFF_B2);
                    bf16_t* dst = (bf16_t*)(ws + boff) + (size_t)tok * D + col0;
                    const float* gf = mod + (size_t)mod_idx(tok) * 6144 + 5120 + col0;
                    const bool rmw = (pass != 0) || (j3 == 0);
#pragma unroll
                    for (int bj = 0; bj < 2; ++bj) {
                        const f32x4 g0 = *(const f32x4*)(gf + bj * 128), g1 = *(const f32x4*)(gf + bj * 128 + 4);
                        float o[8];
                        if (rmw) { const u32x4 hv = *(const u32x4*)(dst + bj * 128); unpack8(hv, o); }
                        else {
#pragma unroll
                            for (int j = 0; j < 8; ++j) o[j] = 0.f; }
                        const f32x4 v0 = acc[ai][bj][m][0], v1 = acc[ai][bj][m][1];
#pragma unroll
                        for (int j = 0; j < 4; ++j) { o[j] += g0[j] * v0[j]; o[4 + j] += g1[j] * v1[j]; }
                        *(u32x4*)(dst + bj * 128) = pack8(o); } }
                asm volatile("" ::: "memory"); }
    }
};

__device__ __forceinline__ void transpose_tile(const float* src, int K, int N, bf16_t* dst, int mode, int tile, LAS float* scr) {
    const int nTn = (N + 63) / 64, kb = tile / nTn, nb = tile - kb * nTn, k0 = kb * 64, n0 = nb * 64, t = threadIdx.x;
#pragma unroll
    for (int r = 0; r < 8; ++r) { const int k = r * 8 + (t >> 6), n = t & 63; scr[k * 65 + n] = (n0 + n < N) ? src[(size_t)(k0 + k) * N + n0 + n] : 0.f; }
    __syncthreads();
    { const int n = t >> 3, kc = t & 7;
        if (n0 + n < N) { float f[8];
#pragma unroll
            for (int j = 0; j < 8; ++j) f[j] = scr[(kc * 8 + j) * 65 + n];
            const int gn = n0 + n; const int row = mode == 0 ? gn : ((gn >> 7) * 256 + (mode == 2 ? 128 : 0) + (gn & 127));
            *(u32x4*)(dst + (size_t)row * K + k0 + kc * 8) = pack8(f); } }
    __syncthreads();
}
__device__ __forceinline__ void transpose_job(const float* src, int K, int N, bf16_t* dst, int mode, LAS float* scr) {
    const int nt = (K / 64) * ((N + 63) / 64);
    for (int tile = blockIdx.x; tile < nt; tile += gridDim.x) transpose_tile(src, K, N, dst, mode, tile, scr);
}

__device__ __forceinline__ void phase_prologue(const P& p, LAS unsigned char* lds) {
    unsigned char* ws = p.ws;
    LAS float* scr = (LAS float*)lds;
    for (int l = 0; l < 2; ++l) {
        transpose_job(p.w_in + (size_t)l * D * UC, D, UC, (bf16_t*)(ws + OFF_WINT) + (size_t)l * NWIN * D, 0, scr);
        transpose_job(p.w_out + (size_t)l * D * D, D, D, (bf16_t*)(ws + OFF_WOUTT) + (size_t)l * D * D, 0, scr);
        transpose_job(p.sh_gate + (size_t)l * D * 256, D, 256, (bf16_t*)(ws + OFF_SH1T) + (size_t)l * 512 * D, 1, scr);
        transpose_job(p.sh_up + (size_t)l * D * 256, D, 256, (bf16_t*)(ws + OFF_SH1T) + (size_t)l * 512 * D, 2, scr);
        transpose_job(p.sh_down + (size_t)l * 256 * D, 256, D, (bf16_t*)(ws + OFF_SH2T) + (size_t)l * D * 256, 0, scr);
        transpose_job(p.router_w + (size_t)l * D * 64, D, 64, (bf16_t*)(ws + OFF_RT) + (size_t)l * 256 * D, 0, scr);
        { u32x4* z = (u32x4*)((bf16_t*)(ws + OFF_WINT) + ((size_t)l * NWIN + UC) * D); const int n = (NWIN - UC) * D / 8;
            for (int i = blockIdx.x * NTHR + threadIdx.x; i < n; i += gridDim.x * NTHR) z[i] = (u32x4){0u, 0u, 0u, 0u}; }
        { u32x4* z = (u32x4*)((bf16_t*)(ws + OFF_RT) + ((size_t)l * 256 + 64) * D); const int n = 192 * D / 8;
            for (int i = blockIdx.x * NTHR + threadIdx.x; i < n; i += gridDim.x * NTHR) z[i] = (u32x4){0u, 0u, 0u, 0u}; }
    }
    LAS float* sc = (LAS float*)lds;
    LAS float* part = (LAS float*)(lds + 9 * 1024 * 4);
    __syncthreads();
    for (int i = threadIdx.x; i < 9 * 1024; i += NTHR) { const int s = i >> 10, k = i & 1023; const float v = s < 8 ? p.c[s * 1024 + k] : p.c_ctx[k]; sc[i] = siluf_(v); }
    __syncthreads();
    const int w = threadIdx.x >> 6, lane = threadIdx.x & 63;
    for (int item = blockIdx.x; item < 2 * 96; item += gridDim.x) {
        const int l = item / 96, cg = item - l * 96, col = cg * 64 + lane;
        const float* wm = p.w_mod + (size_t)l * D * 6144 + col;
        float a[9];
#pragma unroll
        for (int s = 0; s < 9; ++s) a[s] = 0.f;
        for (int k = w * 128; k < w * 128 + 128; ++k) { const float wv = wm[(size_t)k * 6144];
#pragma unroll
            for (int s = 0; s < 9; ++s) a[s] += sc[s * 1024 + k] * wv; }
#pragma unroll
        for (int s = 0; s < 9; ++s) part[(w * 9 + s) * 64 + lane] = a[s];
        __syncthreads();
        for (int i = threadIdx.x; i < 9 * 64; i += NTHR) { const int s = i >> 6, ln = i & 63; float v = p.b_mod[(size_t)l * 6144 + cg * 64 + ln];
#pragma unroll
            for (int ww = 0; ww < 8; ++ww) v += part[(ww * 9 + s) * 64 + ln];
            ((float*)(ws + OFF_MOD))[((size_t)l * 9 + s) * 6144 + cg * 64 + ln] = v; }
        __syncthreads();
    }
}

__device__ __forceinline__ void phase_expert_cvt(const P& p, int l, LAS unsigned char* lds) {
    LAS float* scr = (LAS float*)lds;
    bf16_t* w1t = (bf16_t*)(p.ws + OFF_W1T); bf16_t* w2t = (bf16_t*)(p.ws + OFF_W2T);
    for (int it = blockIdx.x; it < 64 * 192; it += gridDim.x) {
        const int e = it / 192, r = it - e * 192, which = r >> 6, tile = r & 63;
        const size_t eo = ((size_t)l * 64 + e) * D * 256;
        if (which == 0) transpose_tile(p.exp_gate + eo, D, 256, w1t + (size_t)e * 512 * D, 1, tile, scr);
        else if (which == 1) transpose_tile(p.exp_up + eo, D, 256, w1t + (size_t)e * 512 * D, 2, tile, scr);
        else transpose_tile(p.exp_down + eo, 256, D, w2t + (size_t)e * D * 256, 0, tile, scr);
    }
}

template <int SRC, bool FINAL>
__device__ __forceinline__ void phase_norm(const P& p, int l, const float* normw, int sc_off, int sh_off, bool lat_only) {
    unsigned char* ws = p.ws;
    const int gw = blockIdx.x * 8 + (threadIdx.x >> 6), lane = threadIdx.x & 63;
    const bf16_t* HB = (const bf16_t*)(ws + OFF_HB); const bf16_t* B1 = (const bf16_t*)(ws + OFF_AB); const bf16_t* B2 = (const bf16_t*)(ws + OFF_B2);
    bf16_t* dst = (bf16_t*)(ws + OFF_AB);
    const float* mod = (const float*)(ws + OFF_MOD) + (size_t)l * 9 * 6144;
    float nw[16];
#pragma unroll
    for (int i = 0; i < 2; ++i)
#pragma unroll
        for (int j = 0; j < 8; ++j) nw[i * 8 + j] = normw[i * 512 + lane * 8 + j];
    for (int row = gw * 33; row < gw * 33 + 33; ++row) {
        const int b = row / TPS, pos = row - b * TPS;
        if ((lat_only || FINAL) && pos < CTXL) continue;
        float v[16];
        if (SRC == 0) { const float* xr = src_row_f32(p, row);
#pragma unroll
            for (int i = 0; i < 2; ++i) { const f32x4 a = *(const f32x4*)(xr + i * 512 + lane * 8), c = *(const f32x4*)(xr + i * 512 + lane * 8 + 4);
#pragma unroll
                for (int j = 0; j < 4; ++j) { v[i * 8 + j] = a[j]; v[i * 8 + 4 + j] = c[j]; } } }
        else {
#pragma unroll
            for (int i = 0; i < 2; ++i) { const size_t o = (size_t)row * D + i * 512 + lane * 8; float f[8]; unpack8(*(const u32x4*)(HB + o), f);
                if (SRC == 2) { float g[8], h[8]; unpack8(*(const u32x4*)(B1 + o), g); unpack8(*(const u32x4*)(B2 + o), h);
#pragma unroll
                    for (int j = 0; j < 8; ++j) f[j] += g[j] + h[j]; }
#pragma unroll
                for (int j = 0; j < 8; ++j) v[i * 8 + j] = f[j]; }
            if (SRC == 2 && !FINAL) {
#pragma unroll
                for (int i = 0; i < 2; ++i) { float f[8];
#pragma unroll
                    for (int j = 0; j < 8; ++j) f[j] = v[i * 8 + j];
                    *(u32x4*)((bf16_t*)(ws + OFF_HB) + (size_t)row * D + i * 512 + lane * 8) = pack8(f); } } }
        float ss = 0.f;
#pragma unroll
        for (int j = 0; j < 16; ++j) ss += v[j] * v[j];
        ss = wave_sum(ss);
        const float rstd = rsqrtf(ss * (1.f / D) + EPS);
        if (FINAL) { float* o = p.out + ((size_t)b * SEQ + (pos - CTXL)) * D;
#pragma unroll
            for (int i = 0; i < 2; ++i) { f32x4 a, c;
#pragma unroll
                for (int j = 0; j < 4; ++j) { a[j] = v[i * 8 + j] * rstd * nw[i * 8 + j]; c[j] = v[i * 8 + 4 + j] * rstd * nw[i * 8 + 4 + j]; }
                *(f32x4*)(o + i * 512 + lane * 8) = a; *(f32x4*)(o + i * 512 + lane * 8 + 4) = c; } }
        else { const float* mrow = mod + (size_t)(pos < CTXL ? 8 : b) * 6144;
#pragma unroll
            for (int i = 0; i < 2; ++i) { const int col = i * 512 + lane * 8; float f[8];
                const f32x4 s0 = *(const f32x4*)(mrow + sc_off + col), s1 = *(const f32x4*)(mrow + sc_off + col + 4);
                const f32x4 h0 = *(const f32x4*)(mrow + sh_off + col), h1 = *(const f32x4*)(mrow + sh_off + col + 4);
#pragma unroll
                for (int j = 0; j < 4; ++j) { f[j] = v[i * 8 + j] * rstd * nw[i * 8 + j] * (1.f + s0[j]) + h0[j]; f[4 + j] = v[i * 8 + 4 + j] * rstd * nw[i * 8 + 4 + j] * (1.f + s1[j]) + h1[j]; }
                *(u32x4*)(dst + (size_t)row * D + col) = pack8(f); } }
    }
}

__device__ __forceinline__ void prep_run(const P& p, int l, bf16_t* U, int row0, int nblk, int g, int lane) {
    int colbase, kind;
    const float* cw = nullptr; const float* cb = nullptr; int cstride = 0, cc = 0;
    if (g < 8) { kind = 0; colbase = C_X + 128 * g; cc = 128 * g + 2 * lane; cw = p.ssd_conv_w + (size_t)l * 5 * 1024; cb = p.ssd_conv_b + (size_t)l * 1024; cstride = 1024; }
    else if (g < 14) { kind = 1; colbase = C_GQ + 128 * (g - 8); cc = 128 * (g - 8) + 2 * lane; cw = p.gdn_conv_w + (size_t)l * 5 * 768; cstride = 768; }
    else if (g < 16) { kind = 2; colbase = C_HQ + 128 * (g - 14); }
    else { kind = 3; colbase = C_HF + 128 * (g - 16); cc = (128 * (g - 16) + 2 * lane) & 255; }
    bf16_t* base = U + (size_t)row0 * UC + colbase + 2 * lane;
    if (kind >= 2) {
        float lo0 = 0.f, lo1 = 0.f;
        if (kind == 3 && l == 1) { const float a0 = p.hgrn_lb[cc], a1 = p.hgrn_lb[256 + cc], b0 = p.hgrn_lb[cc + 1], b1 = p.hgrn_lb[256 + cc + 1];
            lo0 = 1.f / (1.f + __expf(a0 - a1)); lo1 = 1.f / (1.f + __expf(b0 - b1)); }
        for (int t = 0; t < nblk * 64; ++t) { unsigned* q = (unsigned*)(base + (size_t)t * UC); const unsigned v = *q; float a = bflo(v), b = bfhi(v);
            if (kind == 2) { a = siluf_(a); b = siluf_(b); } else { a = (1.f - lo0) * sigmoidf_(-a); b = (1.f - lo1) * sigmoidf_(-b); }
            *q = pk2(a, b); }
        return;
    }
    float w0[5], w1[5], bias0 = 0.f, bias1 = 0.f;
#pragma unroll
    for (int j = 0; j < 5; ++j) { w0[j] = cw[j * cstride + cc]; w1[j] = cw[j * cstride + cc + 1]; }
    if (kind == 0) { bias0 = cb[cc]; bias1 = cb[cc + 1]; }
    const bool l2 = (kind == 1) && (g < 12); const float l2s = (g < 10) ? 0.125f : 1.f;
    float pa0 = 0.f, pa1 = 0.f, pb0 = 0.f, pb1 = 0.f;
    for (int blk = 0; blk < nblk; ++blk) {
        float r0[68], r1[68];
        r0[0] = pa0; r1[0] = pa1; r0[1] = pb0; r1[1] = pb1;
        bf16_t* bb = base + (size_t)blk * 64 * UC;
#pragma unroll
        for (int t = 0; t < 64; ++t) { const unsigned v = *(const unsigned*)(bb + (size_t)t * UC); r0[2 + t] = bflo(v); r1[2 + t] = bfhi(v); }
        if (blk + 1 < nblk) {
#pragma unroll
            for (int t = 64; t < 66; ++t) { const unsigned v = *(const unsigned*)(bb + (size_t)t * UC); r0[2 + t] = bflo(v); r1[2 + t] = bfhi(v); } }
        else { r0[66] = r0[67] = r1[66] = r1[67] = 0.f; }
#pragma unroll
        for (int t = 0; t < 64; ++t) {
            float a = bias0, b = bias1;
#pragma unroll
            for (int j = 0; j < 5; ++j) { a += r0[t + j] * w0[j]; b += r1[t + j] * w1[j]; }
            a = siluf_(a); b = siluf_(b);
            if (l2) { float ss = a * a + b * b;
#pragma unroll
                for (int o = 1; o < 32; o <<= 1) ss += __shfl_xor(ss, o);
                const float f = rsqrtf(ss + 1e-6f) * l2s; a *= f; b *= f; }
            *(unsigned*)(bb + (size_t)t * UC) = pk2(a, b);
        }
        pa0 = r0[64]; pa1 = r1[64]; pb0 = r0[65]; pb1 = r1[65];
    }
}
__device__ __forceinline__ void phase_prep(const P& p, int l) {
    bf16_t* U = (bf16_t*)(p.ws + OFF_UB);
    const int gw = blockIdx.x * 8 + (threadIdx.x >> 6), lane = threadIdx.x & 63, NW = gridDim.x * 8;
    constexpr int NCTX = NBATCH * 20, NLAT = NBATCH * 128 * 20;
    for (int it = gw; it < NCTX + NLAT; it += NW) {
        if (it < NCTX) { const int b = it / 20, g = it - b * 20; prep_run(p, l, U, b * TPS, 4, g, lane); }
        else { const int j = it - NCTX, g = j % 20, rr = j / 20, b = rr >> 7, gr = rr & 127; prep_run(p, l, U, b * TPS + CTXL + gr * 64, 1, g, lane); }
    }
}

__device__ __forceinline__ int chain_row(int b, int dir, int i) { const int pos = dir == 0 ? i : (i < CTXL ? (CTXL - 1 - i) : (TPS + CTXL - 1 - i)); return b * TPS + pos; }
__device__ __forceinline__ float red8(float v) { v += __shfl_xor(v, 1); v += __shfl_xor(v, 2); v += __shfl_xor(v, 4); return v; }

__device__ __forceinline__ void scan_ssd(const P& p, int l, int b, int hd, int dir) {
    const bf16_t* U = (const bf16_t*)(p.ws + OFF_UB); bf16_t* Y = (bf16_t*)(p.ws + (dir == 0 ? OFF_AB : OFF_Y2));
    const int w = threadIdx.x >> 6, lane = threadIdx.x & 63, pl = lane >> 3, ng = lane & 7, pp = 8 * w + pl, g = hd >> 2;
    const float A = -__expf(p.ssd_a_log[(l * 2 + dir) * 8 + hd]), dtb = p.ssd_dt_bias[(l * 2 + dir) * 8 + hd], Dk = p.ssd_d[l * 8 + hd];
    float h[16];
#pragma unroll
    for (int j = 0; j < 16; ++j) h[j] = 0.f;
    const int oB = C_B + g * 128 + ng * 16, oC = C_C + g * 128 + ng * 16, oX = C_X + hd * 64 + pp, oDT = C_DT + dir * 8 + hd;
    u32x4 nB0, nB1, nC0, nC1; bf16_t nx, ndt;
    { const bf16_t* r = U + (size_t)chain_row(b, dir, 0) * UC; nB0 = *(const u32x4*)(r + oB); nB1 = *(const u32x4*)(r + oB + 8); nC0 = *(const u32x4*)(r + oC); nC1 = *(const u32x4*)(r + oC + 8); nx = r[oX]; ndt = r[oDT]; }
    for (int i = 0; i < TPS; ++i) {
        const u32x4 B0 = nB0, B1 = nB1, C0 = nC0, C1 = nC1; const float x = bf2f(nx), dtr = bf2f(ndt);
        const int row = chain_row(b, dir, i);
        if (i + 1 < TPS) { const bf16_t* r = U + (size_t)chain_row(b, dir, i + 1) * UC; nB0 = *(const u32x4*)(r + oB); nB1 = *(const u32x4*)(r + oB + 8); nC0 = *(const u32x4*)(r + oC); nC1 = *(const u32x4*)(r + oC + 8); nx = r[oX]; ndt = r[oDT]; }
        const float dt = softplusf_(dtr + dtb), a = __expf(dt * A), xdt = x * dt;
        float Bf[16], Cf[16];
        { float t8[8]; unpack8(B0, t8);
#pragma unroll
            for (int j = 0; j < 8; ++j) Bf[j] = t8[j];
            unpack8(B1, t8);
#pragma unroll
            for (int j = 0; j < 8; ++j) Bf[8 + j] = t8[j];
            unpack8(C0, t8);
#pragma unroll
            for (int j = 0; j < 8; ++j) Cf[j] = t8[j];
            unpack8(C1, t8);
#pragma unroll
            for (int j = 0; j < 8; ++j) Cf[8 + j] = t8[j]; }
        float y = 0.f;
#pragma unroll
        for (int j = 0; j < 16; ++j) { h[j] = a * h[j] + xdt * Bf[j]; y += h[j] * Cf[j]; }
        y = red8(y);
        if (dir == 0) y += Dk * x;
        if (ng == 0) Y[(size_t)row * D + hd * 64 + pp] = f2bf(y);
    }
}
__device__ __forceinline__ void scan_hgrn(const P& p, int l, int b, int hd, int dir) {
    const bf16_t* U = (const bf16_t*)(p.ws + OFF_UB); bf16_t* Y = (bf16_t*)(p.ws + (dir == 0 ? OFF_AB : OFF_Y2));
    const int w = threadIdx.x >> 6, lane = threadIdx.x & 63, vl = lane >> 3, kg = lane & 7, vv = 8 * w + vl;
    float S[8];
#pragma unroll
    for (int j = 0; j < 8; ++j) S[j] = 0.f;
    const int oQ = C_HQ + hd * 64 + kg * 8, oK = C_HF + dir * 256 + hd * 64 + kg * 8, oV = C_HI + hd * 64 + vv;
    u32x4 nq, nk; bf16_t nv;
    { const bf16_t* r = U + (size_t)chain_row(b, dir, 0) * UC; nq = *(const u32x4*)(r + oQ); nk = *(const u32x4*)(r + oK); nv = r[oV]; }
    for (int i = 0; i < TPS; ++i) {
        const u32x4 q8 = nq, k8 = nk; const float v = bf2f(nv);
        const int row = chain_row(b, dir, i);
        if (i + 1 < TPS) { const bf16_t* r = U + (size_t)chain_row(b, dir, i + 1) * UC; nq = *(const u32x4*)(r + oQ); nk = *(const u32x4*)(r + oK); nv = r[oV]; }
        float q[8], kk[8]; unpack8(q8, q); unpack8(k8, kk);
        float o = 0.f;
#pragma unroll
        for (int j = 0; j < 8; ++j) { S[j] = (1.f - kk[j]) * S[j] + kk[j] * v; o += q[j] * S[j]; }
        o = red8(o);
        if (kg == 0) Y[(size_t)row * D + 512 + hd * 64 + vv] = f2bf(o);
    }
}
__device__ __forceinline__ void scan_gdn(const P& p, int l, int b, int hd, int dir) {
    const bf16_t* U = (const bf16_t*)(p.ws + OFF_UB); bf16_t* Y = (bf16_t*)(p.ws + (dir == 0 ? OFF_AB : OFF_Y2));
    const int w = threadIdx.x >> 6, lane = threadIdx.x & 63, vl = lane >> 3, kg = lane & 7, vv = 8 * w + vl;
    const float Aa = __expf(p.gdn_a_log[(l * 2 + dir) * 4 + hd]), dtb = p.gdn_dt_bias[(l * 2 + dir) * 4 + hd];
    float M[8];
#pragma unroll
    for (int j = 0; j < 8; ++j) M[j] = 0.f;
    const int oQ = C_GQ + hd * 64 + kg * 8, oK = C_GK + hd * 64 + kg * 8, oV = C_GV + hd * 64 + vv, oA = C_GA + dir * 4 + hd, oBt = C_GB + dir * 4 + hd;
    u32x4 nq, nk; bf16_t nv, na, nb;
    { const bf16_t* r = U + (size_t)chain_row(b, dir, 0) * UC; nq = *(const u32x4*)(r + oQ); nk = *(const u32x4*)(r + oK); nv = r[oV]; na = r[oA]; nb = r[oBt]; }
    for (int i = 0; i < TPS; ++i) {
        const u32x4 q8 = nq, k8 = nk; const float v = bf2f(nv), ar = bf2f(na), br = bf2f(nb);
        const int row = chain_row(b, dir, i);
        if (i + 1 < TPS) { const bf16_t* r = U + (size_t)chain_row(b, dir, i + 1) * UC; nq = *(const u32x4*)(r + oQ); nk = *(const u32x4*)(r + oK); nv = r[oV]; na = r[oA]; nb = r[oBt]; }
        float q[8], k[8]; unpack8(q8, q); unpack8(k8, k);
        const float alpha = __expf(-Aa * softplusf_(ar + dtb)), beta = sigmoidf_(br);
        float d = 0.f;
#pragma unroll
        for (int j = 0; j < 8; ++j) { M[j] *= alpha; d += k[j] * M[j]; }
        d = red8(d);
        const float r = beta * (v - d);
        float o = 0.f;
#pragma unroll
        for (int j = 0; j < 8; ++j) { M[j] += k[j] * r; o += q[j] * M[j]; }
        o = red8(o);
        if (kg == 0) Y[(size_t)row * D + 768 + hd * 64 + vv] = f2bf(o);
    }
}
__device__ __forceinline__ void phase_scan(const P& p, int l) {
    for (int ch = blockIdx.x; ch < 256; ch += gridDim.x) {
        const int dir = ch & 1, hd16 = (ch >> 1) & 15, b = ch >> 5;
        if (hd16 < 8) scan_ssd(p, l, b, hd16, dir);
        else if (hd16 < 12) scan_hgrn(p, l, b, hd16 - 8, dir);
        else scan_gdn(p, l, b, hd16 - 12, dir);
    }
}

__device__ __forceinline__ void phase_post(const P& p, int l, bool lat_only) {
    const bf16_t* U = (const bf16_t*)(p.ws + OFF_UB); bf16_t* Y1 = (bf16_t*)(p.ws + OFF_AB); const bf16_t* Y2 = (const bf16_t*)(p.ws + OFF_Y2);
    const int gw = blockIdx.x * 8 + (threadIdx.x >> 6), lane = threadIdx.x & 63;
    const int col = 16 * lane;
    const int gc = lane < 32 ? col : (lane < 48 ? C_HG + (col - 512) : C_GG + (col - 768));
    float nw[16];
#pragma unroll
    for (int j = 0; j < 16; ++j) nw[j] = lane < 32 ? p.ssd_norm[l * 512 + col + j] : (lane < 48 ? p.hgrn_norm[l * 64 + ((col + j) & 63)] : p.gdn_norm[l * 64 + ((col + j) & 63)]);
    for (int row = gw * 33; row < gw * 33 + 33; ++row) {
        if (lat_only && (row % TPS) < CTXL) continue;
        float y[16], gt[16];
#pragma unroll
        for (int i = 0; i < 2; ++i) { float a[8], c[8], g8[8];
            unpack8(*(const u32x4*)(Y1 + (size_t)row * D + col + i * 8), a); unpack8(*(const u32x4*)(Y2 + (size_t)row * D + col + i * 8), c);
            unpack8(*(const u32x4*)(U + (size_t)row * UC + gc + i * 8), g8);
#pragma unroll
            for (int j = 0; j < 8; ++j) { y[i * 8 + j] = a[j] + c[j]; gt[i * 8 + j] = siluf_(g8[j]); } }
        if (lane < 32) {
#pragma unroll
            for (int j = 0; j < 16; ++j) y[j] *= gt[j]; }
        float ss = 0.f;
#pragma unroll
        for (int j = 0; j < 16; ++j) ss += y[j] * y[j];
        ss += __shfl_xor(ss, 1); ss += __shfl_xor(ss, 2);
        float s16 = ss; s16 += __shfl_xor(s16, 4); s16 += __shfl_xor(s16, 8);
        const float rstd = lane < 32 ? rsqrtf(s16 * (1.f / 256.f) + EPS) : rsqrtf(ss * (1.f / 64.f) + EPS);
#pragma unroll
        for (int i = 0; i < 2; ++i) { float f[8];
#pragma unroll
            for (int j = 0; j < 8; ++j) { const float t = y[i * 8 + j] * rstd * nw[i * 8 + j]; f[j] = lane < 32 ? t : t * gt[i * 8 + j]; }
            *(u32x4*)(Y1 + (size_t)row * D + col + i * 8) = pack8(f); }
    }
}

__device__ __forceinline__ void phase_topk(const P& p, int l, bool lat_only, LAS unsigned char* lds) {
    unsigned char* ws = p.ws;
    LAS int* hist = (LAS int*)lds;
    for (int i = threadIdx.x; i < 256; i += NTHR) hist[i] = 0;
    __syncthreads();
    const int t = threadIdx.x;
    if (t < 264) {
        const int row = blockIdx.x * 264 + t;
        const bool active = !(lat_only && (row % TPS) < CTXL);
        if (active) {
            const float* sp = (const float*)(ws + OFF_SC) + (size_t)row * 64;
            float sc[64], sel[64];
#pragma unroll
            for (int i = 0; i < 16; ++i) { const f32x4 v = *(const f32x4*)(sp + 4 * i); sc[4 * i] = v[0]; sc[4 * i + 1] = v[1]; sc[4 * i + 2] = v[2]; sc[4 * i + 3] = v[3]; }
#pragma unroll
            for (int e = 0; e < 64; ++e) sel[e] = sc[e] + p.router_bias[l * 64 + e];
            int idx[8]; float gv[8]; float gs = 0.f;
#pragma unroll
            for (int r = 0; r < 8; ++r) { float best = -3.0e38f, bs = 0.f; int bi = 0;
#pragma unroll
                for (int e = 0; e < 64; ++e) { const bool gt = sel[e] > best; best = gt ? sel[e] : best; bs = gt ? sc[e] : bs; bi = gt ? e : bi; }
#pragma unroll
                for (int e = 0; e < 64; ++e) sel[e] = (e == bi) ? -3.0e38f : sel[e];
                idx[r] = bi; gv[r] = bs; gs += bs; }
            const float inv = 2.5f / gs;
            int* te = (int*)(ws + OFF_TOKE) + (size_t)row * 8; float* tg = (float*)(ws + OFF_TOKG) + (size_t)row * 8; int* tl = (int*)(ws + OFF_TOKLR) + (size_t)row * 12;
#pragma unroll
            for (int r = 0; r < 8; ++r) { const int s = (r / 3) * 64 + idx[r]; const int lr = atomicAdd((int*)&hist[s], 1); te[r] = idx[r]; tg[r] = gv[r] * inv; tl[r] = lr; }
            tl[8] = atomicAdd((int*)&hist[192], 1);
        }
    }
    __syncthreads();
    for (int i = threadIdx.x; i < 256; i += NTHR) ((int*)(ws + OFF_BCNT))[blockIdx.x * 256 + i] = (i < NSEG) ? hist[i] : 0;
}
__device__ __forceinline__ void phase_lists(const P& p, int l, bool lat_only, LAS unsigned char* lds) {
    unsigned char* ws = p.ws;
    LAS int* tot = (LAS int*)lds; LAS int* base = tot + 256; LAS int* segp = base + 256;
    const int* bc = (const int*)(ws + OFF_BCNT);
    const int t = threadIdx.x;
    if (t < 256) { int a = 0, bs = 0; for (int bb = 0; bb < (int)gridDim.x; ++bb) { const int v = bc[bb * 256 + t]; if (bb < (int)blockIdx.x) bs += v; a += v; } tot[t] = a; base[t] = bs; }
    __syncthreads();
    if (t == 0) { int acc = 0; for (int s = 0; s < NSEG; ++s) { segp[s] = acc; acc += (tot[s] + 255) >> 8; } segp[NSEG] = acc; }
    __syncthreads();
    int* rinfo = (int*)(ws + OFF_RINFO); float* rgate = (float*)(ws + OFF_RGATE);
    if (t < 264) {
        const int row = blockIdx.x * 264 + t;
        const bool active = !(lat_only && (row % TPS) < CTXL);
        if (active) {
            const int* te = (const int*)(ws + OFF_TOKE) + (size_t)row * 8; const float* tg = (const float*)(ws + OFF_TOKG) + (size_t)row * 8; const int* tl = (const int*)(ws + OFF_TOKLR) + (size_t)row * 12;
#pragma unroll
            for (int r = 0; r < 8; ++r) { const int s = (r / 3) * 64 + te[r]; const int slot = 256 * segp[s] + base[s] + tl[r]; rinfo[slot] = row * 16 + r; rgate[slot] = tg[r]; }
            const int slot = 256 * segp[192] + base[192] + tl[8]; rinfo[slot] = row * 16 + 8; rgate[slot] = 1.f;
        }
    }
    for (int s = blockIdx.x; s < NSEG; s += gridDim.x) { const int n = tot[s], e = ((n + 255) >> 8) << 8; for (int r = n + t; r < e; r += NTHR) { rinfo[256 * segp[s] + r] = -1; rgate[256 * segp[s] + r] = 0.f; } }
    if (blockIdx.x == 0 && t <= NSEG) ((int*)(ws + OFF_SEGP))[t] = segp[t];
}
__device__ __forceinline__ const LAS int* load_segp(const P& p, LAS unsigned char* lds) {
    LAS int* segp = (LAS int*)(lds + LDS_TAB);
    __syncthreads();
    if (threadIdx.x <= NSEG) segp[threadIdx.x] = ((const int*)(p.ws + OFF_SEGP))[threadIdx.x];
    __syncthreads();
    return segp;
}

enum { PH_PRO = 0, PH_NORM1, PH_WIN, PH_PREP, PH_SCAN, PH_POST, PH_WOUT, PH_NORM2, PH_ROUTER, PH_TOPK, PH_LISTS, PH_S1, PH_S2A, PH_S2B, PH_S2C, PH_FINAL };

template <int PH>
__device__ __forceinline__ void run_phase(const P& p, const int l, LAS unsigned char* lds) {
    unsigned char* ws = p.ws;
    const float* mod = (const float*)(ws + OFF_MOD) + (size_t)l * 9 * 6144;
    const bool lat_only = (l == 1);
    if constexpr (PH == PH_PRO) phase_prologue(p, lds);
    if constexpr (PH == PH_NORM1) { if (l == 0) phase_norm<0, false>(p, l, p.norm_mix + l * D, 1024, 0, false); else phase_norm<2, false>(p, l, p.norm_mix + l * D, 1024, 0, false); }
    if constexpr (PH == PH_WIN) { SchedDense S{(const bf16_t*)(ws + OFF_WINT) + (size_t)l * NWIN * D, D, NWIN / 256, NPAN * (NWIN / 256), (int)gridDim.x, (int)blockIdx.x, 0};
        EpiU E{(bf16_t*)(ws + OFF_UB)}; pg8::gemm_phase(lds, (const bf16_t*)(ws + OFF_AB), D, S, E); }
    if constexpr (PH == PH_PREP) phase_prep(p, l);
    if constexpr (PH == PH_SCAN) phase_scan(p, l);
    if constexpr (PH == PH_POST) phase_post(p, l, lat_only);
    if constexpr (PH == PH_WOUT) { SchedDense S{(const bf16_t*)(ws + OFF_WOUTT) + (size_t)l * D * D, D, 4, (lat_only ? 256 : NPAN) * 4, (int)gridDim.x, (int)blockIdx.x, lat_only ? 1 : 0};
        EpiRes E{&p, (bf16_t*)(ws + OFF_HB), mod, l}; pg8::gemm_phase(lds, (const bf16_t*)(ws + OFF_AB), D, S, E);
        __syncthreads(); phase_expert_cvt(p, l, lds); }
    if constexpr (PH == PH_NORM2) phase_norm<1, false>(p, l, p.norm_ffn + l * D, 4096, 3072, lat_only);
    if constexpr (PH == PH_ROUTER) { SchedDense S{(const bf16_t*)(ws + OFF_RT) + (size_t)l * 256 * D, D, 1, (lat_only ? 256 : NPAN), (int)gridDim.x, (int)blockIdx.x, lat_only ? 1 : 0};
        EpiRouter E{(float*)(ws + OFF_SC)}; pg8::gemm_phase(lds, (const bf16_t*)(ws + OFF_AB), D, S, E); }
    if constexpr (PH == PH_TOPK) phase_topk(p, l, lat_only, lds);
    if constexpr (PH == PH_LISTS) phase_lists(p, l, lat_only, lds);
    if constexpr (PH == PH_S1) { const LAS int* segp = load_segp(p, lds);
        SchedS1 S{segp, (const int*)(ws + OFF_RINFO), (const bf16_t*)(ws + OFF_W1T), (const bf16_t*)(ws + OFF_SH1T) + (size_t)l * 512 * D, 2 * segp[NSEG], (int)gridDim.x, (int)blockIdx.x};
        EpiGLU E{(bf16_t*)(ws + OFF_HACT), (const float*)(ws + OFF_RGATE)}; pg8::gemm_phase(lds, (const bf16_t*)(ws + OFF_AB), D, S, E); }
    if constexpr (PH == PH_S2A || PH == PH_S2B || PH == PH_S2C) { constexpr int pass = PH - PH_S2A; const LAS int* segp = load_segp(p, lds);
        const int P0 = segp[64 * pass], P1 = pass < 2 ? segp[64 * pass + 64] : segp[NSEG];
        SchedS2 S{segp, (const bf16_t*)(ws + OFF_W2T), (const bf16_t*)(ws + OFF_SH2T) + (size_t)l * D * 256, P0, 4 * (P1 - P0), (int)gridDim.x, (int)blockIdx.x};
        EpiMoE E{(const int*)(ws + OFF_RINFO), mod, ws, pass};
        pg8::gemm_phase(lds, (const bf16_t*)(ws + OFF_HACT), 256, S, E); }
    if constexpr (PH == PH_FINAL) phase_norm<2, true>(p, l, p.norm_final, 0, 0, true);
}

template <int PH>
__global__ void __launch_bounds__(NTHR, 2) k_phase(P p, int l) {
    extern __shared__ __attribute__((aligned(16))) unsigned char smem[];
    run_phase<PH>(p, l, (LAS unsigned char*)smem);
}

#if MK_ONE_LAUNCH
__global__ void __launch_bounds__(NTHR, 2) k_mega(P p) {
    extern __shared__ __attribute__((aligned(16))) unsigned char smem[];
    LAS unsigned char* lds = (LAS unsigned char*)smem;
    if (threadIdx.x < 4) ((LAS unsigned*)(lds + LDS_BARW))[threadIdx.x] = 0u;
    __syncthreads();
    XcdBarrier bar = xcd_barrier_post((unsigned*)(p.ws + OFF_BAR), (volatile LAS unsigned*)(lds + LDS_BARW));
    run_phase<PH_PRO>(p, 0, lds); xcd_barrier(bar);
    for (int l = 0; l < 2; ++l) {
        run_phase<PH_NORM1>(p, l, lds); xcd_barrier(bar);
        run_phase<PH_WIN>(p, l, lds); xcd_barrier(bar);
        run_phase<PH_PREP>(p, l, lds); xcd_barrier(bar);
        run_phase<PH_SCAN>(p, l, lds); xcd_barrier(bar);
        run_phase<PH_POST>(p, l, lds); xcd_barrier(bar);
        run_phase<PH_WOUT>(p, l, lds); xcd_barrier(bar);
        run_phase<PH_NORM2>(p, l, lds); xcd_barrier(bar);
        run_phase<PH_ROUTER>(p, l, lds); xcd_barrier(bar);
        run_phase<PH_TOPK>(p, l, lds); xcd_barrier(bar);
        run_phase<PH_LISTS>(p, l, lds); xcd_barrier(bar);
        run_phase<PH_S1>(p, l, lds); xcd_barrier(bar);
        run_phase<PH_S2A>(p, l, lds); xcd_barrier(bar);
        run_phase<PH_S2B>(p, l, lds); xcd_barrier(bar);
        run_phase<PH_S2C>(p, l, lds); xcd_barrier(bar);
    }
    run_phase<PH_FINAL>(p, 1, lds);
}
#endif

template <int PH> static void launch_phase(const P& p, int l, hipStream_t stream) {
    static bool attr = false;
    if (!attr) { (void)hipFuncSetAttribute((const void*)k_phase<PH>, hipFuncAttributeMaxDynamicSharedMemorySize, LDS_BYTES); attr = true; }
    hipLaunchKernelGGL(k_phase<PH>, dim3(GRID), dim3(NTHR), LDS_BYTES, stream, p, l);
}

extern "C" void kernel_launch(void* const* d_in, const int* in_sizes, int n_in, void* d_out, int out_size, void* d_ws, size_t ws_size, hipStream_t stream) {
    if (n_in != 31 || ws_size < WS_END || out_size != NBATCH * SEQ * D) { fprintf(stderr, "kernel_launch: unexpected shapes: n_in %d ws %zu (need %zu) out %d\n", n_in, ws_size, (size_t)WS_END, out_size); return; }
    P p{};
    const float** f = (const float**)&p;
    for (int i = 0; i < 31; ++i) f[i] = (const float*)d_in[i];
    p.out = (float*)d_out; p.ws = (unsigned char*)d_ws;
#if MK_ONE_LAUNCH
    static bool attr = false;
    if (!attr) { (void)hipFuncSetAttribute((const void*)k_mega, hipFuncAttributeMaxDynamicSharedMemorySize, LDS_BYTES); attr = true; }
    (void)hipMemsetAsync(d_ws, 0, XCD_BAR_WORDS * sizeof(unsigned), stream);
    hipLaunchKernelGGL(k_mega, dim3(GRID), dim3(NTHR), LDS_BYTES, stream, p);
#else
    launch_phase<PH_PRO>(p, 0, stream);
    for (int l = 0; l < 2; ++l) {
        launch_phase<PH_NORM1>(p, l, stream); launch_phase<PH_WIN>(p, l, stream); launch_phase<PH_PREP>(p, l, stream); launch_phase<PH_SCAN>(p, l, stream);
        launch_phase<PH_POST>(p, l, stream); launch_phase<PH_WOUT>(p, l, stream); launch_phase<PH_NORM2>(p, l, stream); launch_phase<PH_ROUTER>(p, l, stream);
        launch_phase<PH_TOPK>(p, l, stream); launch_phase<PH_LISTS>(p, l, stream); launch_phase<PH_S1>(p, l, stream);
        launch_phase<PH_S2A>(p, l, stream); launch_phase<PH_S2B>(p, l, stream); launch_phase<PH_S2C>(p, l, stream);
    }
    launch_phase<PH_FINAL>(p, 1, stream);
#endif
}
```

```cpp
#include <hip/hip_runtime.h>
#include <stdint.h>
#include <stdio.h>

#ifndef MK_ONE_LAUNCH
#define MK_ONE_LAUNCH 1
#endif

#define LAS __attribute__((address_space(3)))
typedef unsigned short bf16_t;
typedef short bf16x8 __attribute__((ext_vector_type(8)));
typedef float f32x4 __attribute__((ext_vector_type(4)));
typedef unsigned u32x4 __attribute__((ext_vector_type(4)));
typedef unsigned u32x2 __attribute__((ext_vector_type(2)));

constexpr int D = 1024, NBATCH = 8, SEQ = 8192, CTXL = 256, TPS = SEQ + CTXL;
constexpr int NROW = NBATCH * TPS;
constexpr int NPAN = NROW / 256;
constexpr int UC = 3872;
constexpr int NWIN = 4096;
constexpr int GRID = 256, NTHR = 512;
constexpr float EPS = 1e-6f;
constexpr int C_Z = 0, C_X = 512, C_B = 1024, C_C = 1280, C_DT = 1536;
constexpr int C_HQ = 1552, C_HF = 1808, C_HI = 2320, C_HG = 2576;
constexpr int C_GQ = 2832, C_GK = 3088, C_GV = 3344, C_GA = 3600, C_GB = 3608, C_GG = 3616;
constexpr int NSEG = 65;
constexpr int MAXPROWS = 9 * NROW + NSEG * 256;
static_assert(MAXPROWS / 256 <= 4096, "panel table");

constexpr size_t al256(size_t x) { return (x + 255) & ~(size_t)255; }
constexpr size_t OFF_BAR = 0;
constexpr size_t OFF_CVTQ = 14336;
constexpr size_t OFF_MOD = 16384;
constexpr size_t OFF_WINT = al256(OFF_MOD + (size_t)2 * 9 * 6144 * 4);
constexpr size_t OFF_WOUTT = OFF_WINT + (size_t)2 * NWIN * D * 2;
constexpr size_t OFF_SH1T = OFF_WOUTT + (size_t)2 * D * D * 2;
constexpr size_t OFF_SH2T = OFF_SH1T + (size_t)2 * 512 * D * 2;
constexpr size_t OFF_RT = OFF_SH2T + (size_t)2 * D * 256 * 2;
constexpr size_t OFF_SCL = OFF_RT + (size_t)2 * 256 * D * 2;
constexpr size_t SCL_BYTES = (size_t)2 << 20;
constexpr size_t ACT_BYTES = (size_t)NROW * D * 2;
constexpr size_t OFF_HB = OFF_SCL + SCL_BYTES;
constexpr size_t OFF_AB = OFF_HB + ACT_BYTES;
constexpr size_t OFF_Y2 = OFF_AB + ACT_BYTES;
constexpr size_t OFF_UB = OFF_Y2 + ACT_BYTES;
constexpr size_t UB_BYTES = (size_t)NROW * UC * 2;
constexpr size_t OFF_XW = OFF_UB + UB_BYTES;
constexpr size_t OFF_W1T = OFF_XW;
constexpr size_t OFF_W2T = OFF_W1T + (size_t)64 * 512 * D * 2;
constexpr size_t WS_END = OFF_W2T + (size_t)64 * D * 256 * 2;
constexpr size_t OFF_F8 = OFF_Y2;
constexpr size_t OFF_SEGP = OFF_UB;
constexpr size_t OFF_RINFO = OFF_SEGP + 1024;
constexpr size_t OFF_RGATE = al256(OFF_RINFO + (size_t)MAXPROWS * 4);
constexpr size_t OFF_HACT = al256(OFF_RGATE + (size_t)MAXPROWS * 4);
constexpr size_t OFF_SLOTU = al256(OFF_HACT + (size_t)MAXPROWS * 256);
constexpr size_t SLOT_BYTES = (size_t)NROW * D;
static_assert(OFF_SLOTU + 5 * SLOT_BYTES <= OFF_XW, "MoE scratch overflow");
constexpr size_t OFF_SC = OFF_SLOTU;
constexpr size_t OFF_TOKE = OFF_SC + (size_t)NROW * 64 * 4;
constexpr size_t OFF_TOKG = OFF_TOKE + (size_t)NROW * 8 * 4;
constexpr size_t OFF_TOKLR = OFF_TOKG + (size_t)NROW * 8 * 4;
constexpr size_t OFF_BCNT = OFF_TOKLR + (size_t)NROW * 12 * 4;
static_assert(WS_END < ((size_t)1 << 32), "32-bit workspace offsets");
constexpr float SLOT_SCALE = 32.f;
constexpr float HACT_SCALE = 8.f, W2_SCALE = 4.f;
static_assert(HACT_SCALE * W2_SCALE == SLOT_SCALE, "slot scale");
__host__ __device__ constexpr size_t slot_off(int k) { return k == 0 ? OFF_AB + SLOT_BYTES : (k < 3 ? OFF_Y2 + (size_t)(k - 1) * SLOT_BYTES : OFF_SLOTU + (size_t)(k - 3) * SLOT_BYTES); }

constexpr int SCL_WIN = 0;
constexpr int SCL_WOUT = SCL_WIN + 2 * 4096;
constexpr int SCL_SH1 = SCL_WOUT + 2 * 1024;
constexpr int SCL_W1 = SCL_SH1 + 2 * 512;
constexpr int SCL_RA = SCL_W1 + 64 * 512;
constexpr int SCL_RF = SCL_RA + NROW;
constexpr int SCL_RY = SCL_RF + NROW;
static_assert((size_t)(SCL_RY + NROW) * 4 <= SCL_BYTES, "scale region overflow");
constexpr int LDS_STAGE = 131072;
constexpr int LDS_BARW = LDS_STAGE;
constexpr int LDS_TAB = LDS_STAGE + 1024;
constexpr int LDS_XS = LDS_STAGE + 2048;
constexpr int XS_WAVE = 2304;
constexpr int LDS_AUX = LDS_XS + 8 * XS_WAVE;
constexpr int LDS_SEGT = LDS_AUX + 4096;
constexpr int LDS_BYTES = LDS_SEGT + 4096;

struct P {
    const float *x, *c, *ctx, *c_ctx, *w_mod, *b_mod, *norm_mix, *w_in, *ssd_conv_w, *ssd_conv_b, *ssd_dt_bias, *ssd_a_log, *ssd_d, *ssd_norm,
        *hgrn_lb, *hgrn_norm, *gdn_conv_w, *gdn_dt_bias, *gdn_a_log, *gdn_norm, *w_out, *norm_ffn, *router_w, *router_bias, *exp_gate, *exp_up,
        *exp_down, *sh_gate, *sh_up, *sh_down, *norm_final;
    float* out;
    unsigned char* ws;
};

__device__ __forceinline__ float bf2f(bf16_t v) { return __uint_as_float((unsigned)v << 16); }
__device__ __forceinline__ float bflo(unsigned v) { return __uint_as_float(v << 16); }
__device__ __forceinline__ float bfhi(unsigned v) { return __uint_as_float(v & 0xffff0000u); }
typedef float f32x2_t __attribute__((ext_vector_type(2)));
typedef __bf16 bf16x2_t __attribute__((ext_vector_type(2)));
__device__ __forceinline__ unsigned pk2(float lo, float hi) { const f32x2_t v = {lo, hi}; const bf16x2_t b = __builtin_convertvector(v, bf16x2_t); return __builtin_bit_cast(unsigned, b); }
__device__ __forceinline__ unsigned pk4_fp8(float a, float b, float c, float d) { int w = 0; w = __builtin_amdgcn_cvt_pk_fp8_f32(a, b, w, false); w = __builtin_amdgcn_cvt_pk_fp8_f32(c, d, w, true); return (unsigned)w; }
__device__ __forceinline__ u32x2 pack8_fp8(const float (&f)[8], float sc) { u32x2 o; o.x = pk4_fp8(f[0] * sc, f[1] * sc, f[2] * sc, f[3] * sc); o.y = pk4_fp8(f[4] * sc, f[5] * sc, f[6] * sc, f[7] * sc); return o; }
__device__ __forceinline__ unsigned pk4_i8(float a, float b, float c, float d, float inv) {
    unsigned w = 0;
    w = __builtin_amdgcn_cvt_pk_u8_f32(__builtin_rintf(a * inv) + 128.f, 0, w); w = __builtin_amdgcn_cvt_pk_u8_f32(__builtin_rintf(b * inv) + 128.f, 1, w);
    w = __builtin_amdgcn_cvt_pk_u8_f32(__builtin_rintf(c * inv) + 128.f, 2, w); w = __builtin_amdgcn_cvt_pk_u8_f32(__builtin_rintf(d * inv) + 128.f, 3, w);
    return w ^ 0x80808080u; }
__device__ __forceinline__ u32x2 pack8_i8(const float (&f)[8], float inv) { u32x2 o; o.x = pk4_i8(f[0], f[1], f[2], f[3], inv); o.y = pk4_i8(f[4], f[5], f[6], f[7], inv); return o; }
__device__ __forceinline__ float wave_max(float v) {
#pragma unroll
    for (int o = 1; o < 64; o <<= 1) v = fmaxf(v, __shfl_xor(v, o));
    return v;
}
__device__ __forceinline__ bf16_t f2bf(float f) { return (bf16_t)(pk2(f, 0.f) & 0xffffu); }
__device__ __forceinline__ float sigmoidf_(float x) { return __builtin_amdgcn_rcpf(1.f + __expf(-x)); }
__device__ __forceinline__ float siluf_(float x) { return x * __builtin_amdgcn_rcpf(1.f + __expf(-x)); }
__device__ __forceinline__ float softplusf_(float x) { return fmaxf(x, 0.f) + log1pf(__expf(-fabsf(x))); }
__device__ __forceinline__ int opaque_tid() { int t = threadIdx.x; asm volatile("" : "+v"(t)); return t; }
__device__ __forceinline__ float wave_sum(float v) {
#pragma unroll
    for (int o = 1; o < 64; o <<= 1) v += __shfl_xor(v, o);
    return v;
}
__device__ __forceinline__ int row_b(int row) { return row / TPS; }
__device__ __forceinline__ int row_pos(int row) { return row % TPS; }
__device__ __forceinline__ int mod_idx(int row) { return (row % TPS) < CTXL ? 8 : row / TPS; }
__device__ __forceinline__ const float* src_row_f32(const P& p, int row) {
    const int b = row / TPS, pos = row - b * TPS;
    return pos < CTXL ? p.ctx + ((size_t)b * CTXL + pos) * D : p.x + ((size_t)b * SEQ + (pos - CTXL)) * D;
}
__device__ __forceinline__ void unpack8(const u32x4 v, float (&f)[8]) {
    f[0] = bflo(v.x); f[1] = bfhi(v.x); f[2] = bflo(v.y); f[3] = bfhi(v.y); f[4] = bflo(v.z); f[5] = bfhi(v.z); f[6] = bflo(v.w); f[7] = bfhi(v.w);
}
__device__ __forceinline__ u32x4 pack8(const float (&f)[8]) { u32x4 o; o.x = pk2(f[0], f[1]); o.y = pk2(f[2], f[3]); o.z = pk2(f[4], f[5]); o.w = pk2(f[6], f[7]); return o; }

#define GAS __attribute__((address_space(1)))
template <class T> __device__ __forceinline__ T* launder_ptr(T* ptr) { unsigned long long v = (unsigned long long)ptr; asm volatile("" : "+s"(v)); return (T*)(GAS T*)v; }
#define XB_TMO      128
#define XB_XCNT(j)  (256  + 64 * (j))
#define XB_XSUB(j)  (1280 + 64 * (j))
#define XB_XGEN(j)  (2304 + 64 * (j))
#define XB_TOP      3328
#define XB_TOPGEN   3392
#define XCD_BAR_WORDS 3456
#define XB_SPIN_CAP (1u << 18)
__device__ __forceinline__ unsigned xb_ld(unsigned* p)              { return __hip_atomic_load(p, __ATOMIC_RELAXED, __HIP_MEMORY_SCOPE_AGENT); }
__device__ __forceinline__ unsigned xb_add(unsigned* p, unsigned v) { return __hip_atomic_fetch_add(p, v, __ATOMIC_RELAXED, __HIP_MEMORY_SCOPE_AGENT); }
__device__ __forceinline__ unsigned xb_xcc_id() { return (unsigned)__builtin_amdgcn_s_getreg((3 << 11) | 20) & 0xFu; }
#define XB_SPIN(cond, bar) do { unsigned _sp = 0; while (cond) { __builtin_amdgcn_s_sleep(1); \
    if ((++_sp & 255u) == 0u) { if (xb_ld(&(bar)[XB_TMO])) break; if (_sp > XB_SPIN_CAP) { atomicAdd(&(bar)[XB_TMO], 1u); break; } } } } while (0)
struct XcdBarrier { unsigned* bar; unsigned x; volatile LAS unsigned* st; };
__device__ __forceinline__ XcdBarrier xcd_barrier_post(unsigned* bar, volatile LAS unsigned* st) {
    XcdBarrier b; b.bar = bar; b.x = xb_xcc_id(); b.st = st;
    if (threadIdx.x == 0) (void)xb_add(&bar[XB_XCNT(b.x)], 1u);
    return b;
}
__device__ __forceinline__ void xcd_barrier_complete(unsigned* bar, unsigned x, unsigned& nloc, unsigned& nx) {
    const unsigned G = gridDim.x * gridDim.y * gridDim.z;
    unsigned sum, cnt, mine, sp = 0u;
    for (;;) {
        sum = 0u; cnt = 0u; mine = 0u;
#pragma unroll
        for (unsigned j = 0; j < 16; ++j) { const unsigned c = xb_ld(&bar[XB_XCNT(j)]); sum += c; cnt += (c > 0u) ? 1u : 0u; mine = (j == x) ? c : mine; }
        if (sum == G) break;
        __builtin_amdgcn_s_sleep(1);
        if ((++sp & 255u) == 0u) { if (xb_ld(&bar[XB_TMO])) break; if (sp > XB_SPIN_CAP) { atomicAdd(&bar[XB_TMO], 1u); break; } }
    }
    nloc = mine > 0u ? mine : 1u; nx = cnt > 0u ? cnt : 1u;
}
__device__ __forceinline__ void xcd_barrier(const XcdBarrier& b) {
    asm volatile("s_waitcnt vmcnt(0)" ::: "memory");
    __syncthreads();
    if (threadIdx.x == 0) {
        unsigned* bar = launder_ptr(b.bar);
        __builtin_amdgcn_s_waitcnt(0);
        const unsigned bx = xb_xcc_id();
        unsigned nloc = b.st[0], nx = b.st[1];
        if (nloc == 0u) { xcd_barrier_complete(bar, bx, nloc, nx); b.st[0] = nloc; b.st[1] = nx; }
        const unsigned old = xb_add(&bar[XB_XSUB(bx)], 1u);
        const unsigned gen = old / nloc;
        if (old + 1u == (gen + 1u) * nloc) {
            __builtin_amdgcn_fence(__ATOMIC_RELEASE, "agent");
            asm volatile("s_waitcnt vmcnt(0)" ::: "memory");
            const unsigned og = xb_add(&bar[XB_TOP], 1u);
            const unsigned tg = og / nx;
            if (og + 1u == (tg + 1u) * nx) xb_add(&bar[XB_TOPGEN], 1u);
            else XB_SPIN(xb_ld(&bar[XB_TOPGEN]) == tg, bar);
            __builtin_amdgcn_fence(__ATOMIC_ACQUIRE, "agent");
            xb_add(&bar[XB_XGEN(bx)], 1u);
            asm volatile("s_waitcnt vmcnt(0)" ::: "memory");
        } else {
            XB_SPIN(xb_ld(&bar[XB_XGEN(bx)]) == gen, bar);
            __builtin_amdgcn_fence(__ATOMIC_ACQUIRE, "agent");
            asm volatile("s_waitcnt vmcnt(0)" ::: "memory");
        }
    }
    __syncthreads();
}

namespace pg8 {
constexpr int BM = 256, BK = 64, HALF = 128, HTB = HALF * BK * 2, STAGE_BYTES = 8 * HTB;
__device__ __forceinline__ int lds_byte(int r, int c) { const int st = (r >> 4) * 2 + (c >> 5), rr = r & 15, cc = c & 31, ob = rr * 64 + cc * 2; return st * 1024 + (ob ^ (((ob >> 9) & 1) << 5)); }
__device__ __forceinline__ void stage_rc(int b, int& R, int& C) { const int st = b / 1024, sb = b % 1024, swz = sb ^ (((sb >> 9) & 1) << 5); R = (st >> 1) * 16 + swz / 64; C = (st & 1) * 32 + (swz % 64) / 2; }
__device__ __forceinline__ int perm32(int rho) { const int n = rho >> 4, i = rho & 15; return 8 * (i >> 2) + 4 * n + (i & 3); }
constexpr bool GEMM_SP2 = true;
constexpr bool GEMM_ALIGN = true;
struct Unit { int pm, pn, aux; };
typedef int i32x8 __attribute__((ext_vector_type(8)));
typedef int i32x8a __attribute__((ext_vector_type(8), aligned(16)));
typedef int i32x4 __attribute__((ext_vector_type(4)));
__device__ __forceinline__ i32x8 cat8(const bf16x8 lo, const bf16x8 hi) { const i32x4 a = __builtin_bit_cast(i32x4, lo), b = __builtin_bit_cast(i32x4, hi); return (i32x8){a[0], a[1], a[2], a[3], b[0], b[1], b[2], b[3]}; }
constexpr float W8_SCALE = 16.f;

template <class Epi, class Sched, int MODE = 0, bool SP2 = GEMM_SP2, bool ALIGN_EPI = GEMM_ALIGN>
__device__ __forceinline__ void gemm_phase(LAS unsigned char* lds, const void* Abase, const int K, const Sched& S, const Epi& E) {
    const int tid = opaque_tid(), wid = __builtin_amdgcn_readfirstlane(tid >> 6), lane = tid & 63, wr = wid >> 2, wc = wid & 3, fr = lane & 15, fq = lane >> 4;
    constexpr bool FP8 = (MODE == 1); constexpr int ESZ = MODE ? 1 : 2;
    const int nt = K * ESZ / (BK * 2);
    constexpr int PM = (int)Epi::PERM;
    unsigned voffB[2], voffB1[2];
#pragma unroll
    for (int i = 0; i < 2; ++i) { int R, C; stage_rc(tid * 16 + i * 8192, R, C);
        if constexpr (PM == 2) { const int w_ = R >> 5, n_ = (R >> 4) & 1, i_ = R & 15, rb = 64 * w_ + 16 * (i_ >> 2) + 4 * n_ + (i_ & 3);
            voffB[i] = (unsigned)(rb * K * ESZ + C * 2); voffB1[i] = (unsigned)((rb + 8) * K * ESZ + C * 2); }
        else { const int Rb = PM ? ((R & ~31) + perm32(R & 31)) : R;
            voffB[i] = (unsigned)(Rb * K * ESZ + C * 2); voffB1[i] = 0u; } }
    const size_t kstep = (size_t)(BK * 2);
    const size_t hstep = PM == 2 ? (size_t)0 : (size_t)HALF * K * ESZ;
#define PG8_VB1 (PM == 2 ? voffB1 : voffB)
    const unsigned ldsw = (unsigned)wid * 1024u;
    const int aoff = lds_byte(wr * 64 + fr, fq * 8), boff = lds_byte(wc * 32 + fr, fq * 8);
#define PG8_SA(b, h) (((b) * 2 + (h)) * HTB)
#define PG8_SB(b, h) ((4 + (b) * 2 + (h)) * HTB)
#define PG8_STAGE(bufoff, gbase, voff) do { _Pragma("unroll") for (int _i = 0; _i < 2; ++_i) \
        __builtin_amdgcn_global_load_lds((const unsigned*)((const char*)(gbase) + (voff)[_i]), (LAS unsigned*)(lds + (bufoff) + ldsw + _i * 8192), 16, 0, 0); } while (0)
#define PG8_LDA(dst, b, h) do { _Pragma("unroll") for (int m = 0; m < 4; ++m) { \
        if constexpr (FP8) dst##8[m] = cat8(*(const LAS bf16x8*)(lds + PG8_SA(b, h) + aoff + m * 2048), *(const LAS bf16x8*)(lds + PG8_SA(b, h) + aoff + m * 2048 + 1024));   \
        else { _Pragma("unroll") for (int k = 0; k < 2; ++k) dst[m][k] = *(const LAS bf16x8*)(lds + PG8_SA(b, h) + aoff + m * 2048 + k * 1024); } } } while (0)
#define PG8_LDB(dst, b, h) do { _Pragma("unroll") for (int n = 0; n < 2; ++n) { \
        if constexpr (FP8) dst##8[n] = cat8(*(const LAS bf16x8*)(lds + PG8_SB(b, h) + boff + n * 2048), *(const LAS bf16x8*)(lds + PG8_SB(b, h) + boff + n * 2048 + 1024)); \
        else { _Pragma("unroll") for (int k = 0; k < 2; ++k) dst[n][k] = *(const LAS bf16x8*)(lds + PG8_SB(b, h) + boff + n * 2048 + k * 1024); } } } while (0)
#define PG8_MMA(ai, bj, At, Bt) do { __builtin_amdgcn_s_setprio(1); _Pragma("unroll") for (int m = 0; m < 4; ++m) _Pragma("unroll") for (int n = 0; n < 2; ++n) { \
        if constexpr (FP8) asm volatile("v_mfma_f32_16x16x128_f8f6f4 %0, %1, %2, %0" : "+v"(acc[ai][bj][m][n]) : "v"(Bt##8[n]), "v"(At##8[m]));   \
        else if constexpr (MODE == 2) { _Pragma("unroll") for (int k = 0; k < 2; ++k) acc[ai][bj][m][n] = __builtin_bit_cast(f32x4, __builtin_amdgcn_mfma_i32_16x16x64_i8(__builtin_bit_cast(i32x4, Bt[n][k]), __builtin_bit_cast(i32x4, At[m][k]), __builtin_bit_cast(i32x4, acc[ai][bj][m][n]), 0, 0, 0)); } \
        else { _Pragma("unroll") for (int k = 0; k < 2; ++k) acc[ai][bj][m][n] = __builtin_amdgcn_mfma_f32_16x16x32_bf16(Bt[n][k], At[m][k], acc[ai][bj][m][n], 0, 0, 0); } } \
        __builtin_amdgcn_s_setprio(0); } while (0)
#define PG8_WAIT_V(n) asm volatile("s_waitcnt vmcnt(" #n ")" ::: "memory")
#define PG8_WAIT_L(n) asm volatile("s_waitcnt lgkmcnt(" #n ")" ::: "memory")
#define PG8_BAR __builtin_amdgcn_s_barrier()
#define PG8_SCHED __builtin_amdgcn_sched_barrier(0)
    Unit cur, nxt; int ui = 0;
    if (!S.next(0, cur)) return;
    f32x4 acc[2][2][4][2];
#pragma unroll
    for (int a = 0; a < 2; ++a)
#pragma unroll
        for (int b = 0; b < 2; ++b)
#pragma unroll
            for (int m = 0; m < 4; ++m)
#pragma unroll
                for (int n = 0; n < 2; ++n) acc[a][b][m][n] = (f32x4){0.f, 0.f, 0.f, 0.f};
    bf16x8 At[4][2], B0[2][2], B1[2][2];
    i32x8 At8[4], B08[2], B18[2];
    unsigned cvA[2][2], nvA[2][2];
    S.avoff(cur, cvA);
    const char* gA = (const char*)Abase;
    const char* cB = S.bptr(cur);
    if constexpr (Epi::AUX) E.stage_aux(lds, cur, 0);
    if constexpr (SP2) {
        PG8_STAGE(PG8_SB(0, 0), cB, voffB); PG8_STAGE(PG8_SB(0, 1), cB + hstep, PG8_VB1); PG8_STAGE(PG8_SA(0, 0), gA, cvA[0]); PG8_STAGE(PG8_SA(0, 1), gA, cvA[1]);
        if (wr == 1) PG8_BAR;
        PG8_WAIT_V(2); PG8_BAR;
        PG8_STAGE(PG8_SB(1, 0), cB + kstep, voffB); PG8_STAGE(PG8_SA(1, 0), gA + kstep, cvA[0]); PG8_STAGE(PG8_SB(1, 1), cB + hstep + kstep, PG8_VB1);
        PG8_WAIT_V(6); PG8_BAR;
    } else {
    PG8_STAGE(PG8_SB(0, 0), cB, voffB); PG8_STAGE(PG8_SA(0, 0), gA, cvA[0]); PG8_STAGE(PG8_SB(0, 1), cB + hstep, PG8_VB1); PG8_STAGE(PG8_SA(0, 1), gA, cvA[1]);
    if (wr == 1) PG8_BAR;
    PG8_WAIT_V(4); PG8_BAR;
    PG8_STAGE(PG8_SB(1, 0), cB + kstep, voffB); PG8_STAGE(PG8_SA(1, 0), gA + kstep, cvA[0]); PG8_STAGE(PG8_SB(1, 1), cB + hstep + kstep, PG8_VB1);
    PG8_WAIT_V(6); PG8_BAR;
    }
    for (;;) {
        const bool has_next = S.next(ui + 1, nxt);
        const char* nB = has_next ? S.bptr(nxt) : cB;
        if (has_next && !Sched::TAB_AVOFF) S.avoff(nxt, nvA);
        else {
#pragma unroll
            for (int h = 0; h < 2; ++h)
#pragma unroll
                for (int i = 0; i < 2; ++i) nvA[h][i] = cvA[h][i];
        }
#pragma unroll 1
        for (int t = 0; t < nt; t += 2) {
            const bool last = (t == nt - 2);
            if constexpr (Sched::TAB_AVOFF) { if (last && has_next) S.avoff_tab(nvA, (const LAS int*)(lds + LDS_AUX + ((ui + 1) & 1) * 2048)); }
            const char* a1 = gA + (size_t)(t + 1) * kstep;
            const char* a2 = last ? gA : gA + (size_t)(t + 2) * kstep; const char* b2 = last ? nB : cB + (size_t)(t + 2) * kstep;
            const char* a3 = a2 + kstep; const char* b3 = b2 + kstep;
            unsigned v2[2][2];
#pragma unroll
            for (int h = 0; h < 2; ++h)
#pragma unroll
                for (int i = 0; i < 2; ++i) v2[h][i] = last ? nvA[h][i] : cvA[h][i];
            if constexpr (SP2) {
            PG8_LDB(B0, 0, 0); PG8_LDB(B1, 0, 1); PG8_SCHED; PG8_LDA(At, 0, 0); PG8_STAGE(PG8_SA(1, 1), a1, cvA[1]);
            PG8_WAIT_V(8); PG8_WAIT_L(0); PG8_BAR; PG8_MMA(0, 0, At, B0); PG8_MMA(0, 1, At, B1); PG8_BAR; PG8_SCHED;
            if constexpr (Epi::AUX) { if (t == 0) E.stage_aux(lds, has_next ? nxt : cur, (ui + 1) & 1); }
            PG8_LDA(At, 0, 1); PG8_STAGE(PG8_SB(0, 0), b2, voffB); PG8_STAGE(PG8_SB(0, 1), b2 + hstep, PG8_VB1); PG8_STAGE(PG8_SA(0, 0), a2, v2[0]);
            PG8_WAIT_V(8); PG8_WAIT_L(0); PG8_BAR; PG8_MMA(1, 0, At, B0); PG8_MMA(1, 1, At, B1); PG8_BAR; PG8_SCHED;
            PG8_LDB(B0, 1, 0); PG8_LDB(B1, 1, 1); PG8_SCHED; PG8_LDA(At, 1, 0); PG8_STAGE(PG8_SA(0, 1), a2, v2[1]);
            PG8_WAIT_V(8); PG8_WAIT_L(0); PG8_BAR; PG8_MMA(0, 0, At, B0); PG8_MMA(0, 1, At, B1); PG8_BAR; PG8_SCHED;
            PG8_LDA(At, 1, 1); PG8_STAGE(PG8_SB(1, 0), b3, voffB); PG8_STAGE(PG8_SB(1, 1), b3 + hstep, PG8_VB1); PG8_STAGE(PG8_SA(1, 0), a3, v2[0]);
            PG8_WAIT_V(8); PG8_WAIT_L(0); PG8_BAR; PG8_MMA(1, 0, At, B0); PG8_MMA(1, 1, At, B1); PG8_BAR; PG8_SCHED;
            } else {
            PG8_LDB(B0, 0, 0); PG8_SCHED; PG8_LDA(At, 0, 0); PG8_STAGE(PG8_SA(1, 1), a1, cvA[1]);
            PG8_WAIT_L(8); PG8_BAR; PG8_WAIT_L(0); PG8_MMA(0, 0, At, B0); PG8_BAR; PG8_SCHED;
            PG8_LDB(B1, 0, 1); PG8_STAGE(PG8_SB(0, 0), b2, voffB);
            PG8_BAR; PG8_WAIT_L(0); PG8_MMA(0, 1, At, B1); PG8_BAR;
            PG8_LDA(At, 0, 1); PG8_STAGE(PG8_SA(0, 0), a2, v2[0]);
            PG8_BAR; PG8_WAIT_L(0); PG8_MMA(1, 0, At, B0); PG8_BAR; PG8_SCHED;
            PG8_STAGE(PG8_SB(0, 1), b2 + hstep, PG8_VB1);
            PG8_WAIT_V(6); PG8_BAR; PG8_MMA(1, 1, At, B1); PG8_BAR;
            PG8_LDB(B0, 1, 0); PG8_SCHED; PG8_LDA(At, 1, 0); PG8_STAGE(PG8_SA(0, 1), a2, v2[1]);
            PG8_WAIT_L(8); PG8_BAR; PG8_WAIT_L(0); PG8_MMA(0, 0, At, B0); PG8_BAR; PG8_SCHED;
            PG8_LDB(B1, 1, 1); PG8_STAGE(PG8_SB(1, 0), b3, voffB);
            PG8_BAR; PG8_WAIT_L(0); PG8_MMA(0, 1, At, B1); PG8_BAR;
            PG8_LDA(At, 1, 1); PG8_STAGE(PG8_SA(1, 0), a3, v2[0]);
            PG8_BAR; PG8_WAIT_L(0); PG8_MMA(1, 0, At, B0); PG8_BAR; PG8_SCHED;
            PG8_STAGE(PG8_SB(1, 1), b3 + hstep, PG8_VB1);
            PG8_WAIT_V(6); PG8_BAR; PG8_MMA(1, 1, At, B1); PG8_BAR;
            }
        }
        if constexpr (ALIGN_EPI) { if (wr == 0) PG8_BAR; }
        if constexpr (FP8) asm volatile("s_nop 15\n\ts_nop 15" ::: "memory");
        E(acc, cur, wr, wc, ui, fq);
        if (!has_next) break;
#pragma unroll
        for (int a = 0; a < 2; ++a)
#pragma unroll
            for (int b = 0; b < 2; ++b)
#pragma unroll
                for (int m = 0; m < 4; ++m)
#pragma unroll
                    for (int n = 0; n < 2; ++n) acc[a][b][m][n] = (f32x4){0.f, 0.f, 0.f, 0.f};
        cur = nxt; cB = nB; ++ui;
#pragma unroll
        for (int h = 0; h < 2; ++h)
#pragma unroll
            for (int i = 0; i < 2; ++i) cvA[h][i] = nvA[h][i];
        if constexpr (ALIGN_EPI) { if (wr == 1) PG8_BAR; }
    }
    PG8_WAIT_V(0);
    if constexpr (!ALIGN_EPI) { if (wr == 0) PG8_BAR; }
    PG8_BAR;
#undef PG8_SA
#undef PG8_VB1
#undef PG8_SB
#undef PG8_STAGE
#undef PG8_LDA
#undef PG8_LDB
#undef PG8_MMA
#undef PG8_WAIT_V
#undef PG8_WAIT_L
#undef PG8_BAR
#undef PG8_SCHED
}
}
using pg8::Unit; using pg8::W8_SCALE; using pg8::i32x4;

struct SchedDense {
    static constexpr bool TAB_AVOFF = false;
    const bf16_t* Bt; int K, nN, nUnits, G, c, latOnly, esz;
    __device__ __forceinline__ bool next(int i, Unit& u) const {
        const int L = i * G + c; if (L >= nUnits) return false;
        int wgid = L; { const int qq = nUnits / 8, rr = nUnits % 8, xcd = wgid % 8, off = wgid / 8; wgid = (xcd < rr ? xcd * (qq + 1) : rr * (qq + 1) + (xcd - rr) * qq) + off; }
        const int nM = nUnits / nN, nig = 8 * nN, gid = wgid / nig, fm = gid * 8, gsz = (nM - fm) < 8 ? (nM - fm) : 8;
        const int q = fm + ((wgid % nig) % gsz); u.pn = (wgid % nig) / gsz;
        u.pm = latOnly ? (q >> 5) * 33 + 1 + (q & 31) : q; u.aux = 0; return true;
    }
    __device__ __forceinline__ void avoff(const Unit& u, unsigned (&v)[2][2]) const {
        int R[2], C[2]; { const int t_ = opaque_tid(); pg8::stage_rc(t_ * 16, R[0], C[0]); pg8::stage_rc(t_ * 16 + 8192, R[1], C[1]); }
#pragma unroll
        for (int h = 0; h < 2; ++h)
#pragma unroll
            for (int i = 0; i < 2; ++i) v[h][i] = (unsigned)((u.pm * 256 + h * 128 + R[i]) * K * esz + C[i] * 2);
    }
    __device__ __forceinline__ const char* bptr(const Unit& u) const { return (const char*)Bt + (size_t)u.pn * 256 * K * esz; }
};
__device__ __forceinline__ int seg_find(const LAS int* segpan, int pp) { return ((const LAS unsigned char*)segpan)[(LDS_SEGT - LDS_TAB) + pp]; }
struct SchedS1 {
    static constexpr bool TAB_AVOFF = true;
    const LAS int* segpan; const int* rinfo; const bf16_t* w1t; const bf16_t* sh1t; int P0, nUnits, G, c;
    __device__ __forceinline__ bool next(int i, Unit& u) const {
        int L = i * G + c; if (L >= nUnits || c < 0) return false;
        { const int qq = nUnits / 8, rr = nUnits % 8, xcd = L % 8, off = L / 8; L = (xcd < rr ? xcd * (qq + 1) : rr * (qq + 1) + (xcd - rr) * qq) + off; }
        const int pp = P0 + (L >> 1); u.pn = L & 1; u.pm = pp; const int s = seg_find(segpan, pp); u.aux = s; return true;
    }
    __device__ __forceinline__ void avoff(const Unit& u, unsigned (&v)[2][2]) const {
        int R[2], C[2]; { const int t_ = opaque_tid(); pg8::stage_rc(t_ * 16, R[0], C[0]); pg8::stage_rc(t_ * 16 + 8192, R[1], C[1]); }
#pragma unroll
        for (int h = 0; h < 2; ++h)
#pragma unroll
            for (int i = 0; i < 2; ++i) { const int info = rinfo[u.pm * 256 + h * 128 + R[i]]; const int tok = info < 0 ? 0 : (info >> 4); v[h][i] = (unsigned)(tok * D + 2 * C[i]); }
    }
    __device__ __forceinline__ void avoff_tab(unsigned (&v)[2][2], const LAS int* tab) const {
        int R[2], C[2]; { const int t_ = opaque_tid(); pg8::stage_rc(t_ * 16, R[0], C[0]); pg8::stage_rc(t_ * 16 + 8192, R[1], C[1]); }
#pragma unroll
        for (int h = 0; h < 2; ++h)
#pragma unroll
            for (int i = 0; i < 2; ++i) { const int info = tab[h * 128 + R[i]]; const int tok = info < 0 ? 0 : (info >> 4); v[h][i] = (unsigned)(tok * D + 2 * C[i]); }
    }
    __device__ __forceinline__ const char* bptr(const Unit& u) const {
        return u.aux < 64 ? (const char*)w1t + ((size_t)u.aux * 512 + u.pn * 256) * D : (const char*)sh1t + (size_t)u.pn * 256 * D;
    }
};
struct SchedS2 {
    static constexpr bool TAB_AVOFF = false;
    const LAS int* segpan; const bf16_t* w2t; const bf16_t* sh2t; int P0, nUnits, G, c, nR;
    __device__ __forceinline__ bool next(int i, Unit& u) const {
        int L = i * G + c; if (L >= nUnits || c < 0) return false;
        { const int qq = nUnits / 8, rr = nUnits % 8, qr = nR / 8, rq = nR % 8, xcd = L % 8, off = L / 8;
            const int t0 = xcd * qq + (xcd < rr ? xcd : rr), r0 = xcd * qr + (xcd < rq ? xcd : rq);
            const int cS = (qq + (xcd < rr ? 1 : 0)) - (qr + (xcd < rq ? 1 : 0));
            L = off < cS ? nR + (t0 - r0) + off : r0 + (off - cS); }
        const int pp = P0 + (L >> 2); u.pn = L & 3; u.pm = pp; const int s = seg_find(segpan, pp); u.aux = s; return true;
    }
    __device__ __forceinline__ void avoff(const Unit& u, unsigned (&v)[2][2]) const {
        int R[2], C[2]; { const int t_ = opaque_tid(); pg8::stage_rc(t_ * 16, R[0], C[0]); pg8::stage_rc(t_ * 16 + 8192, R[1], C[1]); }
#pragma unroll
        for (int h = 0; h < 2; ++h)
#pragma unroll
            for (int i = 0; i < 2; ++i) v[h][i] = (unsigned)((u.pm * 256 + h * 128 + R[i]) * 256 + C[i] * 2);
    }
    __device__ __forceinline__ const char* bptr(const Unit& u) const {
        return u.aux < 64 ? (const char*)w2t + ((size_t)u.aux * 1024 + u.pn * 256) * 256 : (const char*)sh2t + (size_t)u.pn * 256 * 256;
    }
};

struct EpiU {
    static constexpr bool AUX = true; static constexpr bool PERM = true;
    bf16_t* U; const float* hgrn_lb; const float* rs; const float* cs; int layer; LAS unsigned char* ldsb;
    __device__ __forceinline__ void stage_aux(LAS unsigned char* lds, const Unit& u, int par) const {
        const int tid_ = opaque_tid(), w_ = __builtin_amdgcn_readfirstlane(tid_ >> 6);
        if (w_ < 4) __builtin_amdgcn_global_load_lds((const unsigned*)(rs + u.pm * 256 + w_ * 64 + (tid_ & 63)), (LAS unsigned*)(lds + LDS_AUX + par * 2048 + w_ * 256), 4, 0, 0);
        else __builtin_amdgcn_global_load_lds((const unsigned*)(cs + u.pn * 256 + (w_ - 4) * 64 + (tid_ & 63)), (LAS unsigned*)(lds + LDS_AUX + par * 2048 + 1024 + (w_ - 4) * 256), 4, 0, 0);
    }
    __device__ __forceinline__ void operator()(const f32x4 (&acc)[2][2][4][2], const Unit& u, int wr, int wc, int ui, int) const {
        const int ln_ = opaque_tid() & 63, fr = ln_ & 15, fq = ln_ >> 4;
        const int row0 = u.pm * 256 + wr * 64 + fr, col0 = u.pn * 256 + wc * 32 + 8 * fq;
        const LAS float* tabr = (const LAS float*)(ldsb + LDS_AUX + (ui & 1) * 2048); const LAS float* tabc = tabr + 256;
        float rsv[8];
#pragma unroll
        for (int i = 0; i < 8; ++i) rsv[i] = tabr[wr * 64 + fr + (i >> 2) * 128 + (i & 3) * 16];
#pragma unroll
        for (int bj = 0; bj < 2; ++bj) { const int col = col0 + bj * 128;
            if (col < UC) {
                const int kind = (col >= C_HQ && col < C_HF) ? 1 : ((col >= C_HF && col < C_HI) ? 2 : 0);
                const f32x4 cs0 = *(const LAS f32x4*)(tabc + (col - u.pn * 256)), cs1 = *(const LAS f32x4*)(tabc + (col - u.pn * 256) + 4);
                float om[8];
#pragma unroll
                for (int j = 0; j < 8; ++j) om[j] = 1.f;
                if (kind == 2 && layer == 1) { const int ch = (col - C_HF) & 255;
#pragma unroll
                    for (int j = 0; j < 8; ++j) om[j] = 1.f - 1.f / (1.f + __expf(hgrn_lb[ch + j] - hgrn_lb[256 + ch + j])); }
#pragma unroll
                for (int ai = 0; ai < 2; ++ai)
#pragma unroll
                    for (int m = 0; m < 4; ++m) { bf16_t* rowp = U + (size_t)(row0 + ai * 128 + m * 16) * UC;
                        float v[8];
                        { const i32x4 q0 = __builtin_bit_cast(i32x4, acc[ai][bj][m][0]), q1 = __builtin_bit_cast(i32x4, acc[ai][bj][m][1]); const float rr = rsv[ai * 4 + m];
#pragma unroll
                            for (int j = 0; j < 4; ++j) { v[j] = (float)q0[j] * (rr * cs0[j]); v[4 + j] = (float)q1[j] * (rr * cs1[j]); } }
                        if (kind == 1) {
#pragma unroll
                            for (int j = 0; j < 8; ++j) v[j] = siluf_(v[j]); }
                        else if (kind == 2) {
#pragma unroll
                            for (int j = 0; j < 8; ++j) v[j] = om[j] * sigmoidf_(-v[j]); }
                        *(u32x4*)(rowp + col) = pack8(v); } } }
    }
};
struct EpiRes {
    static constexpr bool AUX = false; static constexpr bool PERM = true;
    const float* xin; const float* cin; bf16_t* HB; const float* mod;
    int layer;
    __device__ __forceinline__ void operator()(const f32x4 (&acc)[2][2][4][2], const Unit& u, int wr, int wc, int, int) const {
        const int ln_ = opaque_tid() & 63, fr = ln_ & 15, fq = ln_ >> 4;
        const int row0 = u.pm * 256 + wr * 64 + fr, col0 = u.pn * 256 + wc * 32 + 8 * fq;
        const int mi = (u.pm % 33 == 0) ? 8 : u.pm / 33;
        const float* gm = mod + (size_t)mi * 6144 + 2048;
#pragma unroll
        for (int bj = 0; bj < 2; ++bj) { const int col = col0 + bj * 128;
            const f32x4 g0 = *(const f32x4*)(gm + col), g1 = *(const f32x4*)(gm + col + 4);
#pragma unroll
            for (int ai = 0; ai < 2; ++ai) {
                f32x4 ra[4], rb[4];
                if (layer == 0) {
#pragma unroll
                    for (int m = 0; m < 4; ++m) { const int row = row0 + ai * 128 + m * 16; const int b_ = row / TPS, pos_ = row - b_ * TPS;
                        const float* xr = (pos_ < CTXL ? cin + ((size_t)b_ * CTXL + pos_) * D : xin + ((size_t)b_ * SEQ + (pos_ - CTXL)) * D) + col; ra[m] = *(const f32x4*)xr; rb[m] = *(const f32x4*)(xr + 4); } }
                else {
#pragma unroll
                    for (int m = 0; m < 4; ++m) { const int row = row0 + ai * 128 + m * 16; const u32x4 hv = *(const u32x4*)(HB + (size_t)row * D + col); float o[8]; unpack8(hv, o);
                        ra[m] = (f32x4){o[0], o[1], o[2], o[3]}; rb[m] = (f32x4){o[4], o[5], o[6], o[7]}; } }
#pragma unroll
                for (int m = 0; m < 4; ++m) { const int row = row0 + ai * 128 + m * 16;
                    float o[8];
                    const f32x4 v0 = acc[ai][bj][m][0], v1 = acc[ai][bj][m][1];
#pragma unroll
                    for (int j = 0; j < 4; ++j) { o[j] = ra[m][j] + g0[j] * v0[j]; o[4 + j] = rb[m][j] + g1[j] * v1[j]; }
                    *(u32x4*)(HB + (size_t)row * D + col) = pack8(o); } } }
    }
};
struct EpiRouter {
    static constexpr bool AUX = false; static constexpr bool PERM = false;
    float* SC;
    __device__ __forceinline__ void operator()(const f32x4 (&acc)[2][2][4][2], const Unit& u, int wr, int wc, int, int) const {
        const int ln_ = opaque_tid() & 63, fr = ln_ & 15, fq = ln_ >> 4;
        if (wc >= 2) return;
        const int row0 = u.pm * 256 + wr * 64 + fr, col0 = wc * 32 + 4 * fq;
#pragma unroll
        for (int ai = 0; ai < 2; ++ai)
#pragma unroll
            for (int m = 0; m < 4; ++m)
#pragma unroll
                for (int n = 0; n < 2; ++n) { const f32x4 v = acc[ai][0][m][n]; f32x4 o;
#pragma unroll
                    for (int j = 0; j < 4; ++j) o[j] = sigmoidf_(v[j]);
                    *(f32x4*)(SC + (size_t)(row0 + ai * 128 + m * 16) * 64 + col0 + n * 16) = o; }
    }
};
struct EpiGLU {
    static constexpr bool AUX = true; static constexpr bool PERM = true;
    bf16_t* H; const float* rgate; const int* rinfo; LAS unsigned char* ldsb;
    __device__ __forceinline__ void stage_aux(LAS unsigned char* lds, const Unit& u, int par) const {
        const int tid_ = opaque_tid(), w_ = __builtin_amdgcn_readfirstlane(tid_ >> 6);
        if (w_ < 4) __builtin_amdgcn_global_load_lds((const unsigned*)(rinfo + u.pm * 256 + w_ * 64 + (tid_ & 63)), (LAS unsigned*)(lds + LDS_AUX + par * 2048 + w_ * 256), 4, 0, 0);
        else __builtin_amdgcn_global_load_lds((const unsigned*)(rgate + u.pm * 256 + (w_ - 4) * 64 + (tid_ & 63)), (LAS unsigned*)(lds + LDS_AUX + par * 2048 + 1024 + (w_ - 4) * 256), 4, 0, 0);
    }
    __device__ __forceinline__ void operator()(const f32x4 (&acc)[2][2][4][2], const Unit& u, int wr, int wc, int ui, int) const {
        const int ln_ = opaque_tid() & 63, fr = ln_ & 15, fq = ln_ >> 4;
        const int row0 = u.pm * 256 + wr * 64 + fr, col0 = u.pn * 128 + wc * 32 + 8 * fq;
        const LAS float* tab = (const LAS float*)(ldsb + LDS_AUX + (ui & 1) * 2048 + 1024);
        float rg[8];
#pragma unroll
        for (int i = 0; i < 8; ++i) rg[i] = tab[wr * 64 + fr + (i >> 2) * 128 + (i & 3) * 16];
        float rgs[8];
#pragma unroll
        for (int i = 0; i < 8; ++i) rgs[i] = rg[i] * (HACT_SCALE / (W8_SCALE * W8_SCALE));
#pragma unroll
        for (int ai = 0; ai < 2; ++ai)
#pragma unroll
            for (int m = 0; m < 4; ++m) { float o[8];
#pragma unroll
                for (int n = 0; n < 2; ++n)
#pragma unroll
                    for (int j = 0; j < 4; ++j) { const float g = acc[ai][0][m][n][j], up = acc[ai][1][m][n][j];
                        o[n * 4 + j] = (rgs[ai * 4 + m] * g) * up * __builtin_amdgcn_rcpf(1.f + __builtin_amdgcn_exp2f(g * (-1.4426950408889634f / W8_SCALE))); }
                *(u32x2*)((unsigned char*)H + (size_t)(row0 + ai * 128 + m * 16) * 256 + col0) = pack8_fp8(o, 1.f); }
    }
};
struct EpiMoE {
    static constexpr int PERM = 2;
    static constexpr bool AUX = true;
    const int* rinfo; const float* mod; unsigned char* ws; LAS unsigned char* xs;
    __device__ __forceinline__ void stage_aux(LAS unsigned char* lds, const Unit& u, int par) const {
        const int tid_ = opaque_tid(), w_ = __builtin_amdgcn_readfirstlane(tid_ >> 6);
        if (w_ < 4) __builtin_amdgcn_global_load_lds((const unsigned*)(rinfo + u.pm * 256 + w_ * 64 + (tid_ & 63)), (LAS unsigned*)(lds + LDS_AUX + par * 2048 + w_ * 256), 4, 0, 0);
    }
    __device__ __forceinline__ void operator()(const f32x4 (&acc)[2][2][4][2], const Unit& u, int wr, int wc, int ui, int) const {
        const int tid_ = opaque_tid(), ln_ = tid_ & 63, fr = ln_ & 15, fq = ln_ >> 4;
        const LAS int* tab = (const LAS int*)(xs - LDS_XS + LDS_AUX + (ui & 1) * 2048);
        if (u.aux < 64) {
            LAS unsigned char* sx = xs + (tid_ >> 6) * XS_WAVE;
            const int tr = ln_ >> 2, tc = ln_ & 3;
            int inf[8];
#pragma unroll
            for (int i = 0; i < 8; ++i) inf[i] = tab[wr * 64 + tr + (i >> 2) * 128 + (i & 3) * 16];
#pragma unroll
            for (int ai = 0; ai < 2; ++ai)
#pragma unroll
                for (int m = 0; m < 4; ++m) { u32x4 w;
#pragma unroll
                    for (int bj = 0; bj < 2; ++bj)
#pragma unroll
                        for (int n = 0; n < 2; ++n) { const f32x4 v = acc[ai][bj][m][n];
                            w[bj * 2 + n] = pk4_fp8(v[0], v[1], v[2], v[3]); }
                    *(LAS u32x4*)(sx + fr * 80 + fq * 16) = w;
                    const u32x4 t = *(const LAS u32x4*)(sx + tr * 80 + tc * 16);
                    const int info = inf[ai * 4 + m];
                    if (info >= 0) { const unsigned tok = (unsigned)info >> 4, k = (unsigned)info & 15u;
                        const unsigned base = k == 0u ? (unsigned)(OFF_AB + SLOT_BYTES) : (k < 3u ? (unsigned)(OFF_Y2 - SLOT_BYTES) : (unsigned)(OFF_SLOTU - 3 * SLOT_BYTES));
                        *(u32x4*)(ws + (base + k * (unsigned)SLOT_BYTES + tok * (unsigned)D + (unsigned)(u.pn * 256 + wc * 64 + tc * 16))) = t; } }
        } else {
            const int col0 = u.pn * 256 + wc * 64 + 16 * fq;
            int inf[8];
#pragma unroll
            for (int i = 0; i < 8; ++i) inf[i] = tab[wr * 64 + fr + (i >> 2) * 128 + (i & 3) * 16];
            int bcur = -1; f32x4 gq[2][2];
#pragma unroll
            for (int bj = 0; bj < 2; ++bj) { gq[bj][0] = (f32x4){0.f, 0.f, 0.f, 0.f}; gq[bj][1] = (f32x4){0.f, 0.f, 0.f, 0.f}; }
#pragma unroll
            for (int ai = 0; ai < 2; ++ai) {
                u32x4 old[4][2];
#pragma unroll
                for (int m = 0; m < 4; ++m) { const int info = inf[ai * 4 + m];
                    old[m][0] = (u32x4){0u, 0u, 0u, 0u}; old[m][1] = (u32x4){0u, 0u, 0u, 0u};
                    if (info >= 0) { const int tok = info >> 4;
                        const bf16_t* src = (const bf16_t*)(ws + OFF_HB) + (size_t)tok * D + col0;
                        old[m][0] = *(const u32x4*)src; old[m][1] = *(const u32x4*)(src + 8); } }
#pragma unroll
                for (int m = 0; m < 4; ++m) { const int info = inf[ai * 4 + m];
                    if (info >= 0) { const int tok = info >> 4;
                        bf16_t* dst = (bf16_t*)(ws + OFF_HB) + (size_t)tok * D + col0;
                        const int bb = mod_idx(tok);
                        if (bb != bcur) { const float* gf = mod + (size_t)bb * 6144 + 5120 + col0;
#pragma unroll
                            for (int bj = 0; bj < 2; ++bj) { gq[bj][0] = *(const f32x4*)(gf + bj * 8); gq[bj][1] = *(const f32x4*)(gf + bj * 8 + 4); }
                            bcur = bb; }
#pragma unroll
                        for (int bj = 0; bj < 2; ++bj) { float o[8]; unpack8(old[m][bj], o);
                            const f32x4 v0 = acc[ai][bj][m][0], v1 = acc[ai][bj][m][1];
#pragma unroll
                            for (int j = 0; j < 4; ++j) { o[j] += gq[bj][0][j] * (v0[j] * (1.f / SLOT_SCALE)); o[4 + j] += gq[bj][1][j] * (v1[j] * (1.f / SLOT_SCALE)); }
                            *(u32x4*)(dst + bj * 8) = pack8(o); } } }
            }
            __builtin_amdgcn_s_waitcnt(0x0F70);
        }
    }
};

__device__ __forceinline__ void transpose_load(const float* src, int K, int N, int tile, float (&r)[8]) {
    const int t = opaque_tid();
    const int nTn = (N + 63) / 64, kb = tile / nTn, nb = tile - kb * nTn, k0 = kb * 64, n0 = nb * 64, n = t & 63;
#pragma unroll
    for (int q = 0; q < 8; ++q) r[q] = (n0 + n < N) ? src[(size_t)(k0 + q * 8 + (t >> 6)) * N + n0 + n] : 0.f;
}
__device__ __forceinline__ void transpose_store(LAS float* scr, int K, int N, bf16_t* dst, int mode, int tile, float fp8scale, const float* qs) {
    const int t = opaque_tid();
    const int nTn = (N + 63) / 64, kb = tile / nTn, nb = tile - kb * nTn, k0 = kb * 64, n0 = nb * 64;
    { const int n = t >> 3, kc = t & 7;
        if (n0 + n < N) { float f[8];
#pragma unroll
            for (int j = 0; j < 8; ++j) f[j] = scr[(kc * 8 + j) * 65 + n];
            const int gn = n0 + n; const int row = mode == 0 ? gn : ((gn >> 7) * 256 + (mode == 2 ? 128 : 0) + (gn & 127));
            if (qs) *(u32x2*)((unsigned char*)dst + (size_t)row * K + k0 + kc * 8) = pack8_i8(f, 1.f / qs[row]);
            else if (fp8scale > 0.f) *(u32x2*)((unsigned char*)dst + (size_t)row * K + k0 + kc * 8) = pack8_fp8(f, fp8scale);
            else *(u32x4*)(dst + (size_t)row * K + k0 + kc * 8) = pack8(f); } }
}
__device__ __forceinline__ void transpose_job(const float* src, int K, int N, bf16_t* dst, int mode, LAS float* scr, float fp8scale = 0.f, const float* qs = nullptr) {
    const int t = opaque_tid();
    const int nt = (K / 64) * ((N + 63) / 64), G = (int)gridDim.x;
    float cur[8], nxt[8];
    int tile = blockIdx.x;
    if (tile < nt) transpose_load(src, K, N, tile, cur);
    for (; tile < nt; tile += G) {
#pragma unroll
        for (int q = 0; q < 8; ++q) scr[(q * 8 + (t >> 6)) * 65 + (t & 63)] = cur[q];
        __syncthreads();
        if (tile + G < nt) transpose_load(src, K, N, tile + G, nxt);
        transpose_store(scr, K, N, dst, mode, tile, fp8scale, qs);
        __syncthreads();
#pragma unroll
        for (int q = 0; q < 8; ++q) cur[q] = nxt[q];
    }
}

__device__ __forceinline__ void phase_transposes(const P& p, LAS unsigned char* lds) {
    const int tix = opaque_tid();
    unsigned char* ws = p.ws;
    LAS float* scr = (LAS float*)lds;
    __syncthreads();
    for (int l = 0; l < 2; ++l) {
        transpose_job(p.w_in + (size_t)l * D * UC, D, UC, (bf16_t*)(ws + OFF_WINT + (size_t)l * NWIN * D), 0, scr, 0.f, (const float*)(ws + OFF_SCL) + SCL_WIN + l * 4096);
        transpose_job(p.w_out + (size_t)l * D * D, D, D, (bf16_t*)(ws + OFF_WOUTT) + (size_t)l * D * D, 0, scr);
        transpose_job(p.sh_gate + (size_t)l * D * 256, D, 256, (bf16_t*)(ws + OFF_SH1T + (size_t)l * 512 * D), 1, scr, W8_SCALE);
        transpose_job(p.sh_up + (size_t)l * D * 256, D, 256, (bf16_t*)(ws + OFF_SH1T + (size_t)l * 512 * D), 2, scr, W8_SCALE);
        transpose_job(p.sh_down + (size_t)l * 256 * D, 256, D, (bf16_t*)(ws + OFF_SH2T + (size_t)l * D * 256), 0, scr, W2_SCALE);
        transpose_job(p.router_w + (size_t)l * D * 64, D, 64, (bf16_t*)(ws + OFF_RT) + (size_t)l * 256 * D, 0, scr);
        { u32x4* z = (u32x4*)(ws + OFF_WINT + ((size_t)l * NWIN + UC) * D); const int n = (NWIN - UC) * D / 16;
            for (int i = blockIdx.x * NTHR + tix; i < n; i += gridDim.x * NTHR) z[i] = (u32x4){0u, 0u, 0u, 0u}; }
        { u32x4* z = (u32x4*)((bf16_t*)(ws + OFF_RT) + ((size_t)l * 256 + 64) * D); const int n = 192 * D / 8;
            for (int i = blockIdx.x * NTHR + tix; i < n; i += gridDim.x * NTHR) z[i] = (u32x4){0u, 0u, 0u, 0u}; }
    }
}
__device__ __forceinline__ void colscale_job(const float* src, int K, int N, float* cs, int Npad, LAS unsigned char* lds) {
    const int tix = opaque_tid(), w = tix >> 6, lane = tix & 63;
    LAS float* red = (LAS float*)lds;
    for (int g = blockIdx.x; g < Npad / 64; g += gridDim.x) { const int n = g * 64 + lane; float m = 0.f;
        if (n < N) { const int k0 = w * (K / 8);
#pragma unroll 1
            for (int kk = k0; kk < k0 + K / 8; kk += 32) { float wv[32];
#pragma unroll
                for (int j = 0; j < 32; ++j) wv[j] = src[(size_t)(kk + j) * N + n];
#pragma unroll
                for (int j = 0; j < 32; ++j) m = fmaxf(m, fabsf(wv[j])); } }
        red[w * 64 + lane] = m;
        __syncthreads();
        if (w == 0) {
#pragma unroll
            for (int ww = 1; ww < 8; ++ww) m = fmaxf(m, red[ww * 64 + lane]);
            cs[n] = fmaxf(m, 1e-20f) * (1.f / 127.f); }
        __syncthreads(); }
}
__device__ __forceinline__ void phase_prologue(const P& p, LAS unsigned char* lds) {
    const int tix = opaque_tid();
    unsigned char* ws = p.ws;
    for (int l = 0; l < 2; ++l) colscale_job(p.w_in + (size_t)l * D * UC, D, UC, (float*)(ws + OFF_SCL) + SCL_WIN + l * 4096, 4096, lds);
    __syncthreads();
    LAS float* sc = (LAS float*)lds;
    LAS float* part = (LAS float*)(lds + 9 * 1024 * 4);
    __syncthreads();
    { float cv[18];
#pragma unroll
        for (int q = 0; q < 18; ++q) { const int i = tix + q * NTHR, s = i >> 10, k = i & 1023; cv[q] = s < 8 ? p.c[s * 1024 + k] : p.c_ctx[k]; }
#pragma unroll
        for (int q = 0; q < 18; ++q) sc[tix + q * NTHR] = siluf_(cv[q]); }
    __syncthreads();
    const int w = tix >> 6, lane = tix & 63;
    for (int item = blockIdx.x; item < 2 * 96; item += gridDim.x) {
        const int l = item / 96, cg = item - l * 96, col = cg * 64 + lane;
        const float* wm = p.w_mod + (size_t)l * D * 6144 + col;
        float a[9];
#pragma unroll
        for (int s = 0; s < 9; ++s) a[s] = 0.f;
#pragma unroll 1
        for (int k0 = w * 128; k0 < w * 128 + 128; k0 += 32) { float wv[32];
#pragma unroll
            for (int j = 0; j < 32; ++j) wv[j] = wm[(size_t)(k0 + j) * 6144];
#pragma unroll
            for (int j = 0; j < 32; ++j)
#pragma unroll
                for (int s = 0; s < 9; ++s) a[s] += sc[s * 1024 + k0 + j] * wv[j]; }
#pragma unroll
        for (int s = 0; s < 9; ++s) part[(w * 9 + s) * 64 + lane] = a[s];
        __syncthreads();
        for (int i = tix; i < 9 * 64; i += NTHR) { const int s = i >> 6, ln = i & 63; float v = p.b_mod[(size_t)l * 6144 + cg * 64 + ln];
#pragma unroll
            for (int ww = 0; ww < 8; ++ww) v += part[(ww * 9 + s) * 64 + ln];
            ((float*)(ws + OFF_MOD))[((size_t)l * 9 + s) * 6144 + cg * 64 + ln] = v; }
        __syncthreads();
    }
}

__device__ __forceinline__ void cvt_load_tile(const float* src, int N, int tile, int tix, float (&r)[8]) {
    const int nTn = N / 64, kb = tile / nTn, nb = tile - kb * nTn;
#pragma unroll
    for (int q = 0; q < 8; ++q) r[q] = src[(size_t)(kb * 64 + q * 8 + (tix >> 6)) * N + nb * 64 + (tix & 63)];
}
__device__ __forceinline__ void cvt_store_tile(const LAS float* scr, bf16_t* dst, int K, int N, int mode, int tile, int tix, float fp8scale) {
    const int nTn = N / 64, kb = tile / nTn, nb = tile - kb * nTn, n = tix >> 3, kc = tix & 7; float f[8];
#pragma unroll
    for (int j = 0; j < 8; ++j) f[j] = scr[(kc * 8 + j) * 65 + n];
    const int gn = nb * 64 + n; const int row = mode == 0 ? gn : ((gn >> 7) * 256 + (mode == 2 ? 128 : 0) + (gn & 127));
    if (fp8scale > 0.f) *(u32x2*)((unsigned char*)dst + (size_t)row * K + kb * 64 + kc * 8) = pack8_fp8(f, fp8scale);
    else *(u32x4*)(dst + (size_t)row * K + kb * 64 + kc * 8) = pack8(f);
}
__device__ __forceinline__ void phase_expert_cvt(const P& p, int l, LAS unsigned char* lds, int it0, int it1, int stride) {
    const int tix = opaque_tid();
    bf16_t* w1t = (bf16_t*)(p.ws + OFF_W1T); bf16_t* w2t = (bf16_t*)(p.ws + OFF_W2T);
    float cur[8], nxt[8];
#define CVT_LOAD(itv, regs) do { const int e_ = (itv) / 192, r_ = (itv) - e_ * 192, wh_ = r_ >> 6, tl_ = r_ & 63; const size_t eo_ = ((size_t)l * 64 + e_) * D * 256; \
        if (wh_ == 0) cvt_load_tile(p.exp_gate + eo_, 256, tl_, tix, regs); else if (wh_ == 1) cvt_load_tile(p.exp_up + eo_, 256, tl_, tix, regs); else cvt_load_tile(p.exp_down + eo_, D, tl_, tix, regs); } while (0)
    int it = it0, buf = 0;
    if (it < it1) CVT_LOAD(it, cur);
    for (; it < it1; it += stride) {
        LAS float* scr = (LAS float*)lds + buf * (64 * 65);
#pragma unroll
        for (int q = 0; q < 8; ++q) scr[(q * 8 + (tix >> 6)) * 65 + (tix & 63)] = cur[q];
        __syncthreads();
        if (it + stride < it1) CVT_LOAD(it + stride, nxt);
        { const int e = it / 192, r = it - e * 192, which = r >> 6, tile = r & 63;
            if (which == 0) cvt_store_tile(scr, (bf16_t*)((unsigned char*)w1t + (size_t)e * 512 * D), D, 256, 1, tile, tix, W8_SCALE);
            else if (which == 1) cvt_store_tile(scr, (bf16_t*)((unsigned char*)w1t + (size_t)e * 512 * D), D, 256, 2, tile, tix, W8_SCALE);
            else cvt_store_tile(scr, (bf16_t*)((unsigned char*)w2t + (size_t)e * D * 256), 256, D, 0, tile, tix, W2_SCALE); }
#pragma unroll
        for (int q = 0; q < 8; ++q) cur[q] = nxt[q];
        buf ^= 1;
    }
#undef CVT_LOAD
    __syncthreads();
}

template <int SRC, bool FINAL>
__device__ __forceinline__ void phase_norm(const P& p, int l, const float* normw, int sc_off, int sh_off, bool lat_only) {
    const int tix = opaque_tid();
    unsigned char* ws = p.ws;
    const int gw = blockIdx.x * 8 + (tix >> 6), lane = tix & 63;
#define CB(i) (SRC == 2 ? lane * 16 + (i) * 8 : (i) * 512 + lane * 8)
    const bf16_t* HB = (const bf16_t*)(ws + OFF_HB);
    const float* modg = (const float*)(ws + OFF_MOD) + (size_t)(FINAL ? l : l - 1) * 9 * 6144 + 5120;
    bf16_t* dst = (bf16_t*)(ws + OFF_AB);
    const float* mod = (const float*)(ws + OFF_MOD) + (size_t)l * 9 * 6144;
    float nw[16];
#pragma unroll
    for (int i = 0; i < 2; ++i)
#pragma unroll
        for (int j = 0; j < 8; ++j) nw[i * 8 + j] = normw[CB(i) + j];
    constexpr int NRAW = SRC == 0 ? 4 : (SRC == 1 ? 2 : 10);
    constexpr bool D3 = (SRC != 2);
    u32x4 cur[NRAW], nxt[NRAW], nx2[D3 ? NRAW : 1];
    auto valid = [&](int row) { return !((lat_only || FINAL) && (row % TPS) < CTXL); };
    auto load = [&](int row, u32x4 (&r)[NRAW]) {
        if (SRC == 0) { const float* xr = src_row_f32(p, row);
#pragma unroll
            for (int i = 0; i < 2; ++i) { r[2 * i] = *(const u32x4*)(xr + CB(i)); r[2 * i + 1] = *(const u32x4*)(xr + CB(i) + 4); } }
        else {
#pragma unroll
            for (int i = 0; i < 2; ++i) { const size_t o = (size_t)row * D + CB(i); r[i] = *(const u32x4*)(HB + o); }
            if (SRC == 2) {
#pragma unroll
                for (int k = 0; k < 8; ++k) r[2 + k] = *(const u32x4*)(ws + slot_off(k) + (size_t)row * D + lane * 16); } }
    };
    int mcur = -1; f32x4 msc[2][2], msh[2][2];
#pragma unroll
    for (int i = 0; i < 2; ++i)
#pragma unroll
        for (int h = 0; h < 2; ++h) { msc[i][h] = (f32x4){0.f, 0.f, 0.f, 0.f}; msh[i][h] = (f32x4){0.f, 0.f, 0.f, 0.f}; }
    int gcur = -1; f32x4 mgf[2][2];
#pragma unroll
    for (int i = 0; i < 2; ++i) { mgf[i][0] = (f32x4){0.f, 0.f, 0.f, 0.f}; mgf[i][1] = (f32x4){0.f, 0.f, 0.f, 0.f}; }
    const int end = gw * 33 + 33;
    int row = gw * 33;
    while (row < end && !valid(row)) ++row;
    if (row < end) load(row, cur);
    int nrow = row + 1;
    while (nrow < end && !valid(nrow)) ++nrow;
    if (nrow < end) load(nrow, nxt);
    while (row < end) {
        int n2row = nrow + 1;
        while (n2row < end && !valid(n2row)) ++n2row;
        if constexpr (D3) { if (n2row < end) load(n2row, nx2); }
        const int b = row / TPS, pos = row - b * TPS;
        float v[16];
        if (SRC == 0) {
#pragma unroll
            for (int i = 0; i < 2; ++i)
#pragma unroll
                for (int j = 0; j < 4; ++j) { v[i * 8 + j] = __uint_as_float(cur[2 * i][j]); v[i * 8 + 4 + j] = __uint_as_float(cur[2 * i + 1][j]); } }
        else {
            if (SRC == 2) { const int gi = pos < CTXL ? 8 : b;
                if (gi != gcur) { const float* grow = modg + (size_t)gi * 6144;
#pragma unroll
                    for (int i = 0; i < 2; ++i) { mgf[i][0] = *(const f32x4*)(grow + CB(i)) * (1.f / SLOT_SCALE); mgf[i][1] = *(const f32x4*)(grow + CB(i) + 4) * (1.f / SLOT_SCALE); }
                    gcur = gi; } }
#pragma unroll
            for (int i = 0; i < 2; ++i) { float f[8]; unpack8(cur[i], f);
                if (SRC == 2) { float sm[8];
#pragma unroll
                    for (int j = 0; j < 8; ++j) sm[j] = 0.f;
#pragma unroll
                    for (int k = 0; k < 8; ++k) { const int w0 = (int)cur[2 + k][2 * i], w1 = (int)cur[2 + k][2 * i + 1];
                        const f32x2_t q0 = __builtin_amdgcn_cvt_pk_f32_fp8(w0, false), q1 = __builtin_amdgcn_cvt_pk_f32_fp8(w0, true), q2 = __builtin_amdgcn_cvt_pk_f32_fp8(w1, false), q3 = __builtin_amdgcn_cvt_pk_f32_fp8(w1, true);
                        sm[0] += q0[0]; sm[1] += q0[1]; sm[2] += q1[0]; sm[3] += q1[1]; sm[4] += q2[0]; sm[5] += q2[1]; sm[6] += q3[0]; sm[7] += q3[1]; }
#pragma unroll
                    for (int j = 0; j < 4; ++j) { f[j] += mgf[i][0][j] * sm[j]; f[4 + j] += mgf[i][1][j] * sm[4 + j]; } }
#pragma unroll
                for (int j = 0; j < 8; ++j) v[i * 8 + j] = f[j]; }
            if (SRC == 2 && !FINAL) {
#pragma unroll
                for (int i = 0; i < 2; ++i) { float f[8];
#pragma unroll
                    for (int j = 0; j < 8; ++j) f[j] = v[i * 8 + j];
                    *(u32x4*)((bf16_t*)(ws + OFF_HB) + (size_t)row * D + CB(i)) = pack8(f); } } }
        float ss = 0.f;
#pragma unroll
        for (int j = 0; j < 16; ++j) ss += v[j] * v[j];
        ss = wave_sum(ss);
        const float rstd = rsqrtf(ss * (1.f / D) + EPS);
        if (FINAL) { float* o = p.out + ((size_t)b * SEQ + (pos - CTXL)) * D;
#pragma unroll
            for (int i = 0; i < 2; ++i) { f32x4 a, c;
#pragma unroll
                for (int j = 0; j < 4; ++j) { a[j] = v[i * 8 + j] * rstd * nw[i * 8 + j]; c[j] = v[i * 8 + 4 + j] * rstd * nw[i * 8 + 4 + j]; }
                *(f32x4*)(o + CB(i)) = a; *(f32x4*)(o + CB(i) + 4) = c; } }
        else { const int mi = pos < CTXL ? 8 : b;
            if (mi != mcur) { const float* mrow = mod + (size_t)mi * 6144;
#pragma unroll
                for (int i = 0; i < 2; ++i) { const int col = CB(i);
                    msc[i][0] = *(const f32x4*)(mrow + sc_off + col); msc[i][1] = *(const f32x4*)(mrow + sc_off + col + 4);
                    msh[i][0] = *(const f32x4*)(mrow + sh_off + col); msh[i][1] = *(const f32x4*)(mrow + sh_off + col + 4); }
                mcur = mi; }
            float fo[2][8]; float amax = 0.f;
#pragma unroll
            for (int i = 0; i < 2; ++i)
#pragma unroll
                for (int j = 0; j < 4; ++j) { fo[i][j] = v[i * 8 + j] * rstd * nw[i * 8 + j] * (1.f + msc[i][0][j]) + msh[i][0][j]; fo[i][4 + j] = v[i * 8 + 4 + j] * rstd * nw[i * 8 + 4 + j] * (1.f + msc[i][1][j]) + msh[i][1][j];
                    amax = fmaxf(amax, fmaxf(fabsf(fo[i][j]), fabsf(fo[i][4 + j]))); }
            if (SRC == 1) {
#pragma unroll
                for (int i = 0; i < 2; ++i) { const int col = CB(i); *(u32x4*)(dst + (size_t)row * D + col) = pack8(fo[i]); *(u32x2*)(ws + OFF_F8 + (size_t)row * D + col) = pack8_fp8(fo[i], 1.f); } }
            else {
                amax = fmaxf(wave_max(amax), 1e-20f); const float inv = 127.f / amax;
                if (lane == 0) ((float*)(ws + OFF_SCL))[SCL_RA + row] = amax * (1.f / 127.f);
#pragma unroll
                for (int i = 0; i < 2; ++i) *(u32x2*)(ws + OFF_AB + (size_t)row * D + CB(i)) = pack8_i8(fo[i], inv); } }
        if constexpr (D3) {
#pragma unroll
            for (int i = 0; i < NRAW; ++i) { cur[i] = nxt[i]; nxt[i] = nx2[i]; }
        } else {
#pragma unroll
            for (int i = 0; i < NRAW; ++i) cur[i] = nxt[i];
            if (n2row < end) load(n2row, nxt); }
        row = nrow; nrow = n2row;
    }
}
#undef CB

__device__ __forceinline__ void prep_run(const P& p, int l, bf16_t* U, int row0, int nblk, int g, int lane) {
    const int tix = opaque_tid();
    int colbase, kind;
    const float* cw = nullptr; const float* cb = nullptr; int cstride = 0, cc = 0;
    if (g < 8) { kind = 0; colbase = C_X + 128 * g; cc = 128 * g + 2 * lane; cw = p.ssd_conv_w + (size_t)l * 5 * 1024; cb = p.ssd_conv_b + (size_t)l * 1024; cstride = 1024; }
    else if (g < 14) { kind = 1; colbase = C_GQ + 128 * (g - 8); cc = 128 * (g - 8) + 2 * lane; cw = p.gdn_conv_w + (size_t)l * 5 * 768; cstride = 768; }
    else if (g < 16) { kind = 2; colbase = C_HQ + 128 * (g - 14); }
    else { kind = 3; colbase = C_HF + 128 * (g - 16); cc = (128 * (g - 16) + 2 * lane) & 255; }
    bf16_t* base = U + (size_t)row0 * UC + colbase + 2 * lane;
    if (kind >= 2) {
        float lo0 = 0.f, lo1 = 0.f;
        if (kind == 3 && l == 1) { const float a0 = p.hgrn_lb[cc], a1 = p.hgrn_lb[256 + cc], b0 = p.hgrn_lb[cc + 1], b1 = p.hgrn_lb[256 + cc + 1];
            lo0 = 1.f / (1.f + __expf(a0 - a1)); lo1 = 1.f / (1.f + __expf(b0 - b1)); }
        for (int blk = 0; blk < nblk; ++blk) { bf16_t* bb = base + (size_t)blk * 64 * UC; unsigned raw[64];
#pragma unroll
            for (int t = 0; t < 64; ++t) raw[t] = *(const unsigned*)(bb + (size_t)t * UC);
#pragma unroll
            for (int t = 0; t < 64; ++t) { float a = bflo(raw[t]), b = bfhi(raw[t]);
                if (kind == 2) { a = siluf_(a); b = siluf_(b); } else { a = (1.f - lo0) * sigmoidf_(-a); b = (1.f - lo1) * sigmoidf_(-b); }
                *(unsigned*)(bb + (size_t)t * UC) = pk2(a, b); } }
        return;
    }
    float w0[5], w1[5], bias0 = 0.f, bias1 = 0.f;
#pragma unroll
    for (int j = 0; j < 5; ++j) { w0[j] = cw[j * cstride + cc]; w1[j] = cw[j * cstride + cc + 1]; }
    if (kind == 0) { bias0 = cb[cc]; bias1 = cb[cc + 1]; }
    const bool l2 = (kind == 1) && (g < 12); const float l2s = (g < 10) ? 0.125f : 1.f;
    float pa0 = 0.f, pa1 = 0.f, pb0 = 0.f, pb1 = 0.f;
    for (int blk = 0; blk < nblk; ++blk) {
        float r0[68], r1[68];
        r0[0] = pa0; r1[0] = pa1; r0[1] = pb0; r1[1] = pb1;
        bf16_t* bb = base + (size_t)blk * 64 * UC;
#pragma unroll
        for (int t = 0; t < 64; ++t) { const unsigned v = *(const unsigned*)(bb + (size_t)t * UC); r0[2 + t] = bflo(v); r1[2 + t] = bfhi(v); }
        if (blk + 1 < nblk) {
#pragma unroll
            for (int t = 64; t < 66; ++t) { const unsigned v = *(const unsigned*)(bb + (size_t)t * UC); r0[2 + t] = bflo(v); r1[2 + t] = bfhi(v); } }
        else { r0[66] = r0[67] = r1[66] = r1[67] = 0.f; }
#pragma unroll
        for (int t = 0; t < 64; ++t) {
            float a = bias0, b = bias1;
#pragma unroll
            for (int j = 0; j < 5; ++j) { a += r0[t + j] * w0[j]; b += r1[t + j] * w1[j]; }
            a = siluf_(a); b = siluf_(b);
            if (l2) { float ss = a * a + b * b;
#pragma unroll
                for (int o = 1; o < 32; o <<= 1) ss += __shfl_xor(ss, o);
                const float f = rsqrtf(ss + 1e-6f) * l2s; a *= f; b *= f; }
            *(unsigned*)(bb + (size_t)t * UC) = pk2(a, b);
        }
        pa0 = r0[64]; pa1 = r1[64]; pb0 = r0[65]; pb1 = r1[65];
    }
}
__device__ __forceinline__ void phase_prep(const P& p, int l) {
    const int tix = opaque_tid();
    bf16_t* U = (bf16_t*)(p.ws + OFF_UB);
    const int gw = blockIdx.x * 8 + (tix >> 6), lane = tix & 63, NW = gridDim.x * 8;
    constexpr int NG = 14;
    constexpr int NCTX = NBATCH * NG, NLAT = NBATCH * 128 * NG;
    if (gw < NCTX) { const int b = gw / NG, g = gw - b * NG; prep_run(p, l, U, b * TPS, 4, g, lane); }
    const int nfree = NW - NCTX;
    for (int slot = 0; ; ++slot) {
        int j;
        if (slot < 4) { if (gw < NCTX) continue; j = slot * nfree + (gw - NCTX); }
        else j = 4 * nfree + (slot - 4) * NW + gw;
        if (j >= NLAT) break;
        const int g = j % NG, rr = j / NG, b = rr >> 7, gr = rr & 127; prep_run(p, l, U, b * TPS + CTXL + gr * 64, 1, g, lane);
    }
}

__device__ __forceinline__ int chain_row(int b, int dir, int i) { const int pos = dir == 0 ? i : (i < CTXL ? (CTXL - 1 - i) : (TPS + CTXL - 1 - i)); return b * TPS + pos; }
__device__ __forceinline__ bf16x8 ldfrag(const LAS unsigned char* base, int row, int stride, int k0) { return *(const LAS bf16x8*)(base + (size_t)(row * stride + k0) * 2); }
#define DPP_SHR_ADD(v, ctrl, rmask) (v) += __builtin_bit_cast(float, __builtin_amdgcn_update_dpp(0, __builtin_bit_cast(int, (v)), (ctrl), (rmask), 0xf, true))
__device__ __forceinline__ float row16_incl_scan(float v) {
    DPP_SHR_ADD(v, 0x111, 0xf); DPP_SHR_ADD(v, 0x112, 0xf); DPP_SHR_ADD(v, 0x114, 0xf); DPP_SHR_ADD(v, 0x118, 0xf);
    return v;
}
__device__ __forceinline__ float wave_incl_scan(float v) {
    v = row16_incl_scan(v);
    DPP_SHR_ADD(v, 0x142, 0xa);
    DPP_SHR_ADD(v, 0x143, 0xc);
    return v;
}
typedef short bf16x4 __attribute__((ext_vector_type(4)));
__device__ __forceinline__ bf16x4 ldfrag4(const LAS unsigned char* base, int row, int stride, int k0) { return *(const LAS bf16x4*)(base + (size_t)(row * stride + k0) * 2); }
__device__ __forceinline__ bf16x4 accfrag(const f32x4 a) { u32x2 o; o.x = pk2(a[0], a[1]); o.y = pk2(a[2], a[3]); return __builtin_bit_cast(bf16x4, o); }
#define MFMA16(a, b, c) __builtin_amdgcn_mfma_f32_16x16x16bf16_1k((a), (b), (c), 0, 0, 0)
__device__ __forceinline__ void scan_ssd_mma(const P& p, int l, int b, int hd, int dir, LAS unsigned char* lds) {
    const int tix = opaque_tid();
    const bf16_t* U = (const bf16_t*)(p.ws + OFF_UB); bf16_t* Y = (bf16_t*)(p.ws + (dir == 0 ? OFF_AB : OFF_Y2));
    const int w = __builtin_amdgcn_readfirstlane(tix >> 6), lane = tix & 63, l15 = lane & 15, lq = lane >> 4, g = hd >> 2;
    const float A = -__expf(p.ssd_a_log[(l * 2 + dir) * 8 + hd]), dtb = p.ssd_dt_bias[(l * 2 + dir) * 8 + hd], Dk = p.ssd_d[l * 8 + hd];
    constexpr int SC = 136, SX = 72;
    constexpr int SB = 44544;
    LAS unsigned char* BT = lds + 2 * SB;
    LAS unsigned char* XT = BT + 18432;
    LAS unsigned char* LS = XT + 9216;
    constexpr int NCH = TPS / 64;
    f32x4 Ht[8];
#pragma unroll
    for (int j = 0; j < 8; ++j) Ht[j] = (f32x4){0.f, 0.f, 0.f, 0.f};
    u32x4 preA[5], preB[5]; bf16_t pdtA = 0, pdtB = 0;
    auto issue = [&](int c, u32x4 (&pre)[5], bf16_t& pdt) {
#pragma unroll
        for (int j = 0; j < 5; ++j) { const int q = tix + NTHR * j, t = q / 40, pc = q - t * 40;
            const bf16_t* r = U + (size_t)chain_row(b, dir, c * 64 + t) * UC;
            const int col = pc < 8 ? (C_X + hd * 64 + pc * 8) : (pc < 24 ? (C_B + g * 128 + (pc - 8) * 8) : (C_C + g * 128 + (pc - 24) * 8));
            pre[j] = *(const u32x4*)(r + col); }
        if (w == 0) pdt = U[(size_t)chain_row(b, dir, c * 64 + lane) * UC + C_DT + dir * 8 + hd];
    };
    issue(0, preA, pdtA); issue(1, preB, pdtB);
    const int pt = w & 3, th = w >> 2;
    static_assert(NCH % 2 == 0, "chunk loop is unrolled by two");
    auto chunk = [&](int c, u32x4 (&pre)[5], bf16_t& pdt) {
        LAS unsigned char* CS = lds + (c & 1) * SB; LAS unsigned char* BS = CS + 17408; LAS unsigned char* XS = CS + 34816;
        LAS float* CUM = (LAS float*)(CS + 44032); LAS float* DTV = CUM + 64;
#pragma unroll
        for (int j = 0; j < 5; ++j) { const int q = tix + NTHR * j, t = q / 40, pc = q - t * 40;
            LAS unsigned char* dst = pc < 8 ? (XS + (size_t)(t * SX + pc * 8) * 2) : (pc < 24 ? (BS + (size_t)(t * SC + (pc - 8) * 8) * 2) : (CS + (size_t)(t * SC + (pc - 24) * 8) * 2));
            *(LAS u32x4*)dst = pre[j]; }
        if (w == 0) { const float dt = softplusf_(bf2f(pdt) + dtb); float a = dt * A;
            a = wave_incl_scan(a);
            CUM[lane] = a; DTV[lane] = dt; }
        __syncthreads();
        if (c + 2 < NCH) issue(c + 2, pre, pdt);
        const float cum63 = CUM[63];
        { const int s = tix & 63, pb = tix >> 6; float f[8]; unpack8(*(const LAS u32x4*)(XS + (size_t)(s * SX + pb * 8) * 2), f); const float dt = DTV[s];
#pragma unroll
            for (int j = 0; j < 8; ++j) *(LAS bf16_t*)(XT + (size_t)((pb * 8 + j) * SX + s) * 2) = f2bf(f[j] * dt);
            const float sc = __expf(cum63 - CUM[s]);
#pragma unroll
            for (int h2 = 0; h2 < 2; ++h2) { unpack8(*(const LAS u32x4*)(BS + (size_t)(s * SC + pb * 16 + h2 * 8) * 2), f);
#pragma unroll
                for (int j = 0; j < 8; ++j) *(LAS bf16_t*)(BT + (size_t)((pb * 16 + h2 * 8 + j) * SX + s) * 2) = f2bf(f[j] * sc); } }
        { const int tm = w >> 1;
            float ct[4];
#pragma unroll
            for (int r = 0; r < 4; ++r) ct[r] = CUM[tm * 16 + 4 * lq + r];
#pragma unroll
            for (int tt = 0; tt < 2; ++tt) { const int tn = 2 * (w & 1) + tt; f32x4 acc = (f32x4){0.f, 0.f, 0.f, 0.f};
#pragma unroll
                for (int kk = 0; kk < 4; ++kk) acc = __builtin_amdgcn_mfma_f32_16x16x32_bf16(ldfrag(CS, tm * 16 + l15, SC, kk * 32 + 8 * lq), ldfrag(BS, tn * 16 + l15, SC, kk * 32 + 8 * lq), acc, 0, 0, 0);
                const int s = tn * 16 + l15; const float cs = CUM[s];
#pragma unroll
                for (int r = 0; r < 4; ++r) { const int t = tm * 16 + 4 * lq + r; const float v = (s <= t) ? acc[r] * __expf(ct[r] - cs) : 0.f;
                    *(LAS bf16_t*)(LS + (size_t)(t * SX + s) * 2) = f2bf(v); } } }
        __syncthreads();
        { bf16x4 hb[8];
#pragma unroll
            for (int nt = 0; nt < 8; ++nt) hb[nt] = accfrag(Ht[nt]);
#pragma unroll
            for (int tt = 0; tt < 2; ++tt) { const int tm = 2 * th + tt; f32x4 acc = (f32x4){0.f, 0.f, 0.f, 0.f};
#pragma unroll
                for (int nt = 0; nt < 8; ++nt) acc = MFMA16(ldfrag4(CS, tm * 16 + l15, SC, nt * 16 + 4 * lq), hb[nt], acc);
#pragma unroll
                for (int r = 0; r < 4; ++r) acc[r] *= __expf(CUM[tm * 16 + 4 * lq + r]);
#pragma unroll
                for (int kk = 0; kk < 2; ++kk) acc = __builtin_amdgcn_mfma_f32_16x16x32_bf16(ldfrag(LS, tm * 16 + l15, SX, kk * 32 + 8 * lq), ldfrag(XT, pt * 16 + l15, SX, kk * 32 + 8 * lq), acc, 0, 0, 0);
                const int pcol = pt * 16 + l15;
#pragma unroll
                for (int r = 0; r < 4; ++r) { const int t = tm * 16 + 4 * lq + r; float y = acc[r];
                    if (dir == 0) y += Dk * bf2f(*(const LAS bf16_t*)(XS + (size_t)(t * SX + pcol) * 2));
                    Y[(size_t)chain_row(b, dir, c * 64 + t) * D + hd * 64 + pcol] = f2bf(y); } }
            const float dec = __expf(cum63);
            const bf16x8 xf0 = ldfrag(XT, pt * 16 + l15, SX, 8 * lq), xf1 = ldfrag(XT, pt * 16 + l15, SX, 32 + 8 * lq);
#pragma unroll
            for (int nt = 0; nt < 8; ++nt) { f32x4 acc = Ht[nt] * dec;
                acc = __builtin_amdgcn_mfma_f32_16x16x32_bf16(ldfrag(BT, nt * 16 + l15, SX, 8 * lq), xf0, acc, 0, 0, 0);
                acc = __builtin_amdgcn_mfma_f32_16x16x32_bf16(ldfrag(BT, nt * 16 + l15, SX, 32 + 8 * lq), xf1, acc, 0, 0, 0);
                Ht[nt] = acc; } }
    };
#pragma unroll 1
    for (int c = 0; c < NCH; c += 2) { chunk(c, preA, pdtA); chunk(c + 1, preB, pdtB); }
    __syncthreads();
}
__device__ __forceinline__ void scan_hgrn_mma(const P& p, int l, int b, int hd, int dir, LAS unsigned char* lds) {
    const int tix = opaque_tid();
    const bf16_t* U = (const bf16_t*)(p.ws + OFF_UB); bf16_t* Y = (bf16_t*)(p.ws + (dir == 0 ? OFF_AB : OFF_Y2));
    const int w = __builtin_amdgcn_readfirstlane(tix >> 6), lane = tix & 63, l15 = lane & 15, lq = lane >> 4;
    constexpr int SX = 72, SP = 40;
    LAS unsigned char* QS = lds;
    LAS unsigned char* KS = lds + 9216;
    LAS unsigned char* VS = lds + 18432;
    LAS unsigned char* KE = lds + 27648;
    LAS unsigned char* VT = lds + 48128;
    LAS unsigned char* ATT = lds + 68608;
    LAS float* ER = (LAS float*)(lds + 73728);
    LAS unsigned char* ST = lds + 74752;
    constexpr int NCH = TPS / 64;
    for (int i = tix; i < (74752 + 9216 - 27648) / 4; i += NTHR) ((LAS unsigned*)KE)[i] = 0u;
    f32x4 Sacc[4];
#pragma unroll
    for (int i = 0; i < 4; ++i) Sacc[i] = (f32x4){0.f, 0.f, 0.f, 0.f};
    u32x4 preA[3], preB[3];
    auto issue = [&](int c, u32x4 (&pre)[3]) {
#pragma unroll
        for (int j = 0; j < 3; ++j) { const int q = tix + NTHR * j, t = q / 24, pc = q - t * 24;
            const bf16_t* r = U + (size_t)chain_row(b, dir, c * 64 + t) * UC;
            const int col = pc < 8 ? (C_HQ + hd * 64 + pc * 8) : (pc < 16 ? (C_HF + dir * 256 + hd * 64 + (pc - 8) * 8) : (C_HI + hd * 64 + (pc - 16) * 8));
            pre[j] = *(const u32x4*)(r + col); }
    };
    issue(0, preA); issue(1, preB);
    static_assert(NCH % 2 == 0, "chunk loop is unrolled by two");
#pragma unroll 1
    for (int cc = 0; cc < NCH; cc += 2)
#pragma unroll
    for (int half = 0; half < 2; ++half) { const int c = cc + half; u32x4 (&pre)[3] = half ? preB : preA;
#pragma unroll
        for (int j = 0; j < 3; ++j) { const int q = tix + NTHR * j, t = q / 24, pc = q - t * 24;
            LAS unsigned char* dst = (pc < 8 ? QS : (pc < 16 ? KS : VS)) + (size_t)(t * SX + (pc & 7) * 8) * 2;
            *(LAS u32x4*)dst = pre[j]; }
        __syncthreads();
        if (c + 2 < NCH) issue(c + 2, pre);
        if (tix < 256) { const int k = tix & 63, j = tix >> 6; float r = 0.f, rr[16], kv[16], qv[16];
#pragma unroll
            for (int t = 0; t < 16; ++t) { kv[t] = bf2f(*(const LAS bf16_t*)(KS + (size_t)((16 * j + t) * SX + k) * 2)); qv[t] = bf2f(*(const LAS bf16_t*)(QS + (size_t)((16 * j + t) * SX + k) * 2)); }
#pragma unroll
            for (int t = 0; t < 16; ++t) { r += __logf(fmaxf(1.f - kv[t], 1e-30f)); rr[t] = r; }
#pragma unroll
            for (int t = 0; t < 16; ++t) { *(LAS bf16_t*)(QS + (size_t)((16 * j + t) * SX + k) * 2) = f2bf(qv[t] * __expf(rr[t])); *(LAS bf16_t*)(KS + (size_t)((16 * j + t) * SX + k) * 2) = f2bf(kv[t] * __expf(-fmaxf(rr[t], -80.f))); }
            ER[j * 64 + k] = __expf(r);
#pragma unroll
            for (int t = 0; t < 16; ++t) *(LAS bf16_t*)(KE + (size_t)((j * 64 + k) * SP + t) * 2) = f2bf(kv[t] * __expf(r - rr[t])); }
        else { const int v = (tix - 256) & 63, j = (tix - 256) >> 6; bf16_t tv[16];
#pragma unroll
            for (int t = 0; t < 16; ++t) tv[t] = *(const LAS bf16_t*)(VS + (size_t)((16 * j + t) * SX + v) * 2);
            u32x4 o0, o1; o0.x = tv[0] | ((unsigned)tv[1] << 16); o0.y = tv[2] | ((unsigned)tv[3] << 16); o0.z = tv[4] | ((unsigned)tv[5] << 16); o0.w = tv[6] | ((unsigned)tv[7] << 16);
            o1.x = tv[8] | ((unsigned)tv[9] << 16); o1.y = tv[10] | ((unsigned)tv[11] << 16); o1.z = tv[12] | ((unsigned)tv[13] << 16); o1.w = tv[14] | ((unsigned)tv[15] << 16);
            *(LAS u32x4*)(VT + (size_t)((j * 64 + v) * SP) * 2) = o0; *(LAS u32x4*)(VT + (size_t)((j * 64 + v) * SP + 8) * 2) = o1; }
        __syncthreads();
        if (w < 4) { const int j = w; f32x4 acc = (f32x4){0.f, 0.f, 0.f, 0.f};
#pragma unroll
            for (int kk = 0; kk < 2; ++kk) acc = __builtin_amdgcn_mfma_f32_16x16x32_bf16(ldfrag(QS, 16 * j + l15, SX, kk * 32 + 8 * lq), ldfrag(KS, 16 * j + l15, SX, kk * 32 + 8 * lq), acc, 0, 0, 0);
#pragma unroll
            for (int r = 0; r < 4; ++r) { const int t = 4 * lq + r; *(LAS bf16_t*)(ATT + (size_t)((j * 16 + t) * SP + l15) * 2) = f2bf(l15 <= t ? acc[r] : 0.f); } }
        __syncthreads();
        if (w < 4) { const int vt = w;
#pragma unroll
            for (int j = 0; j < 4; ++j) {
                bf16x4 sb[4];
#pragma unroll
                for (int kt = 0; kt < 4; ++kt) sb[kt] = accfrag(Sacc[kt]);
                const bf16x4 vfr = ldfrag4(VT, j * 64 + vt * 16 + l15, SP, 4 * lq);
                f32x4 o = (f32x4){0.f, 0.f, 0.f, 0.f};
#pragma unroll
                for (int kt = 0; kt < 4; ++kt) o = MFMA16(ldfrag4(QS, 16 * j + l15, SX, 16 * kt + 4 * lq), sb[kt], o);
                o = MFMA16(ldfrag4(ATT, j * 16 + l15, SP, 4 * lq), vfr, o);
#pragma unroll
                for (int r = 0; r < 4; ++r) Y[(size_t)chain_row(b, dir, c * 64 + 16 * j + 4 * lq + r) * D + 512 + hd * 64 + vt * 16 + l15] = f2bf(o[r]);
#pragma unroll
                for (int kt = 0; kt < 4; ++kt) { f32x4 acc = Sacc[kt];
#pragma unroll
                    for (int r = 0; r < 4; ++r) acc[r] *= ER[j * 64 + kt * 16 + 4 * lq + r];
                    Sacc[kt] = MFMA16(ldfrag4(KE, j * 64 + kt * 16 + l15, SP, 4 * lq), vfr, acc); }
            } }
        __syncthreads();
    }
}
__device__ __forceinline__ void scan_gdn_mma(const P& p, int l, int b, int hd, int dir, LAS unsigned char* lds) {
    const int tix = opaque_tid();
    const bf16_t* U = (const bf16_t*)(p.ws + OFF_UB); bf16_t* Y = (bf16_t*)(p.ws + (dir == 0 ? OFF_AB : OFF_Y2));
    const int w = __builtin_amdgcn_readfirstlane(tix >> 6), lane = tix & 63, l15 = lane & 15, lq = lane >> 4;
    const float Aa = __expf(p.gdn_a_log[(l * 2 + dir) * 4 + hd]), dtb = p.gdn_dt_bias[(l * 2 + dir) * 4 + hd];
    constexpr int SX = 72, SP = 40;
    LAS unsigned char* QS = lds;
    LAS unsigned char* KS = lds + 9216;
    LAS unsigned char* VS = lds + 18432;
    LAS unsigned char* QG = lds + 27648;
    LAS unsigned char* KE = lds + 36864;
    LAS float* AM = (LAS float*)(lds + 57344);
    LAS unsigned char* QKM = lds + 61952;
    LAS unsigned char* TM = lds + 67072;
    LAS unsigned char* RT = lds + 72192;
    LAS unsigned char* VNT = lds + 77312;
    LAS unsigned char* MT = lds + 82432;
    LAS float* GAM = (LAS float*)(lds + 100864); LAS float* BETA = (LAS float*)(lds + 101120); LAS float* EGAM = (LAS float*)(lds + 101376);
    constexpr int NCH = TPS / 64;
    for (int i = tix; i < (82432 + 9216 - 36864) / 4; i += NTHR) ((LAS unsigned*)KE)[i] = 0u;
    f32x4 Macc[4];
#pragma unroll
    for (int i = 0; i < 4; ++i) Macc[i] = (f32x4){0.f, 0.f, 0.f, 0.f};
    u32x4 preA[3], preB[3]; bf16_t paA = 0, pbA = 0, paB = 0, pbB = 0;
    auto issue = [&](int c, u32x4 (&pre)[3], bf16_t& pa, bf16_t& pb) {
#pragma unroll
        for (int j = 0; j < 3; ++j) { const int q = tix + NTHR * j, t = q / 24, pc = q - t * 24;
            const bf16_t* r = U + (size_t)chain_row(b, dir, c * 64 + t) * UC;
            const int col = pc < 8 ? (C_GQ + hd * 64 + pc * 8) : (pc < 16 ? (C_GK + hd * 64 + (pc - 8) * 8) : (C_GV + hd * 64 + (pc - 16) * 8));
            pre[j] = *(const u32x4*)(r + col); }
        if (w == 0) { const bf16_t* r = U + (size_t)chain_row(b, dir, c * 64 + lane) * UC; pa = r[C_GA + dir * 4 + hd]; pb = r[C_GB + dir * 4 + hd]; }
    };
    issue(0, preA, paA, pbA); issue(1, preB, paB, pbB);
    static_assert(NCH % 2 == 0, "chunk loop is unrolled by two");
#pragma unroll 1
    for (int cc = 0; cc < NCH; cc += 2)
#pragma unroll
    for (int half = 0; half < 2; ++half) { const int c = cc + half; u32x4 (&pre)[3] = half ? preB : preA; bf16_t& pa = half ? paB : paA; bf16_t& pb = half ? pbB : pbA;
        const int tix = opaque_tid(), lane = tix & 63, l15 = lane & 15, lq = lane >> 4;
#pragma unroll
        for (int j = 0; j < 3; ++j) { const int q = tix + NTHR * j, t = q / 24, pc = q - t * 24;
            LAS unsigned char* dst = (pc < 8 ? QS : (pc < 16 ? KS : VS)) + (size_t)(t * SX + (pc & 7) * 8) * 2;
            *(LAS u32x4*)dst = pre[j]; }
        if (w == 0) { float g = -Aa * softplusf_(bf2f(pa) + dtb); const float be = sigmoidf_(bf2f(pb));
            g = row16_incl_scan(g);
            GAM[lane] = g; BETA[lane] = be; EGAM[lane] = __expf(g); }
        __syncthreads();
        if (c + 2 < NCH) issue(c + 2, pre, pa, pb);
        { const int t = tix >> 3, kb = tix & 7; float f[8]; unpack8(*(const LAS u32x4*)(QS + (size_t)(t * SX + kb * 8) * 2), f); const float eg = EGAM[t];
#pragma unroll
            for (int i = 0; i < 8; ++i) f[i] *= eg;
            *(LAS u32x4*)(QG + (size_t)(t * SX + kb * 8) * 2) = pack8(f);
            unpack8(*(const LAS u32x4*)(KS + (size_t)(t * SX + kb * 8) * 2), f); const float ek = __expf(GAM[(t & 48) + 15] - GAM[t]);
#pragma unroll
            for (int i = 0; i < 8; ++i) *(LAS bf16_t*)(KE + (size_t)(((t >> 4) * 64 + kb * 8 + i) * SP + (t & 15)) * 2) = f2bf(f[i] * ek); }
        { const int j = w & 3, which = w >> 2;
            if (which == 0) {
                f32x4 kk = (f32x4){0.f, 0.f, 0.f, 0.f};
#pragma unroll
                for (int q = 0; q < 2; ++q) kk = __builtin_amdgcn_mfma_f32_16x16x32_bf16(ldfrag(KS, 16 * j + l15, SX, q * 32 + 8 * lq), ldfrag(KS, 16 * j + l15, SX, q * 32 + 8 * lq), kk, 0, 0, 0);
                const float gs = GAM[16 * j + l15], bs = BETA[16 * j + l15];
                f32x4 Q, QT, ST;
#pragma unroll
                for (int r = 0; r < 4; ++r) { const int t = 4 * lq + r; const float gt = GAM[16 * j + t], bt = BETA[16 * j + t];
                    Q[r] = (l15 < t) ? -bt * kk[r] * __expf(gt - gs) : 0.f;
                    QT[r] = (t < l15) ? -bs * kk[r] * __expf(gs - gt) : 0.f;
                    ST[r] = QT[r] + ((t == l15) ? 1.f : 0.f); }
#pragma unroll
                for (int lv = 0; lv < 3; ++lv) { const bf16x4 qa = accfrag(QT), qb = accfrag(Q);
                    const f32x4 Q2 = MFMA16(qa, qb, ((f32x4){0.f, 0.f, 0.f, 0.f}));
                    if (lv < 2) QT = MFMA16(qb, qa, ((f32x4){0.f, 0.f, 0.f, 0.f}));
                    Q = Q2;
                    ST = MFMA16(accfrag(Q), accfrag(ST), ST); }
                *(LAS bf16x4*)(TM + (size_t)(j * 64 + lane) * 8) = accfrag(ST);
            } else {
                f32x4 qk = (f32x4){0.f, 0.f, 0.f, 0.f};
#pragma unroll
                for (int q = 0; q < 2; ++q) qk = __builtin_amdgcn_mfma_f32_16x16x32_bf16(ldfrag(KS, 16 * j + l15, SX, q * 32 + 8 * lq), ldfrag(QS, 16 * j + l15, SX, q * 32 + 8 * lq), qk, 0, 0, 0);
                const float gt = GAM[16 * j + l15];
#pragma unroll
                for (int r = 0; r < 4; ++r) { const int s2 = 4 * lq + r; qk[r] = (s2 <= l15) ? qk[r] * __expf(gt - GAM[16 * j + s2]) : 0.f; }
                *(LAS bf16x4*)(QKM + (size_t)(j * 64 + lane) * 8) = accfrag(qk);
            } }
        __syncthreads();
        if (w < 4) { const int vt = w;
#pragma unroll
            for (int j = 0; j < 4; ++j) {
                bf16x4 mb[4];
#pragma unroll
                for (int kt = 0; kt < 4; ++kt) mb[kt] = accfrag(Macc[kt]);
                f32x4 km = (f32x4){0.f, 0.f, 0.f, 0.f}, o = (f32x4){0.f, 0.f, 0.f, 0.f};
#pragma unroll
                for (int kt = 0; kt < 4; ++kt) km = MFMA16(ldfrag4(KS, 16 * j + l15, SX, 16 * kt + 4 * lq), mb[kt], km);
#pragma unroll
                for (int kt = 0; kt < 4; ++kt) o = MFMA16(ldfrag4(QG, 16 * j + l15, SX, 16 * kt + 4 * lq), mb[kt], o);
                f32x4 rv;
#pragma unroll
                for (int r = 0; r < 4; ++r) { const int s2 = 16 * j + 4 * lq + r; const float vv = bf2f(*(const LAS bf16_t*)(VS + (size_t)(s2 * SX + vt * 16 + l15) * 2));
                    rv[r] = BETA[s2] * (vv - EGAM[s2] * km[r]); }
                const f32x4 vn = MFMA16(*(const LAS bf16x4*)(TM + (size_t)(j * 64 + lane) * 8), accfrag(rv), ((f32x4){0.f, 0.f, 0.f, 0.f}));
                const bf16x4 vb = accfrag(vn);
                o = MFMA16(*(const LAS bf16x4*)(QKM + (size_t)(j * 64 + lane) * 8), vb, o);
#pragma unroll
                for (int r = 0; r < 4; ++r) Y[(size_t)chain_row(b, dir, c * 64 + 16 * j + 4 * lq + r) * D + 768 + hd * 64 + vt * 16 + l15] = f2bf(o[r]);
                const float dec = EGAM[16 * j + 15];
#pragma unroll
                for (int kt = 0; kt < 4; ++kt) Macc[kt] = MFMA16(ldfrag4(KE, j * 64 + kt * 16 + l15, SP, 4 * lq), vb, Macc[kt] * dec);
            } }
        __syncthreads();
    }
}
constexpr int CVT_GRAB = 6;
static_assert((64 * 192) % CVT_GRAB == 0, "tile split");
__device__ __forceinline__ void phase_scan(const P& p, int l, LAS unsigned char* lds) {
    const int tix = opaque_tid();
    for (int ch = blockIdx.x; ch < 256; ch += gridDim.x) {
        const int x = ch & 7, m = ch >> 3; int dir, hd16, b;
        if (m < 16) { const int gidx = x + 8 * (m >> 3), r8 = m & 7; b = gidx >> 1; hd16 = (gidx & 1) * 4 + (r8 >> 1); dir = r8 & 1; }
        else { const int idx = x * 8 + (m & 7); b = idx >> 3; hd16 = (m < 24 ? 8 : 12) + ((idx >> 1) & 3); dir = idx & 1; }
        if (hd16 < 8) scan_ssd_mma(p, l, b, hd16, dir, lds);
        else if (hd16 < 12) scan_hgrn_mma(p, l, b, hd16 - 8, dir, lds);
        else scan_gdn_mma(p, l, b, hd16 - 12, dir, lds);
        __syncthreads();
        unsigned* qhead = (unsigned*)(p.ws + OFF_CVTQ) + 64 * l;
        for (;;) {
            if (tix == 0) *(LAS int*)(lds + LDS_TAB) = (int)__hip_atomic_fetch_add(qhead, (unsigned)CVT_GRAB, __ATOMIC_RELAXED, __HIP_MEMORY_SCOPE_AGENT);
            __syncthreads();
            const int t0 = *(const LAS int*)(lds + LDS_TAB);
            __syncthreads();
            if (t0 >= 64 * 192) break;
            phase_expert_cvt(p, l, lds, t0, t0 + CVT_GRAB, 1);
        }
    }
}

__device__ __forceinline__ void phase_post(const P& p, int l, bool lat_only) {
    const int tix = opaque_tid();
    const bf16_t* U = (const bf16_t*)(p.ws + OFF_UB); bf16_t* Y1 = (bf16_t*)(p.ws + OFF_AB); const bf16_t* Y2 = (const bf16_t*)(p.ws + OFF_Y2);
    const int gw = blockIdx.x * 8 + (tix >> 6), lane = tix & 63;
    const int col = 16 * lane;
    const int gc = lane < 32 ? col : (lane < 48 ? C_HG + (col - 512) : C_GG + (col - 768));
    float nw[16];
#pragma unroll
    for (int j = 0; j < 16; ++j) nw[j] = lane < 32 ? p.ssd_norm[l * 512 + col + j] : (lane < 48 ? p.hgrn_norm[l * 64 + ((col + j) & 63)] : p.gdn_norm[l * 64 + ((col + j) & 63)]);
    u32x4 cur[6], nxt[6], nx2[6];
    auto valid = [&](int row) { return !(lat_only && (row % TPS) < CTXL); };
    auto load = [&](int row, u32x4 (&r)[6]) {
#pragma unroll
        for (int i = 0; i < 2; ++i) { r[i] = *(const u32x4*)(Y1 + (size_t)row * D + col + i * 8); r[2 + i] = *(const u32x4*)(Y2 + (size_t)row * D + col + i * 8); r[4 + i] = *(const u32x4*)(U + (size_t)row * UC + gc + i * 8); }
    };
    const int end = gw * 33 + 33;
    int row = gw * 33;
    while (row < end && !valid(row)) ++row;
    if (row < end) load(row, cur);
    int nrow = row + 1;
    while (nrow < end && !valid(nrow)) ++nrow;
    if (nrow < end) load(nrow, nxt);
    while (row < end) {
        int n2row = nrow + 1;
        while (n2row < end && !valid(n2row)) ++n2row;
        if (n2row < end) load(n2row, nx2);
        float y[16], gt[16];
#pragma unroll
        for (int i = 0; i < 2; ++i) { float a[8], c[8], g8[8];
            unpack8(cur[i], a); unpack8(cur[2 + i], c); unpack8(cur[4 + i], g8);
#pragma unroll
            for (int j = 0; j < 8; ++j) { y[i * 8 + j] = a[j] + c[j]; gt[i * 8 + j] = siluf_(g8[j]); } }
        if (lane < 32) {
#pragma unroll
            for (int j = 0; j < 16; ++j) y[j] *= gt[j]; }
        float ss = 0.f;
#pragma unroll
        for (int j = 0; j < 16; ++j) ss += y[j] * y[j];
        ss += __shfl_xor(ss, 1); ss += __shfl_xor(ss, 2);
        float s16 = ss; s16 += __shfl_xor(s16, 4); s16 += __shfl_xor(s16, 8);
        const float rstd = lane < 32 ? rsqrtf(s16 * (1.f / 256.f) + EPS) : rsqrtf(ss * (1.f / 64.f) + EPS);
#pragma unroll
        for (int i = 0; i < 2; ++i) { float f[8];
#pragma unroll
            for (int j = 0; j < 8; ++j) { const float t = y[i * 8 + j] * rstd * nw[i * 8 + j]; f[j] = lane < 32 ? t : t * gt[i * 8 + j]; }
            *(u32x4*)(Y1 + (size_t)row * D + col + i * 8) = pack8(f); }
#pragma unroll
        for (int i = 0; i < 6; ++i) { cur[i] = nxt[i]; nxt[i] = nx2[i]; }
        row = nrow; nrow = n2row;
    }
}

__device__ __forceinline__ void phase_topk(const P& p, int l, bool lat_only, LAS unsigned char* lds) {
    const int tix = opaque_tid();
    unsigned char* ws = p.ws;
    LAS int* hist = (LAS int*)lds;
    for (int i = tix; i < 256; i += NTHR) hist[i] = 0;
    __syncthreads();
    const int t = tix;
    if (t < 264) {
        const int row = blockIdx.x * 264 + t;
        const bool active = !(lat_only && (row % TPS) < CTXL);
        if (active) {
            const float* sp = (const float*)(ws + OFF_SC) + (size_t)row * 64;
            float sc[64], sel[64];
#pragma unroll
            for (int i = 0; i < 16; ++i) { const f32x4 v = *(const f32x4*)(sp + 4 * i); sc[4 * i] = v[0]; sc[4 * i + 1] = v[1]; sc[4 * i + 2] = v[2]; sc[4 * i + 3] = v[3]; }
#pragma unroll
            for (int e = 0; e < 64; ++e) sel[e] = sc[e] + p.router_bias[l * 64 + e];
            int idx[8]; float gv[8]; float gs = 0.f;
#pragma unroll
            for (int r = 0; r < 8; ++r) { float best = -3.0e38f, bs = 0.f; int bi = 0;
#pragma unroll
                for (int e = 0; e < 64; ++e) { const bool gt = sel[e] > best; best = gt ? sel[e] : best; bs = gt ? sc[e] : bs; bi = gt ? e : bi; }
#pragma unroll
                for (int e = 0; e < 64; ++e) sel[e] = (e == bi) ? -3.0e38f : sel[e];
                idx[r] = bi; gv[r] = bs; gs += bs; }
            const float inv = 2.5f / gs;
            int* te = (int*)(ws + OFF_TOKE) + (size_t)row * 8; float* tg = (float*)(ws + OFF_TOKG) + (size_t)row * 8; int* tl = (int*)(ws + OFF_TOKLR) + (size_t)row * 12;
#pragma unroll
            for (int r = 0; r < 8; ++r) { const int s = idx[r]; const int lr = atomicAdd((int*)&hist[s], 1); te[r] = idx[r]; tg[r] = gv[r] * inv; tl[r] = lr; }
            tl[8] = atomicAdd((int*)&hist[64], 1);
        }
    }
    __syncthreads();
    for (int i = tix; i < 256; i += NTHR) ((int*)(ws + OFF_BCNT))[blockIdx.x * 256 + i] = (i < NSEG) ? hist[i] : 0;
}
__device__ __forceinline__ void phase_lists(const P& p, int l, bool lat_only, LAS unsigned char* lds) {
    const int tix = opaque_tid();
    unsigned char* ws = p.ws;
    LAS int* tot = (LAS int*)lds; LAS int* base = tot + 256; LAS int* segp = base + 256;
    const int* bc = (const int*)(ws + OFF_BCNT);
    const int t = tix;
    { LAS int* pa = (LAS int*)lds + 1024; LAS int* pb = pa + 512;
        const int sg = t & 127, part = t >> 7; int a = 0, bs = 0;
        if (sg < NSEG) {
#pragma unroll 16
            for (int k = 0; k < GRID / 4; ++k) { const int bb = part * (GRID / 4) + k; const int v = bc[bb * 256 + sg]; a += v; bs += bb < (int)blockIdx.x ? v : 0; } }
        pa[t] = a; pb[t] = bs;
        __syncthreads();
        if (t < 256) { const bool in = t < NSEG; tot[t] = in ? pa[t] + pa[128 + t] + pa[256 + t] + pa[384 + t] : 0; base[t] = in ? pb[t] + pb[128 + t] + pb[256 + t] + pb[384 + t] : 0; } }
    __syncthreads();
    if (t == 0) { int acc = 0; for (int s = 0; s < NSEG; ++s) { segp[s] = acc; acc += (tot[s] + 255) >> 8; } segp[NSEG] = acc; }
    __syncthreads();
    int* rinfo = (int*)(ws + OFF_RINFO); float* rgate = (float*)(ws + OFF_RGATE);
    if (t < 264) {
        const int row = blockIdx.x * 264 + t;
        const bool active = !(lat_only && (row % TPS) < CTXL);
        if (active) {
            const int* te = (const int*)(ws + OFF_TOKE) + (size_t)row * 8; const float* tg = (const float*)(ws + OFF_TOKG) + (size_t)row * 8; const int* tl = (const int*)(ws + OFF_TOKLR) + (size_t)row * 12;
#pragma unroll
            for (int r = 0; r < 8; ++r) { const int s = te[r]; const int slot = 256 * segp[s] + base[s] + tl[r]; rinfo[slot] = row * 16 + r; rgate[slot] = tg[r]; }
            const int slot = 256 * segp[64] + base[64] + tl[8]; rinfo[slot] = row * 16 + 8; rgate[slot] = 1.f;
        }
    }
    for (int s = blockIdx.x; s < NSEG; s += gridDim.x) { const int n = tot[s], e = ((n + 255) >> 8) << 8; for (int r = n + t; r < e; r += NTHR) { rinfo[256 * segp[s] + r] = -1; rgate[256 * segp[s] + r] = 0.f; } }
    if (blockIdx.x == 0 && t <= NSEG) ((int*)(ws + OFF_SEGP))[t] = segp[t];
}
__device__ __forceinline__ const LAS int* load_segp(const P& p, LAS unsigned char* lds) {
    const int tix = opaque_tid();
    LAS int* segp = (LAS int*)(lds + LDS_TAB);
    __syncthreads();
    if (tix <= NSEG) segp[tix] = ((const int*)(p.ws + OFF_SEGP))[tix];
    __syncthreads();
    { LAS unsigned char* segt = lds + LDS_SEGT; const int np = segp[NSEG];
        for (int pp = tix; pp < np; pp += NTHR) { int lo = 0, hi = NSEG; while (hi - lo > 1) { const int mid = (lo + hi) >> 1; if (segp[mid] <= pp) lo = mid; else hi = mid; } segt[pp] = (unsigned char)lo; } }
    __syncthreads();
    return segp;
}

enum { PH_PRO = 0, PH_NORM1, PH_WIN, PH_PREP, PH_SCAN, PH_POST, PH_WOUT, PH_NORM2, PH_ROUTER, PH_TOPK, PH_LISTS, PH_MOE, PH_FINAL };

__device__ __forceinline__ P launder_params(const P& p0) {
    P p;
    p.x = launder_ptr(p0.x); p.c = launder_ptr(p0.c); p.ctx = launder_ptr(p0.ctx); p.c_ctx = launder_ptr(p0.c_ctx); p.w_mod = launder_ptr(p0.w_mod); p.b_mod = launder_ptr(p0.b_mod);
    p.norm_mix = launder_ptr(p0.norm_mix); p.w_in = launder_ptr(p0.w_in); p.ssd_conv_w = launder_ptr(p0.ssd_conv_w); p.ssd_conv_b = launder_ptr(p0.ssd_conv_b);
    p.ssd_dt_bias = launder_ptr(p0.ssd_dt_bias); p.ssd_a_log = launder_ptr(p0.ssd_a_log); p.ssd_d = launder_ptr(p0.ssd_d); p.ssd_norm = launder_ptr(p0.ssd_norm);
    p.hgrn_lb = launder_ptr(p0.hgrn_lb); p.hgrn_norm = launder_ptr(p0.hgrn_norm); p.gdn_conv_w = launder_ptr(p0.gdn_conv_w); p.gdn_dt_bias = launder_ptr(p0.gdn_dt_bias);
    p.gdn_a_log = launder_ptr(p0.gdn_a_log); p.gdn_norm = launder_ptr(p0.gdn_norm); p.w_out = launder_ptr(p0.w_out); p.norm_ffn = launder_ptr(p0.norm_ffn);
    p.router_w = launder_ptr(p0.router_w); p.router_bias = launder_ptr(p0.router_bias); p.exp_gate = launder_ptr(p0.exp_gate); p.exp_up = launder_ptr(p0.exp_up);
    p.exp_down = launder_ptr(p0.exp_down); p.sh_gate = launder_ptr(p0.sh_gate); p.sh_up = launder_ptr(p0.sh_up); p.sh_down = launder_ptr(p0.sh_down);
    p.norm_final = launder_ptr(p0.norm_final); p.out = launder_ptr(p0.out); p.ws = launder_ptr(p0.ws);
    return p;
}
template <int PH>
__device__ __forceinline__ void run_phase(const P& p0, const int l0, LAS unsigned char* lds, const int step = 0) {
    const P p = launder_params(p0);
    int l = l0; asm volatile("" : "+s"(l));
    unsigned char* ws = p.ws;
    const float* mod = (const float*)(ws + OFF_MOD) + (size_t)l * 9 * 6144;
    const bool lat_only = (l == 1);
    if constexpr (PH == PH_PRO) phase_prologue(p, lds);
    if constexpr (PH == PH_NORM1) { if (l == 0) { phase_norm<0, false>(p, l, p.norm_mix + l * D, 1024, 0, false); phase_transposes(p, lds); } else phase_norm<2, false>(p, l, p.norm_mix + l * D, 1024, 0, false); }
    if constexpr (PH == PH_WIN) { SchedDense S{(const bf16_t*)(ws + OFF_WINT + (size_t)l * NWIN * D), D, NWIN / 256, NPAN * (NWIN / 256), (int)gridDim.x, (int)blockIdx.x, 0, 1};
        EpiU E{(bf16_t*)(ws + OFF_UB), p.hgrn_lb, (const float*)(ws + OFF_SCL) + SCL_RA, (const float*)(ws + OFF_SCL) + SCL_WIN + l * 4096, l, lds}; pg8::gemm_phase<EpiU, SchedDense, 2>(lds, ws + OFF_AB, D, S, E); }
    if constexpr (PH == PH_PREP) phase_prep(p, l);
    if constexpr (PH == PH_SCAN) phase_scan(p, l, lds);
    if constexpr (PH == PH_POST) phase_post(p, l, lat_only);
    if constexpr (PH == PH_WOUT) { SchedDense S{(const bf16_t*)(ws + OFF_WOUTT) + (size_t)l * D * D, D, 4, (lat_only ? 256 : NPAN) * 4, (int)gridDim.x, (int)blockIdx.x, lat_only ? 1 : 0, 2};
        EpiRes E{p.x, p.ctx, (bf16_t*)(ws + OFF_HB), mod, l}; pg8::gemm_phase(lds, (const bf16_t*)(ws + OFF_AB), D, S, E);
        }
    if constexpr (PH == PH_NORM2) phase_norm<1, false>(p, l, p.norm_ffn + l * D, 4096, 3072, lat_only);
    if constexpr (PH == PH_ROUTER) { SchedDense S{(const bf16_t*)(ws + OFF_RT) + (size_t)l * 256 * D, D, 1, (lat_only ? 256 : NPAN), (int)gridDim.x, (int)blockIdx.x, lat_only ? 1 : 0, 2};
        EpiRouter E{(float*)(ws + OFF_SC)}; pg8::gemm_phase(lds, (const bf16_t*)(ws + OFF_AB), D, S, E); }
    if constexpr (PH == PH_TOPK) phase_topk(p, l, lat_only, lds);
    if constexpr (PH == PH_LISTS) phase_lists(p, l, lat_only, lds);
    if constexpr (PH == PH_MOE) {
        const LAS int* segp = load_segp(p, lds);
        const int G = (int)gridDim.x, bid = (int)blockIdx.x;
        if (step > 0) {
            SchedS2 S{segp, (const bf16_t*)(ws + OFF_W2T), (const bf16_t*)(ws + OFF_SH2T + (size_t)l * D * 256), 0, 4 * segp[NSEG], G, bid, 4 * segp[NSEG - 1]};
            EpiMoE E{(const int*)(ws + OFF_RINFO), mod, ws, lds + LDS_XS};
            pg8::gemm_phase<EpiMoE, SchedS2, 1>(lds, ws + OFF_HACT, 256, S, E); }
        else { SchedS1 S{segp, (const int*)(ws + OFF_RINFO), (const bf16_t*)(ws + OFF_W1T), (const bf16_t*)(ws + OFF_SH1T + (size_t)l * 512 * D), 0, 2 * segp[NSEG], G, bid};
            EpiGLU E{(bf16_t*)(ws + OFF_HACT), (const float*)(ws + OFF_RGATE), (const int*)(ws + OFF_RINFO), lds}; pg8::gemm_phase<EpiGLU, SchedS1, 1>(lds, ws + OFF_F8, D, S, E); }
    }
    if constexpr (PH == PH_FINAL) phase_norm<2, true>(p, l, p.norm_final, 0, 0, true);
}

template <int PH>
__global__ void __launch_bounds__(NTHR, 2) k_phase(P p, int l, int step) {
    extern __shared__ __attribute__((aligned(16))) unsigned char smem[];
    run_phase<PH>(p, l, (LAS unsigned char*)smem, step);
}

#if MK_ONE_LAUNCH
__global__ void __launch_bounds__(NTHR, 2) k_mega(P p) {
    extern __shared__ __attribute__((aligned(16))) unsigned char smem[];
    LAS unsigned char* lds = (LAS unsigned char*)smem;
    if (threadIdx.x < 4) ((LAS unsigned*)(lds + LDS_BARW))[threadIdx.x] = 0u;
    __syncthreads();
    XcdBarrier bar = xcd_barrier_post((unsigned*)(p.ws + OFF_BAR), (volatile LAS unsigned*)(lds + LDS_BARW));
    run_phase<PH_PRO>(p, 0, lds); xcd_barrier(bar);
    for (int l = 0; l < 2; ++l) {
        run_phase<PH_NORM1>(p, l, lds); xcd_barrier(bar);
        run_phase<PH_WIN>(p, l, lds); xcd_barrier(bar);
        run_phase<PH_PREP>(p, l, lds); xcd_barrier(bar);
        run_phase<PH_SCAN>(p, l, lds); xcd_barrier(bar);
        run_phase<PH_POST>(p, l, lds); xcd_barrier(bar);
        run_phase<PH_WOUT>(p, l, lds); xcd_barrier(bar);
        run_phase<PH_NORM2>(p, l, lds); xcd_barrier(bar);
        run_phase<PH_ROUTER>(p, l, lds); xcd_barrier(bar);
        run_phase<PH_TOPK>(p, l, lds); xcd_barrier(bar);
        run_phase<PH_LISTS>(p, l, lds); xcd_barrier(bar);
        for (int st = 0; st < 2; ++st) { run_phase<PH_MOE>(p, l, lds, st); xcd_barrier(bar); }
    }
    run_phase<PH_FINAL>(p, 1, lds);
}
#endif

template <int PH> static void launch_phase(const P& p, int l, hipStream_t stream, int step = 0) {
    static bool attr = false;
    if (!attr) { (void)hipFuncSetAttribute((const void*)k_phase<PH>, hipFuncAttributeMaxDynamicSharedMemorySize, LDS_BYTES); attr = true; }
    hipLaunchKernelGGL(k_phase<PH>, dim3(GRID), dim3(NTHR), LDS_BYTES, stream, p, l, step);
}

extern "C" void kernel_launch(void* const* d_in, const int* in_sizes, int n_in, void* d_out, int out_size, void* d_ws, size_t ws_size, hipStream_t stream) {
    if (n_in != 31 || ws_size < WS_END || out_size != NBATCH * SEQ * D) { fprintf(stderr, "kernel_launch: unexpected shapes: n_in %d ws %zu (need %zu) out %d\n", n_in, ws_size, (size_t)WS_END, out_size); return; }
    P p{};
    const float** f = (const float**)&p;
    for (int i = 0; i < 31; ++i) f[i] = (const float*)d_in[i];
    p.out = (float*)d_out; p.ws = (unsigned char*)d_ws;
#if MK_ONE_LAUNCH
    static bool attr = false;
    if (!attr) { (void)hipFuncSetAttribute((const void*)k_mega, hipFuncAttributeMaxDynamicSharedMemorySize, LDS_BYTES); attr = true; }
    (void)hipMemsetAsync(d_ws, 0, 16384, stream);
    hipLaunchKernelGGL(k_mega, dim3(GRID), dim3(NTHR), LDS_BYTES, stream, p);
#else
    launch_phase<PH_PRO>(p, 0, stream);
    for (int l = 0; l < 2; ++l) {
        launch_phase<PH_NORM1>(p, l, stream); launch_phase<PH_WIN>(p, l, stream); launch_phase<PH_PREP>(p, l, stream); launch_phase<PH_SCAN>(p, l, stream);
        launch_phase<PH_POST>(p, l, stream); launch_phase<PH_WOUT>(p, l, stream); launch_phase<PH_NORM2>(p, l, stream); launch_phase<PH_ROUTER>(p, l, stream);
        launch_phase<PH_TOPK>(p, l, stream); launch_phase<PH_LISTS>(p, l, stream);
        for (int st = 0; st < 2; ++st) launch_phase<PH_MOE>(p, l, stream, st);
    }
    launch_phase<PH_FINAL>(p, 1, stream);
#endif
}
```

```cpp
#include <hip/hip_runtime.h>
#include <stdint.h>
#include <stdio.h>

#ifndef MK_ONE_LAUNCH
#define MK_ONE_LAUNCH 1
#endif

#define LAS __attribute__((address_space(3)))
typedef unsigned short bf16_t;
typedef short bf16x8 __attribute__((ext_vector_type(8)));
typedef float f32x4 __attribute__((ext_vector_type(4)));
typedef unsigned u32x4 __attribute__((ext_vector_type(4)));
typedef unsigned u32x2 __attribute__((ext_vector_type(2)));

constexpr int D = 1024, NBATCH = 8, SEQ = 8192, CTXL = 256, TPS = SEQ + CTXL;
constexpr int NROW = NBATCH * TPS;
constexpr int NPAN = NROW / 256;
constexpr int UC = 3872;
constexpr int NWIN = 4096;
constexpr int GRID = 256, NTHR = 512;
constexpr float EPS = 1e-6f;
constexpr int C_Z = 0, C_X = 512, C_B = 1024, C_C = 1280, C_DT = 1536;
constexpr int C_HQ = 1552, C_HF = 1808, C_HI = 2320, C_HG = 2576;
constexpr int C_GQ = 2832, C_GK = 3088, C_GV = 3344, C_GA = 3600, C_GB = 3608, C_GG = 3616;
constexpr int NSEG = 65;
constexpr int MAXPROWS = 9 * NROW + NSEG * 256;
static_assert(MAXPROWS / 256 <= 4096, "panel table");

constexpr size_t al256(size_t x) { return (x + 255) & ~(size_t)255; }
constexpr size_t OFF_BAR = 0;
constexpr size_t OFF_CVTQ = 14336;
constexpr size_t OFF_MOD = 16384;
constexpr size_t OFF_WINT = al256(OFF_MOD + (size_t)2 * 9 * 6144 * 4);
constexpr size_t OFF_WOUTT = OFF_WINT + (size_t)2 * NWIN * D * 2;
constexpr size_t OFF_SH1T = OFF_WOUTT + (size_t)2 * D * D * 2;
constexpr size_t OFF_SH2T = OFF_SH1T + (size_t)2 * 512 * D * 2;
constexpr size_t OFF_RT = OFF_SH2T + (size_t)2 * D * 256 * 2;
constexpr size_t OFF_SCL = OFF_RT + (size_t)2 * 256 * D * 2;
constexpr size_t SCL_BYTES = (size_t)2 << 20;
constexpr size_t ACT_BYTES = (size_t)NROW * D * 2;
constexpr size_t OFF_HB = OFF_SCL + SCL_BYTES;
constexpr size_t OFF_AB = OFF_HB + ACT_BYTES;
constexpr size_t OFF_Y2 = OFF_AB + ACT_BYTES;
constexpr size_t OFF_UB = OFF_Y2 + ACT_BYTES;
constexpr size_t UB_BYTES = (size_t)NROW * UC * 2;
constexpr size_t OFF_XW = OFF_UB + UB_BYTES;
constexpr size_t OFF_W1T = OFF_XW;
constexpr size_t OFF_W2T = OFF_W1T + (size_t)64 * 512 * D * 2;
constexpr size_t WS_END = OFF_W2T + (size_t)64 * D * 256 * 2;
constexpr size_t OFF_F8 = OFF_Y2;
constexpr size_t OFF_SEGP = OFF_UB;
constexpr size_t OFF_RINFO = OFF_SEGP + 1024;
constexpr size_t OFF_RGATE = al256(OFF_RINFO + (size_t)MAXPROWS * 4);
constexpr size_t OFF_HACT = al256(OFF_RGATE + (size_t)MAXPROWS * 4);
constexpr size_t OFF_SLOTU = al256(OFF_HACT + (size_t)MAXPROWS * 256);
constexpr size_t SLOT_BYTES = (size_t)NROW * D;
static_assert(OFF_SLOTU + 5 * SLOT_BYTES <= OFF_XW, "MoE scratch overflow");
constexpr size_t OFF_SC = OFF_SLOTU;
constexpr size_t OFF_TOKE = OFF_SC + (size_t)NROW * 64 * 4;
constexpr size_t OFF_TOKG = OFF_TOKE + (size_t)NROW * 8 * 4;
constexpr size_t OFF_TOKLR = OFF_TOKG + (size_t)NROW * 8 * 4;
constexpr size_t OFF_BCNT = OFF_TOKLR + (size_t)NROW * 12 * 4;
static_assert(WS_END < ((size_t)1 << 32), "32-bit workspace offsets");
constexpr float SLOT_SCALE = 32.f;
constexpr float HACT_SCALE = 8.f, W2_SCALE = 4.f;
static_assert(HACT_SCALE * W2_SCALE == SLOT_SCALE, "slot scale");
__host__ __device__ constexpr size_t slot_off(int k) { return k == 0 ? OFF_AB + SLOT_BYTES : (k < 3 ? OFF_Y2 + (size_t)(k - 1) * SLOT_BYTES : OFF_SLOTU + (size_t)(k - 3) * SLOT_BYTES); }

constexpr int SCL_WIN = 0;
constexpr int SCL_WOUT = SCL_WIN + 2 * 4096;
constexpr int SCL_SH1 = SCL_WOUT + 2 * 1024;
constexpr int SCL_W1 = SCL_SH1 + 2 * 512;
constexpr int SCL_RA = SCL_W1 + 64 * 512;
constexpr int SCL_RF = SCL_RA + NROW;
constexpr int SCL_RY = SCL_RF + NROW;
static_assert((size_t)(SCL_RY + NROW) * 4 <= SCL_BYTES, "scale region overflow");
constexpr int LDS_STAGE = 131072;
constexpr int LDS_BARW = LDS_STAGE;
constexpr int LDS_TAB = LDS_STAGE + 1024;
constexpr int LDS_XS = LDS_STAGE + 2048;
constexpr int XS_WAVE = 2304;
constexpr int LDS_AUX = LDS_XS + 8 * XS_WAVE;
constexpr int LDS_SEGT = LDS_AUX + 4096;
constexpr int LDS_BYTES = LDS_SEGT + 4096;

struct P {
    const float *x, *c, *ctx, *c_ctx, *w_mod, *b_mod, *norm_mix, *w_in, *ssd_conv_w, *ssd_conv_b, *ssd_dt_bias, *ssd_a_log, *ssd_d, *ssd_norm,
        *hgrn_lb, *hgrn_norm, *gdn_conv_w, *gdn_dt_bias, *gdn_a_log, *gdn_norm, *w_out, *norm_ffn, *router_w, *router_bias, *exp_gate, *exp_up,
        *exp_down, *sh_gate, *sh_up, *sh_down, *norm_final;
    float* out;
    unsigned char* ws;
};

__device__ __forceinline__ float bf2f(bf16_t v) { return __uint_as_float((unsigned)v << 16); }
__device__ __forceinline__ float bflo(unsigned v) { return __uint_as_float(v << 16); }
__device__ __forceinline__ float bfhi(unsigned v) { return __uint_as_float(v & 0xffff0000u); }
typedef float f32x2_t __attribute__((ext_vector_type(2)));
typedef __bf16 bf16x2_t __attribute__((ext_vector_type(2)));
__device__ __forceinline__ unsigned pk2(float lo, float hi) { const f32x2_t v = {lo, hi}; const bf16x2_t b = __builtin_convertvector(v, bf16x2_t); return __builtin_bit_cast(unsigned, b); }
__device__ __forceinline__ unsigned pk4_fp8(float a, float b, float c, float d) { int w = 0; w = __builtin_amdgcn_cvt_pk_fp8_f32(a, b, w, false); w = __builtin_amdgcn_cvt_pk_fp8_f32(c, d, w, true); return (unsigned)w; }
__device__ __forceinline__ u32x2 pack8_fp8(const float (&f)[8], float sc) { u32x2 o; o.x = pk4_fp8(f[0] * sc, f[1] * sc, f[2] * sc, f[3] * sc); o.y = pk4_fp8(f[4] * sc, f[5] * sc, f[6] * sc, f[7] * sc); return o; }
__device__ __forceinline__ unsigned pk4_i8(float a, float b, float c, float d, float inv) {
    unsigned w = 0;
    w = __builtin_amdgcn_cvt_pk_u8_f32(__builtin_rintf(a * inv) + 128.f, 0, w); w = __builtin_amdgcn_cvt_pk_u8_f32(__builtin_rintf(b * inv) + 128.f, 1, w);
    w = __builtin_amdgcn_cvt_pk_u8_f32(__builtin_rintf(c * inv) + 128.f, 2, w); w = __builtin_amdgcn_cvt_pk_u8_f32(__builtin_rintf(d * inv) + 128.f, 3, w);
    return w ^ 0x80808080u; }
__device__ __forceinline__ u32x2 pack8_i8(const float (&f)[8], float inv) { u32x2 o; o.x = pk4_i8(f[0], f[1], f[2], f[3], inv); o.y = pk4_i8(f[4], f[5], f[6], f[7], inv); return o; }
__device__ __forceinline__ float wave_max(float v) {
#pragma unroll
    for (int o = 1; o < 64; o <<= 1) v = fmaxf(v, __shfl_xor(v, o));
    return v;
}
__device__ __forceinline__ bf16_t f2bf(float f) { return (bf16_t)(pk2(f, 0.f) & 0xffffu); }
__device__ __forceinline__ float sigmoidf_(float x) { return __builtin_amdgcn_rcpf(1.f + __expf(-x)); }
__device__ __forceinline__ float siluf_(float x) { return x * __builtin_amdgcn_rcpf(1.f + __expf(-x)); }
__device__ __forceinline__ float softplusf_(float x) { return fmaxf(x, 0.f) + log1pf(__expf(-fabsf(x))); }
__device__ __forceinline__ int opaque_tid() { int t = threadIdx.x; asm volatile("" : "+v"(t)); return t; }
__device__ __forceinline__ float wave_sum(float v) {
#pragma unroll
    for (int o = 1; o < 64; o <<= 1) v += __shfl_xor(v, o);
    return v;
}
__device__ __forceinline__ int row_b(int row) { return row / TPS; }
__device__ __forceinline__ int row_pos(int row) { return row % TPS; }
__device__ __forceinline__ int mod_idx(int row) { return (row % TPS) < CTXL ? 8 : row / TPS; }
__device__ __forceinline__ const float* src_row_f32(const P& p, int row) {
    const int b = row / TPS, pos = row - b * TPS;
    return pos < CTXL ? p.ctx + ((size_t)b * CTXL + pos) * D : p.x + ((size_t)b * SEQ + (pos - CTXL)) * D;
}
__device__ __forceinline__ void unpack8(const u32x4 v, float (&f)[8]) {
    f[0] = bflo(v.x); f[1] = bfhi(v.x); f[2] = bflo(v.y); f[3] = bfhi(v.y); f[4] = bflo(v.z); f[5] = bfhi(v.z); f[6] = bflo(v.w); f[7] = bfhi(v.w);
}
__device__ __forceinline__ u32x4 pack8(const float (&f)[8]) { u32x4 o; o.x = pk2(f[0], f[1]); o.y = pk2(f[2], f[3]); o.z = pk2(f[4], f[5]); o.w = pk2(f[6], f[7]); return o; }

#define GAS __attribute__((address_space(1)))
template <class T> __device__ __forceinline__ T* launder_ptr(T* ptr) { unsigned long long v = (unsigned long long)ptr; asm volatile("" : "+s"(v)); return (T*)(GAS T*)v; }
#define XB_TMO      128
#define XB_XCNT(j)  (256  + 64 * (j))
#define XB_XSUB(j)  (1280 + 64 * (j))
#define XB_XGEN(j)  (2304 + 64 * (j))
#define XB_TOP      3328
#define XB_TOPGEN   3392
#define XCD_BAR_WORDS 3456
#define XB_SPIN_CAP (1u << 18)
__device__ __forceinline__ unsigned xb_ld(unsigned* p)              { return __hip_atomic_load(p, __ATOMIC_RELAXED, __HIP_MEMORY_SCOPE_AGENT); }
__device__ __forceinline__ unsigned xb_add(unsigned* p, unsigned v) { return __hip_atomic_fetch_add(p, v, __ATOMIC_RELAXED, __HIP_MEMORY_SCOPE_AGENT); }
__device__ __forceinline__ unsigned xb_xcc_id() { return (unsigned)__builtin_amdgcn_s_getreg((3 << 11) | 20) & 0xFu; }
#define XB_SPIN(cond, bar) do { unsigned _sp = 0; while (cond) { __builtin_amdgcn_s_sleep(1); \
    if ((++_sp & 255u) == 0u) { if (xb_ld(&(bar)[XB_TMO])) break; if (_sp > XB_SPIN_CAP) { atomicAdd(&(bar)[XB_TMO], 1u); break; } } } } while (0)
struct XcdBarrier { unsigned* bar; unsigned x; volatile LAS unsigned* st; };
__device__ __forceinline__ XcdBarrier xcd_barrier_post(unsigned* bar, volatile LAS unsigned* st) {
    XcdBarrier b; b.bar = bar; b.x = xb_xcc_id(); b.st = st;
    if (threadIdx.x == 0) (void)xb_add(&bar[XB_XCNT(b.x)], 1u);
    return b;
}
__device__ __forceinline__ void xcd_barrier_complete(unsigned* bar, unsigned x, unsigned& nloc, unsigned& nx) {
    const unsigned G = gridDim.x * gridDim.y * gridDim.z;
    unsigned sum, cnt, mine, sp = 0u;
    for (;;) {
        sum = 0u; cnt = 0u; mine = 0u;
#pragma unroll
        for (unsigned j = 0; j < 16; ++j) { const unsigned c = xb_ld(&bar[XB_XCNT(j)]); sum += c; cnt += (c > 0u) ? 1u : 0u; mine = (j == x) ? c : mine; }
        if (sum == G) break;
        __builtin_amdgcn_s_sleep(1);
        if ((++sp & 255u) == 0u) { if (xb_ld(&bar[XB_TMO])) break; if (sp > XB_SPIN_CAP) { atomicAdd(&bar[XB_TMO], 1u); break; } }
    }
    nloc = mine > 0u ? mine : 1u; nx = cnt > 0u ? cnt : 1u;
}
__device__ __forceinline__ void xcd_barrier(const XcdBarrier& b) {
    asm volatile("s_waitcnt vmcnt(0)" ::: "memory");
    __syncthreads();
    if (threadIdx.x == 0) {
        unsigned* bar = launder_ptr(b.bar);
        __builtin_amdgcn_s_waitcnt(0);
        const unsigned bx = xb_xcc_id();
        unsigned nloc = b.st[0], nx = b.st[1];
        if (nloc == 0u) { xcd_barrier_complete(bar, bx, nloc, nx); b.st[0] = nloc; b.st[1] = nx; }
        const unsigned old = xb_add(&bar[XB_XSUB(bx)], 1u);
        const unsigned gen = old / nloc;
        if (old + 1u == (gen + 1u) * nloc) {
            __builtin_amdgcn_fence(__ATOMIC_RELEASE, "agent");
            asm volatile("s_waitcnt vmcnt(0)" ::: "memory");
            const unsigned og = xb_add(&bar[XB_TOP], 1u);
            const unsigned tg = og / nx;
            if (og + 1u == (tg + 1u) * nx) xb_add(&bar[XB_TOPGEN], 1u);
            else XB_SPIN(xb_ld(&bar[XB_TOPGEN]) == tg, bar);
            __builtin_amdgcn_fence(__ATOMIC_ACQUIRE, "agent");
            xb_add(&bar[XB_XGEN(bx)], 1u);
            asm volatile("s_waitcnt vmcnt(0)" ::: "memory");
        } else {
            XB_SPIN(xb_ld(&bar[XB_XGEN(bx)]) == gen, bar);
            __builtin_amdgcn_fence(__ATOMIC_ACQUIRE, "agent");
            asm volatile("s_waitcnt vmcnt(0)" ::: "memory");
        }
    }
    __syncthreads();
}

namespace pg8 {
constexpr int BM = 256, BK = 64, HALF = 128, HTB = HALF * BK * 2, STAGE_BYTES = 8 * HTB;
__device__ __forceinline__ int lds_byte(int r, int c) { const int st = (r >> 4) * 2 + (c >> 5), rr = r & 15, cc = c & 31, ob = rr * 64 + cc * 2; return st * 1024 + (ob ^ (((ob >> 9) & 1) << 5)); }
__device__ __forceinline__ void stage_rc(int b, int& R, int& C) { const int st = b / 1024, sb = b % 1024, swz = sb ^ (((sb >> 9) & 1) << 5); R = (st >> 1) * 16 + swz / 64; C = (st & 1) * 32 + (swz % 64) / 2; }
__device__ __forceinline__ int perm32(int rho) { const int n = rho >> 4, i = rho & 15; return 8 * (i >> 2) + 4 * n + (i & 3); }
constexpr bool GEMM_SP2 = true;
constexpr bool GEMM_ALIGN = true;
struct Unit { int pm, pn, aux; };
typedef int i32x8 __attribute__((ext_vector_type(8)));
typedef int i32x8a __attribute__((ext_vector_type(8), aligned(16)));
typedef int i32x4 __attribute__((ext_vector_type(4)));
__device__ __forceinline__ i32x8 cat8(const bf16x8 lo, const bf16x8 hi) { const i32x4 a = __builtin_bit_cast(i32x4, lo), b = __builtin_bit_cast(i32x4, hi); return (i32x8){a[0], a[1], a[2], a[3], b[0], b[1], b[2], b[3]}; }
constexpr float W8_SCALE = 16.f;

template <class Epi, class Sched, int MODE = 0, bool SP2 = GEMM_SP2, bool ALIGN_EPI = GEMM_ALIGN>
__device__ __forceinline__ void gemm_phase(LAS unsigned char* lds, const void* Abase, const int K, const Sched& S, const Epi& E) {
    const int tid = opaque_tid(), wid = __builtin_amdgcn_readfirstlane(tid >> 6), lane = tid & 63, wr = wid >> 2, wc = wid & 3, fr = lane & 15, fq = lane >> 4;
    constexpr bool FP8 = (MODE == 1); constexpr int ESZ = MODE ? 1 : 2;
    const int nt = K * ESZ / (BK * 2);
    constexpr int PM = (int)Epi::PERM;
    unsigned voffB[2], voffB1[2];
#pragma unroll
    for (int i = 0; i < 2; ++i) { int R, C; stage_rc(tid * 16 + i * 8192, R, C);
        if constexpr (PM == 2) { const int w_ = R >> 5, n_ = (R >> 4) & 1, i_ = R & 15, rb = 64 * w_ + 16 * (i_ >> 2) + 4 * n_ + (i_ & 3);
            voffB[i] = (unsigned)(rb * K * ESZ + C * 2); voffB1[i] = (unsigned)((rb + 8) * K * ESZ + C * 2); }
        else { const int Rb = PM ? ((R & ~31) + perm32(R & 31)) : R;
            voffB[i] = (unsigned)(Rb * K * ESZ + C * 2); voffB1[i] = 0u; } }
    const size_t kstep = (size_t)(BK * 2);
    const size_t hstep = PM == 2 ? (size_t)0 : (size_t)HALF * K * ESZ;
#define PG8_VB1 (PM == 2 ? voffB1 : voffB)
    const unsigned ldsw = (unsigned)wid * 1024u;
    const int aoff = lds_byte(wr * 64 + fr, fq * 8), boff = lds_byte(wc * 32 + fr, fq * 8);
#define PG8_SA(b, h) (((b) * 2 + (h)) * HTB)
#define PG8_SB(b, h) ((4 + (b) * 2 + (h)) * HTB)
#define PG8_STAGE(bufoff, gbase, voff) do { _Pragma("unroll") for (int _i = 0; _i < 2; ++_i) \
        __builtin_amdgcn_global_load_lds((const unsigned*)((const char*)(gbase) + (voff)[_i]), (LAS unsigned*)(lds + (bufoff) + ldsw + _i * 8192), 16, 0, 0); } while (0)
#define PG8_LDA(dst, b, h) do { _Pragma("unroll") for (int m = 0; m < 4; ++m) { \
        if constexpr (FP8) dst##8[m] = cat8(*(const LAS bf16x8*)(lds + PG8_SA(b, h) + aoff + m * 2048), *(const LAS bf16x8*)(lds + PG8_SA(b, h) + aoff + m * 2048 + 1024));   \
        else { _Pragma("unroll") for (int k = 0; k < 2; ++k) dst[m][k] = *(const LAS bf16x8*)(lds + PG8_SA(b, h) + aoff + m * 2048 + k * 1024); } } } while (0)
#define PG8_LDB(dst, b, h) do { _Pragma("unroll") for (int n = 0; n < 2; ++n) { \
        if constexpr (FP8) dst##8[n] = cat8(*(const LAS bf16x8*)(lds + PG8_SB(b, h) + boff + n * 2048), *(const LAS bf16x8*)(lds + PG8_SB(b, h) + boff + n * 2048 + 1024)); \
        else { _Pragma("unroll") for (int k = 0; k < 2; ++k) dst[n][k] = *(const LAS bf16x8*)(lds + PG8_SB(b, h) + boff + n * 2048 + k * 1024); } } } while (0)
#define PG8_MMA(ai, bj, At, Bt) do { __builtin_amdgcn_s_setprio(1); _Pragma("unroll") for (int m = 0; m < 4; ++m) _Pragma("unroll") for (int n = 0; n < 2; ++n) { \
        if constexpr (FP8) asm volatile("v_mfma_f32_16x16x128_f8f6f4 %0, %1, %2, %0" : "+v"(acc[ai][bj][m][n]) : "v"(Bt##8[n]), "v"(At##8[m]));   \
        else if constexpr (MODE == 2) { _Pragma("unroll") for (int k = 0; k < 2; ++k) acc[ai][bj][m][n] = __builtin_bit_cast(f32x4, __builtin_amdgcn_mfma_i32_16x16x64_i8(__builtin_bit_cast(i32x4, Bt[n][k]), __builtin_bit_cast(i32x4, At[m][k]), __builtin_bit_cast(i32x4, acc[ai][bj][m][n]), 0, 0, 0)); } \
        else { _Pragma("unroll") for (int k = 0; k < 2; ++k) acc[ai][bj][m][n] = __builtin_amdgcn_mfma_f32_16x16x32_bf16(Bt[n][k], At[m][k], acc[ai][bj][m][n], 0, 0, 0); } } \
        __builtin_amdgcn_s_setprio(0); } while (0)
#define PG8_WAIT_V(n) asm volatile("s_waitcnt vmcnt(" #n ")" ::: "memory")
#define PG8_WAIT_L(n) asm volatile("s_waitcnt lgkmcnt(" #n ")" ::: "memory")
#define PG8_BAR __builtin_amdgcn_s_barrier()
#define PG8_SCHED __builtin_amdgcn_sched_barrier(0)
    Unit cur, nxt; int ui = 0;
    if (!S.next(0, cur)) return;
    f32x4 acc[2][2][4][2];
#pragma unroll
    for (int a = 0; a < 2; ++a)
#pragma unroll
        for (int b = 0; b < 2; ++b)
#pragma unroll
            for (int m = 0; m < 4; ++m)
#pragma unroll
                for (int n = 0; n < 2; ++n) acc[a][b][m][n] = (f32x4){0.f, 0.f, 0.f, 0.f};
    bf16x8 At[4][2], B0[2][2], B1[2][2];
    i32x8 At8[4], B08[2], B18[2];
    unsigned cvA[2][2], nvA[2][2];
    S.avoff(cur, cvA);
    const char* gA = (const char*)Abase;
    const char* cB = S.bptr(cur);
    if constexpr (Epi::AUX) E.stage_aux(lds, cur, 0);
    if constexpr (SP2) {
        PG8_STAGE(PG8_SB(0, 0), cB, voffB); PG8_STAGE(PG8_SB(0, 1), cB + hstep, PG8_VB1); PG8_STAGE(PG8_SA(0, 0), gA, cvA[0]); PG8_STAGE(PG8_SA(0, 1), gA, cvA[1]);
        if (wr == 1) PG8_BAR;
        PG8_WAIT_V(2); PG8_BAR;
        PG8_STAGE(PG8_SB(1, 0), cB + kstep, voffB); PG8_STAGE(PG8_SA(1, 0), gA + kstep, cvA[0]); PG8_STAGE(PG8_SB(1, 1), cB + hstep + kstep, PG8_VB1);
        PG8_WAIT_V(6); PG8_BAR;
    } else {
    PG8_STAGE(PG8_SB(0, 0), cB, voffB); PG8_STAGE(PG8_SA(0, 0), gA, cvA[0]); PG8_STAGE(PG8_SB(0, 1), cB + hstep, PG8_VB1); PG8_STAGE(PG8_SA(0, 1), gA, cvA[1]);
    if (wr == 1) PG8_BAR;
    PG8_WAIT_V(4); PG8_BAR;
    PG8_STAGE(PG8_SB(1, 0), cB + kstep, voffB); PG8_STAGE(PG8_SA(1, 0), gA + kstep, cvA[0]); PG8_STAGE(PG8_SB(1, 1), cB + hstep + kstep, PG8_VB1);
    PG8_WAIT_V(6); PG8_BAR;
    }
    for (;;) {
        const bool has_next = S.next(ui + 1, nxt);
        const char* nB = has_next ? S.bptr(nxt) : cB;
        if (has_next && !Sched::TAB_AVOFF) S.avoff(nxt, nvA);
        else {
#pragma unroll
            for (int h = 0; h < 2; ++h)
#pragma unroll
                for (int i = 0; i < 2; ++i) nvA[h][i] = cvA[h][i];
        }
#pragma unroll 1
        for (int t = 0; t < nt; t += 2) {
            const bool last = (t == nt - 2);
            if constexpr (Sched::TAB_AVOFF) { if (last && has_next) S.avoff_tab(nvA, (const LAS int*)(lds + LDS_AUX + ((ui + 1) & 1) * 2048)); }
            const char* a1 = gA + (size_t)(t + 1) * kstep;
            const char* a2 = last ? gA : gA + (size_t)(t + 2) * kstep; const char* b2 = last ? nB : cB + (size_t)(t + 2) * kstep;
            const char* a3 = a2 + kstep; const char* b3 = b2 + kstep;
            unsigned v2[2][2];
#pragma unroll
            for (int h = 0; h < 2; ++h)
#pragma unroll
                for (int i = 0; i < 2; ++i) v2[h][i] = last ? nvA[h][i] : cvA[h][i];
            if constexpr (SP2) {
            PG8_LDB(B0, 0, 0); PG8_LDB(B1, 0, 1); PG8_SCHED; PG8_LDA(At, 0, 0); PG8_STAGE(PG8_SA(1, 1), a1, cvA[1]);
            PG8_WAIT_V(8); PG8_WAIT_L(0); PG8_BAR; PG8_MMA(0, 0, At, B0); PG8_MMA(0, 1, At, B1); PG8_BAR; PG8_SCHED;
            if constexpr (Epi::AUX) { if (t == 0) E.stage_aux(lds, has_next ? nxt : cur, (ui + 1) & 1); }
            PG8_LDA(At, 0, 1); PG8_STAGE(PG8_SB(0, 0), b2, voffB); PG8_STAGE(PG8_SB(0, 1), b2 + hstep, PG8_VB1); PG8_STAGE(PG8_SA(0, 0), a2, v2[0]);
            PG8_WAIT_V(8); PG8_WAIT_L(0); PG8_BAR; PG8_MMA(1, 0, At, B0); PG8_MMA(1, 1, At, B1); PG8_BAR; PG8_SCHED;
            PG8_LDB(B0, 1, 0); PG8_LDB(B1, 1, 1); PG8_SCHED; PG8_LDA(At, 1, 0); PG8_STAGE(PG8_SA(0, 1), a2, v2[1]);
            PG8_WAIT_V(8); PG8_WAIT_L(0); PG8_BAR; PG8_MMA(0, 0, At, B0); PG8_MMA(0, 1, At, B1); PG8_BAR; PG8_SCHED;
            PG8_LDA(At, 1, 1); PG8_STAGE(PG8_SB(1, 0), b3, voffB); PG8_STAGE(PG8_SB(1, 1), b3 + hstep, PG8_VB1); PG8_STAGE(PG8_SA(1, 0), a3, v2[0]);
            PG8_WAIT_V(8); PG8_WAIT_L(0); PG8_BAR; PG8_MMA(1, 0, At, B0); PG8_MMA(1, 1, At, B1); PG8_BAR; PG8_SCHED;
            } else {
            PG8_LDB(B0, 0, 0); PG8_SCHED; PG8_LDA(At, 0, 0); PG8_STAGE(PG8_SA(1, 1), a1, cvA[1]);
            PG8_WAIT_L(8); PG8_BAR; PG8_WAIT_L(0); PG8_MMA(0, 0, At, B0); PG8_BAR; PG8_SCHED;
            PG8_LDB(B1, 0, 1); PG8_STAGE(PG8_SB(0, 0), b2, voffB);
            PG8_BAR; PG8_WAIT_L(0); PG8_MMA(0, 1, At, B1); PG8_BAR;
            PG8_LDA(At, 0, 1); PG8_STAGE(PG8_SA(0, 0), a2, v2[0]);
            PG8_BAR; PG8_WAIT_L(0); PG8_MMA(1, 0, At, B0); PG8_BAR; PG8_SCHED;
            PG8_STAGE(PG8_SB(0, 1), b2 + hstep, PG8_VB1);
            PG8_WAIT_V(6); PG8_BAR; PG8_MMA(1, 1, At, B1); PG8_BAR;
            PG8_LDB(B0, 1, 0); PG8_SCHED; PG8_LDA(At, 1, 0); PG8_STAGE(PG8_SA(0, 1), a2, v2[1]);
            PG8_WAIT_L(8); PG8_BAR; PG8_WAIT_L(0); PG8_MMA(0, 0, At, B0); PG8_BAR; PG8_SCHED;
            PG8_LDB(B1, 1, 1); PG8_STAGE(PG8_SB(1, 0), b3, voffB);
            PG8_BAR; PG8_WAIT_L(0); PG8_MMA(0, 1, At, B1); PG8_BAR;
            PG8_LDA(At, 1, 1); PG8_STAGE(PG8_SA(1, 0), a3, v2[0]);
            PG8_BAR; PG8_WAIT_L(0); PG8_MMA(1, 0, At, B0); PG8_BAR; PG8_SCHED;
            PG8_STAGE(PG8_SB(1, 1), b3 + hstep, PG8_VB1);
            PG8_WAIT_V(6); PG8_BAR; PG8_MMA(1, 1, At, B1); PG8_BAR;
            }
        }
        if constexpr (ALIGN_EPI) { if (wr == 0) PG8_BAR; }
        if constexpr (FP8) asm volatile("s_nop 15\n\ts_nop 15" ::: "memory");
        E(acc, cur, wr, wc, ui, fq);
        if (!has_next) break;
#pragma unroll
        for (int a = 0; a < 2; ++a)
#pragma unroll
            for (int b = 0; b < 2; ++b)
#pragma unroll
                for (int m = 0; m < 4; ++m)
#pragma unroll
                    for (int n = 0; n < 2; ++n) acc[a][b][m][n] = (f32x4){0.f, 0.f, 0.f, 0.f};
        cur = nxt; cB = nB; ++ui;
#pragma unroll
        for (int h = 0; h < 2; ++h)
#pragma unroll
            for (int i = 0; i < 2; ++i) cvA[h][i] = nvA[h][i];
        if constexpr (ALIGN_EPI) { if (wr == 1) PG8_BAR; }
    }
    PG8_WAIT_V(0);
    if constexpr (!ALIGN_EPI) { if (wr == 0) PG8_BAR; }
    PG8_BAR;
#undef PG8_SA
#undef PG8_VB1
#undef PG8_SB
#undef PG8_STAGE
#undef PG8_LDA
#undef PG8_LDB
#undef PG8_MMA
#undef PG8_WAIT_V
#undef PG8_WAIT_L
#undef PG8_BAR
#undef PG8_SCHED
}
}
using pg8::Unit; using pg8::W8_SCALE; using pg8::i32x4;

struct SchedDense {
    static constexpr bool TAB_AVOFF = false;
    const bf16_t* Bt; int K, nN, nUnits, G, c, latOnly, esz;
    __device__ __forceinline__ bool next(int i, Unit& u) const {
        const int L = i * G + c; if (L >= nUnits) return false;
        int wgid = L; { const int qq = nUnits / 8, rr = nUnits % 8, xcd = wgid % 8, off = wgid / 8; wgid = (xcd < rr ? xcd * (qq + 1) : rr * (qq + 1) + (xcd - rr) * qq) + off; }
        const int nM = nUnits / nN, nig = 8 * nN, gid = wgid / nig, fm = gid * 8, gsz = (nM - fm) < 8 ? (nM - fm) : 8;
        const int q = fm + ((wgid % nig) % gsz); u.pn = (wgid % nig) / gsz;
        u.pm = latOnly ? (q >> 5) * 33 + 1 + (q & 31) : q; u.aux = 0; return true;
    }
    __device__ __forceinline__ void avoff(const Unit& u, unsigned (&v)[2][2]) const {
        int R[2], C[2]; { const int t_ = opaque_tid(); pg8::stage_rc(t_ * 16, R[0], C[0]); pg8::stage_rc(t_ * 16 + 8192, R[1], C[1]); }
#pragma unroll
        for (int h = 0; h < 2; ++h)
#pragma unroll
            for (int i = 0; i < 2; ++i) v[h][i] = (unsigned)((u.pm * 256 + h * 128 + R[i]) * K * esz + C[i] * 2);
    }
    __device__ __forceinline__ const char* bptr(const Unit& u) const { return (const char*)Bt + (size_t)u.pn * 256 * K * esz; }
};
__device__ __forceinline__ int seg_find(const LAS int* segpan, int pp) { return ((const LAS unsigned char*)segpan)[(LDS_SEGT - LDS_TAB) + pp]; }
struct SchedS1 {
    static constexpr bool TAB_AVOFF = true;
    const LAS int* segpan; const int* rinfo; const bf16_t* w1t; const bf16_t* sh1t; int P0, nUnits, G, c;
    __device__ __forceinline__ bool next(int i, Unit& u) const {
        int L = i * G + c; if (L >= nUnits || c < 0) return false;
        { const int qq = nUnits / 8, rr = nUnits % 8, xcd = L % 8, off = L / 8; L = (xcd < rr ? xcd * (qq + 1) : rr * (qq + 1) + (xcd - rr) * qq) + off; }
        const int pp = P0 + (L >> 1); u.pn = L & 1; u.pm = pp; const int s = seg_find(segpan, pp); u.aux = s; return true;
    }
    __device__ __forceinline__ void avoff(const Unit& u, unsigned (&v)[2][2]) const {
        int R[2], C[2]; { const int t_ = opaque_tid(); pg8::stage_rc(t_ * 16, R[0], C[0]); pg8::stage_rc(t_ * 16 + 8192, R[1], C[1]); }
#pragma unroll
        for (int h = 0; h < 2; ++h)
#pragma unroll
            for (int i = 0; i < 2; ++i) { const int info = rinfo[u.pm * 256 + h * 128 + R[i]]; const int tok = info < 0 ? 0 : (info >> 4); v[h][i] = (unsigned)(tok * D + 2 * C[i]); }
    }
    __device__ __forceinline__ void avoff_tab(unsigned (&v)[2][2], const LAS int* tab) const {
        int R[2], C[2]; { const int t_ = opaque_tid(); pg8::stage_rc(t_ * 16, R[0], C[0]); pg8::stage_rc(t_ * 16 + 8192, R[1], C[1]); }
#pragma unroll
        for (int h = 0; h < 2; ++h)
#pragma unroll
            for (int i = 0; i < 2; ++i) { const int info = tab[h * 128 + R[i]]; const int tok = info < 0 ? 0 : (info >> 4); v[h][i] = (unsigned)(tok * D + 2 * C[i]); }
    }
    __device__ __forceinline__ const char* bptr(const Unit& u) const {
        return u.aux < 64 ? (const char*)w1t + ((size_t)u.aux * 512 + u.pn * 256) * D : (const char*)sh1t + (size_t)u.pn * 256 * D;
    }
};
struct SchedS2 {
    static constexpr bool TAB_AVOFF = false;
    const LAS int* segpan; const bf16_t* w2t; const bf16_t* sh2t; int P0, nUnits, G, c, nR;
    __device__ __forceinline__ bool next(int i, Unit& u) const {
        int L = i * G + c; if (L >= nUnits || c < 0) return false;
        { const int qq = nUnits / 8, rr = nUnits % 8, qr = nR / 8, rq = nR % 8, xcd = L % 8, off = L / 8;
            const int t0 = xcd * qq + (xcd < rr ? xcd : rr), r0 = xcd * qr + (xcd < rq ? xcd : rq);
            const int cS = (qq + (xcd < rr ? 1 : 0)) - (qr + (xcd < rq ? 1 : 0));
            L = off < cS ? nR + (t0 - r0) + off : r0 + (off - cS); }
        const int pp = P0 + (L >> 2); u.pn = L & 3; u.pm = pp; const int s = seg_find(segpan, pp); u.aux = s; return true;
    }
    __device__ __forceinline__ void avoff(const Unit& u, unsigned (&v)[2][2]) const {
        int R[2], C[2]; { const int t_ = opaque_tid(); pg8::stage_rc(t_ * 16, R[0], C[0]); pg8::stage_rc(t_ * 16 + 8192, R[1], C[1]); }
#pragma unroll
        for (int h = 0; h < 2; ++h)
#pragma unroll
            for (int i = 0; i < 2; ++i) v[h][i] = (unsigned)((u.pm * 256 + h * 128 + R[i]) * 256 + C[i] * 2);
    }
    __device__ __forceinline__ const char* bptr(const Unit& u) const {
        return u.aux < 64 ? (const char*)w2t + ((size_t)u.aux * 1024 + u.pn * 256) * 256 : (const char*)sh2t + (size_t)u.pn * 256 * 256;
    }
};

struct EpiU {
    static constexpr bool AUX = true; static constexpr bool PERM = true;
    bf16_t* U; const float* hgrn_lb; const float* rs; const float* cs; int layer; LAS unsigned char* ldsb;
    __device__ __forceinline__ void stage_aux(LAS unsigned char* lds, const Unit& u, int par) const {
        const int tid_ = opaque_tid(), w_ = __builtin_amdgcn_readfirstlane(tid_ >> 6);
        if (w_ < 4) __builtin_amdgcn_global_load_lds((const unsigned*)(rs + u.pm * 256 + w_ * 64 + (tid_ & 63)), (LAS unsigned*)(lds + LDS_AUX + par * 2048 + w_ * 256), 4, 0, 0);
        else __builtin_amdgcn_global_load_lds((const unsigned*)(cs + u.pn * 256 + (w_ - 4) * 64 + (tid_ & 63)), (LAS unsigned*)(lds + LDS_AUX + par * 2048 + 1024 + (w_ - 4) * 256), 4, 0, 0);
    }
    __device__ __forceinline__ void operator()(const f32x4 (&acc)[2][2][4][2], const Unit& u, int wr, int wc, int ui, int) const {
        const int ln_ = opaque_tid() & 63, fr = ln_ & 15, fq = ln_ >> 4;
        const int row0 = u.pm * 256 + wr * 64 + fr, col0 = u.pn * 256 + wc * 32 + 8 * fq;
        const LAS float* tabr = (const LAS float*)(ldsb + LDS_AUX + (ui & 1) * 2048); const LAS float* tabc = tabr + 256;
        float rsv[8];
#pragma unroll
        for (int i = 0; i < 8; ++i) rsv[i] = tabr[wr * 64 + fr + (i >> 2) * 128 + (i & 3) * 16];
#pragma unroll
        for (int bj = 0; bj < 2; ++bj) { const int col = col0 + bj * 128;
            if (col < UC) {
                const int kind = (col >= C_HQ && col < C_HF) ? 1 : ((col >= C_HF && col < C_HI) ? 2 : 0);
                const f32x4 cs0 = *(const LAS f32x4*)(tabc + (col - u.pn * 256)), cs1 = *(const LAS f32x4*)(tabc + (col - u.pn * 256) + 4);
                float om[8];
#pragma unroll
                for (int j = 0; j < 8; ++j) om[j] = 1.f;
                if (kind == 2 && layer == 1) { const int ch = (col - C_HF) & 255;
#pragma unroll
                    for (int j = 0; j < 8; ++j) om[j] = 1.f - 1.f / (1.f + __expf(hgrn_lb[ch + j] - hgrn_lb[256 + ch + j])); }
#pragma unroll
                for (int ai = 0; ai < 2; ++ai)
#pragma unroll
                    for (int m = 0; m < 4; ++m) { bf16_t* rowp = U + (size_t)(row0 + ai * 128 + m * 16) * UC;
                        float v[8];
                        { const i32x4 q0 = __builtin_bit_cast(i32x4, acc[ai][bj][m][0]), q1 = __builtin_bit_cast(i32x4, acc[ai][bj][m][1]); const float rr = rsv[ai * 4 + m];
#pragma unroll
                            for (int j = 0; j < 4; ++j) { v[j] = (float)q0[j] * (rr * cs0[j]); v[4 + j] = (float)q1[j] * (rr * cs1[j]); } }
                        if (kind == 1) {
#pragma unroll
                            for (int j = 0; j < 8; ++j) v[j] = siluf_(v[j]); }
                        else if (kind == 2) {
#pragma unroll
                            for (int j = 0; j < 8; ++j) v[j] = om[j] * sigmoidf_(-v[j]); }
                        *(u32x4*)(rowp + col) = pack8(v); } } }
    }
};
struct EpiRes {
    static constexpr bool AUX = false; static constexpr bool PERM = true;
    const float* xin; const float* cin; bf16_t* HB; const float* mod;
    int layer;
    __device__ __forceinline__ void operator()(const f32x4 (&acc)[2][2][4][2], const Unit& u, int wr, int wc, int, int) const {
        const int ln_ = opaque_tid() & 63, fr = ln_ & 15, fq = ln_ >> 4;
        const int row0 = u.pm * 256 + wr * 64 + fr, col0 = u.pn * 256 + wc * 32 + 8 * fq;
        const int mi = (u.pm % 33 == 0) ? 8 : u.pm / 33;
        const float* gm = mod + (size_t)mi * 6144 + 2048;
#pragma unroll
        for (int bj = 0; bj < 2; ++bj) { const int col = col0 + bj * 128;
            const f32x4 g0 = *(const f32x4*)(gm + col), g1 = *(const f32x4*)(gm + col + 4);
#pragma unroll
            for (int ai = 0; ai < 2; ++ai) {
                f32x4 ra[4], rb[4];
                if (layer == 0) {
#pragma unroll
                    for (int m = 0; m < 4; ++m) { const int row = row0 + ai * 128 + m * 16; const int b_ = row / TPS, pos_ = row - b_ * TPS;
                        const float* xr = (pos_ < CTXL ? cin + ((size_t)b_ * CTXL + pos_) * D : xin + ((size_t)b_ * SEQ + (pos_ - CTXL)) * D) + col; ra[m] = *(const f32x4*)xr; rb[m] = *(const f32x4*)(xr + 4); } }
                else {
#pragma unroll
                    for (int m = 0; m < 4; ++m) { const int row = row0 + ai * 128 + m * 16; const u32x4 hv = *(const u32x4*)(HB + (size_t)row * D + col); float o[8]; unpack8(hv, o);
                        ra[m] = (f32x4){o[0], o[1], o[2], o[3]}; rb[m] = (f32x4){o[4], o[5], o[6], o[7]}; } }
#pragma unroll
                for (int m = 0; m < 4; ++m) { const int row = row0 + ai * 128 + m * 16;
                    float o[8];
                    const f32x4 v0 = acc[ai][bj][m][0], v1 = acc[ai][bj][m][1];
#pragma unroll
                    for (int j = 0; j < 4; ++j) { o[j] = ra[m][j] + g0[j] * v0[j]; o[4 + j] = rb[m][j] + g1[j] * v1[j]; }
                    *(u32x4*)(HB + (size_t)row * D + col) = pack8(o); } } }
    }
};
struct EpiRouter {
    static constexpr bool AUX = false; static constexpr bool PERM = false;
    float* SC;
    __device__ __forceinline__ void operator()(const f32x4 (&acc)[2][2][4][2], const Unit& u, int wr, int wc, int, int) const {
        const int ln_ = opaque_tid() & 63, fr = ln_ & 15, fq = ln_ >> 4;
        if (wc >= 2) return;
        const int row0 = u.pm * 256 + wr * 64 + fr, col0 = wc * 32 + 4 * fq;
#pragma unroll
        for (int ai = 0; ai < 2; ++ai)
#pragma unroll
            for (int m = 0; m < 4; ++m)
#pragma unroll
                for (int n = 0; n < 2; ++n) { const f32x4 v = acc[ai][0][m][n]; f32x4 o;
#pragma unroll
                    for (int j = 0; j < 4; ++j) o[j] = sigmoidf_(v[j]);
                    *(f32x4*)(SC + (size_t)(row0 + ai * 128 + m * 16) * 64 + col0 + n * 16) = o; }
    }
};
struct EpiGLU {
    static constexpr bool AUX = true; static constexpr bool PERM = true;
    bf16_t* H; const float* rgate; const int* rinfo; LAS unsigned char* ldsb;
    __device__ __forceinline__ void stage_aux(LAS unsigned char* lds, const Unit& u, int par) const {
        const int tid_ = opaque_tid(), w_ = __builtin_amdgcn_readfirstlane(tid_ >> 6);
        if (w_ < 4) __builtin_amdgcn_global_load_lds((const unsigned*)(rinfo + u.pm * 256 + w_ * 64 + (tid_ & 63)), (LAS unsigned*)(lds + LDS_AUX + par * 2048 + w_ * 256), 4, 0, 0);
        else __builtin_amdgcn_global_load_lds((const unsigned*)(rgate + u.pm * 256 + (w_ - 4) * 64 + (tid_ & 63)), (LAS unsigned*)(lds + LDS_AUX + par * 2048 + 1024 + (w_ - 4) * 256), 4, 0, 0);
    }
    __device__ __forceinline__ void operator()(const f32x4 (&acc)[2][2][4][2], const Unit& u, int wr, int wc, int ui, int) const {
        const int ln_ = opaque_tid() & 63, fr = ln_ & 15, fq = ln_ >> 4;
        const int row0 = u.pm * 256 + wr * 64 + fr, col0 = u.pn * 128 + wc * 32 + 8 * fq;
        const LAS float* tab = (const LAS float*)(ldsb + LDS_AUX + (ui & 1) * 2048 + 1024);
        float rg[8];
#pragma unroll
        for (int i = 0; i < 8; ++i) rg[i] = tab[wr * 64 + fr + (i >> 2) * 128 + (i & 3) * 16];
        float rgs[8];
#pragma unroll
        for (int i = 0; i < 8; ++i) rgs[i] = rg[i] * (HACT_SCALE / (W8_SCALE * W8_SCALE));
#pragma unroll
        for (int ai = 0; ai < 2; ++ai)
#pragma unroll
            for (int m = 0; m < 4; ++m) { float o[8];
#pragma unroll
                for (int n = 0; n < 2; ++n)
#pragma unroll
                    for (int j = 0; j < 4; ++j) { const float g = acc[ai][0][m][n][j], up = acc[ai][1][m][n][j];
                        o[n * 4 + j] = (rgs[ai * 4 + m] * g) * up * __builtin_amdgcn_rcpf(1.f + __builtin_amdgcn_exp2f(g * (-1.4426950408889634f / W8_SCALE))); }
                *(u32x2*)((unsigned char*)H + (size_t)(row0 + ai * 128 + m * 16) * 256 + col0) = pack8_fp8(o, 1.f); }
    }
};
struct EpiMoE {
    static constexpr int PERM = 2;
    static constexpr bool AUX = true;
    const int* rinfo; const float* mod; unsigned char* ws; LAS unsigned char* xs;
    __device__ __forceinline__ void stage_aux(LAS unsigned char* lds, const Unit& u, int par) const {
        const int tid_ = opaque_tid(), w_ = __builtin_amdgcn_readfirstlane(tid_ >> 6);
        if (w_ < 4) __builtin_amdgcn_global_load_lds((const unsigned*)(rinfo + u.pm * 256 + w_ * 64 + (tid_ & 63)), (LAS unsigned*)(lds + LDS_AUX + par * 2048 + w_ * 256), 4, 0, 0);
    }
    __device__ __forceinline__ void operator()(const f32x4 (&acc)[2][2][4][2], const Unit& u, int wr, int wc, int ui, int) const {
        const int tid_ = opaque_tid(), ln_ = tid_ & 63, fr = ln_ & 15, fq = ln_ >> 4;
        const LAS int* tab = (const LAS int*)(xs - LDS_XS + LDS_AUX + (ui & 1) * 2048);
        if (u.aux < 64) {
            LAS unsigned char* sx = xs + (tid_ >> 6) * XS_WAVE;
            const int tr = ln_ >> 2, tc = ln_ & 3;
            int inf[8];
#pragma unroll
            for (int i = 0; i < 8; ++i) inf[i] = tab[wr * 64 + tr + (i >> 2) * 128 + (i & 3) * 16];
#pragma unroll
            for (int ai = 0; ai < 2; ++ai)
#pragma unroll
                for (int m = 0; m < 4; ++m) { u32x4 w;
#pragma unroll
                    for (int bj = 0; bj < 2; ++bj)
#pragma unroll
                        for (int n = 0; n < 2; ++n) { const f32x4 v = acc[ai][bj][m][n];
                            w[bj * 2 + n] = pk4_fp8(v[0], v[1], v[2], v[3]); }
                    *(LAS u32x4*)(sx + fr * 80 + fq * 16) = w;
                    const u32x4 t = *(const LAS u32x4*)(sx + tr * 80 + tc * 16);
                    const int info = inf[ai * 4 + m];
                    if (info >= 0) { const unsigned tok = (unsigned)info >> 4, k = (unsigned)info & 15u;
                        const unsigned base = k == 0u ? (unsigned)(OFF_AB + SLOT_BYTES) : (k < 3u ? (unsigned)(OFF_Y2 - SLOT_BYTES) : (unsigned)(OFF_SLOTU - 3 * SLOT_BYTES));
                        *(u32x4*)(ws + (base + k * (unsigned)SLOT_BYTES + tok * (unsigned)D + (unsigned)(u.pn * 256 + wc * 64 + tc * 16))) = t; } }
        } else {
            const int col0 = u.pn * 256 + wc * 64 + 16 * fq;
            int inf[8];
#pragma unroll
            for (int i = 0; i < 8; ++i) inf[i] = tab[wr * 64 + fr + (i >> 2) * 128 + (i & 3) * 16];
            int bcur = -1; f32x4 gq[2][2];
#pragma unroll
            for (int bj = 0; bj < 2; ++bj) { gq[bj][0] = (f32x4){0.f, 0.f, 0.f, 0.f}; gq[bj][1] = (f32x4){0.f, 0.f, 0.f, 0.f}; }
#pragma unroll
            for (int ai = 0; ai < 2; ++ai) {
                u32x4 old[4][2];
#pragma unroll
                for (int m = 0; m < 4; ++m) { const int info = inf[ai * 4 + m];
                    old[m][0] = (u32x4){0u, 0u, 0u, 0u}; old[m][1] = (u32x4){0u, 0u, 0u, 0u};
                    if (info >= 0) { const int tok = info >> 4;
                        const bf16_t* src = (const bf16_t*)(ws + OFF_HB) + (size_t)tok * D + col0;
                        old[m][0] = *(const u32x4*)src; old[m][1] = *(const u32x4*)(src + 8); } }
#pragma unroll
                for (int m = 0; m < 4; ++m) { const int info = inf[ai * 4 + m];
                    if (info >= 0) { const int tok = info >> 4;
                        bf16_t* dst = (bf16_t*)(ws + OFF_HB) + (size_t)tok * D + col0;
                        const int bb = mod_idx(tok);
                        if (bb != bcur) { const float* gf = mod + (size_t)bb * 6144 + 5120 + col0;
#pragma unroll
                            for (int bj = 0; bj < 2; ++bj) { gq[bj][0] = *(const f32x4*)(gf + bj * 8); gq[bj][1] = *(const f32x4*)(gf + bj * 8 + 4); }
                            bcur = bb; }
#pragma unroll
                        for (int bj = 0; bj < 2; ++bj) { float o[8]; unpack8(old[m][bj], o);
                            const f32x4 v0 = acc[ai][bj][m][0], v1 = acc[ai][bj][m][1];
#pragma unroll
                            for (int j = 0; j < 4; ++j) { o[j] += gq[bj][0][j] * (v0[j] * (1.f / SLOT_SCALE)); o[4 + j] += gq[bj][1][j] * (v1[j] * (1.f / SLOT_SCALE)); }
                            *(u32x4*)(dst + bj * 8) = pack8(o); } } }
            }
            __builtin_amdgcn_s_waitcnt(0x0F70);
        }
    }
};

__device__ __forceinline__ void transpose_load(const float* src, int K, int N, int tile, float (&r)[8]) {
    const int t = opaque_tid();
    const int nTn = (N + 63) / 64, kb = tile / nTn, nb = tile - kb * nTn, k0 = kb * 64, n0 = nb * 64, n = t & 63;
#pragma unroll
    for (int q = 0; q < 8; ++q) r[q] = (n0 + n < N) ? src[(size_t)(k0 + q * 8 + (t >> 6)) * N + n0 + n] : 0.f;
}
__device__ __forceinline__ void transpose_store(LAS float* scr, int K, int N, bf16_t* dst, int mode, int tile, float fp8scale, const float* qs) {
    const int t = opaque_tid();
    const int nTn = (N + 63) / 64, kb = tile / nTn, nb = tile - kb * nTn, k0 = kb * 64, n0 = nb * 64;
    { const int n = t >> 3, kc = t & 7;
        if (n0 + n < N) { float f[8];
#pragma unroll
            for (int j = 0; j < 8; ++j) f[j] = scr[(kc * 8 + j) * 65 + n];
            const int gn = n0 + n; const int row = mode == 0 ? gn : ((gn >> 7) * 256 + (mode == 2 ? 128 : 0) + (gn & 127));
            if (qs) *(u32x2*)((unsigned char*)dst + (size_t)row * K + k0 + kc * 8) = pack8_i8(f, 1.f / qs[row]);
            else if (fp8scale > 0.f) *(u32x2*)((unsigned char*)dst + (size_t)row * K + k0 + kc * 8) = pack8_fp8(f, fp8scale);
            else *(u32x4*)(dst + (size_t)row * K + k0 + kc * 8) = pack8(f); } }
}
__device__ __forceinline__ void transpose_job(const float* src, int K, int N, bf16_t* dst, int mode, LAS float* scr, float fp8scale = 0.f, const float* qs = nullptr) {
    const int t = opaque_tid();
    const int nt = (K / 64) * ((N + 63) / 64), G = (int)gridDim.x;
    float cur[8], nxt[8];
    int tile = blockIdx.x;
    if (tile < nt) transpose_load(src, K, N, tile, cur);
    for (; tile < nt; tile += G) {
#pragma unroll
        for (int q = 0; q < 8; ++q) scr[(q * 8 + (t >> 6)) * 65 + (t & 63)] = cur[q];
        __syncthreads();
        if (tile + G < nt) transpose_load(src, K, N, tile + G, nxt);
        transpose_store(scr, K, N, dst, mode, tile, fp8scale, qs);
        __syncthreads();
#pragma unroll
        for (int q = 0; q < 8; ++q) cur[q] = nxt[q];
    }
}

__device__ __forceinline__ void phase_transposes(const P& p, LAS unsigned char* lds) {
    const int tix = opaque_tid();
    unsigned char* ws = p.ws;
    LAS float* scr = (LAS float*)lds;
    __syncthreads();
    for (int l = 0; l < 2; ++l) {
        transpose_job(p.w_in + (size_t)l * D * UC, D, UC, (bf16_t*)(ws + OFF_WINT + (size_t)l * NWIN * D), 0, scr, 0.f, (const float*)(ws + OFF_SCL) + SCL_WIN + l * 4096);
        transpose_job(p.w_out + (size_t)l * D * D, D, D, (bf16_t*)(ws + OFF_WOUTT) + (size_t)l * D * D, 0, scr);
        transpose_job(p.sh_gate + (size_t)l * D * 256, D, 256, (bf16_t*)(ws + OFF_SH1T + (size_t)l * 512 * D), 1, scr, W8_SCALE);
        transpose_job(p.sh_up + (size_t)l * D * 256, D, 256, (bf16_t*)(ws + OFF_SH1T + (size_t)l * 512 * D), 2, scr, W8_SCALE);
        transpose_job(p.sh_down + (size_t)l * 256 * D, 256, D, (bf16_t*)(ws + OFF_SH2T + (size_t)l * D * 256), 0, scr, W2_SCALE);
        transpose_job(p.router_w + (size_t)l * D * 64, D, 64, (bf16_t*)(ws + OFF_RT) + (size_t)l * 256 * D, 0, scr);
        { u32x4* z = (u32x4*)(ws + OFF_WINT + ((size_t)l * NWIN + UC) * D); const int n = (NWIN - UC) * D / 16;
            for (int i = blockIdx.x * NTHR + tix; i < n; i += gridDim.x * NTHR) z[i] = (u32x4){0u, 0u, 0u, 0u}; }
        { u32x4* z = (u32x4*)((bf16_t*)(ws + OFF_RT) + ((size_t)l * 256 + 64) * D); const int n = 192 * D / 8;
            for (int i = blockIdx.x * NTHR + tix; i < n; i += gridDim.x * NTHR) z[i] = (u32x4){0u, 0u, 0u, 0u}; }
    }
}
__device__ __forceinline__ void colscale_job(const float* src, int K, int N, float* cs, int Npad, LAS unsigned char* lds, int wg0) {
    const int tix = opaque_tid(), w = tix >> 6, lane = tix & 63;
    LAS float* red = (LAS float*)lds;
    for (int g = ((int)blockIdx.x - wg0 + (int)gridDim.x) % (int)gridDim.x; g < Npad / 64; g += gridDim.x) { const int n = g * 64 + lane; float m = 0.f;
        if (n < N) { const int k0 = w * (K / 8);
#pragma unroll 1
            for (int kk = k0; kk < k0 + K / 8; kk += 32) { float wv[32];
#pragma unroll
                for (int j = 0; j < 32; ++j) wv[j] = src[(size_t)(kk + j) * N + n];
#pragma unroll
                for (int j = 0; j < 32; ++j) m = fmaxf(m, fabsf(wv[j])); } }
        red[w * 64 + lane] = m;
        __syncthreads();
        if (w == 0) {
#pragma unroll
            for (int ww = 1; ww < 8; ++ww) m = fmaxf(m, red[ww * 64 + lane]);
            cs[n] = fmaxf(m, 1e-20f) * (1.f / 127.f); }
        __syncthreads(); }
}
__device__ __forceinline__ void phase_prologue(const P& p, LAS unsigned char* lds) {
    const int tix = opaque_tid();
    unsigned char* ws = p.ws;
    for (int l = 0; l < 2; ++l) colscale_job(p.w_in + (size_t)l * D * UC, D, UC, (float*)(ws + OFF_SCL) + SCL_WIN + l * 4096, 4096, lds, 192 - 64 * l);
    __syncthreads();
    LAS float* sc = (LAS float*)lds;
    LAS float* part = (LAS float*)(lds + 9 * 1024 * 4);
    __syncthreads();
    { float cv[18];
#pragma unroll
        for (int q = 0; q < 18; ++q) { const int i = tix + q * NTHR, s = i >> 10, k = i & 1023; cv[q] = s < 8 ? p.c[s * 1024 + k] : p.c_ctx[k]; }
#pragma unroll
        for (int q = 0; q < 18; ++q) sc[tix + q * NTHR] = siluf_(cv[q]); }
    __syncthreads();
    const int w = tix >> 6, lane = tix & 63;
    for (int item = blockIdx.x; item < 2 * 96; item += gridDim.x) {
        const int l = item / 96, cg = item - l * 96, col = cg * 64 + lane;
        const float* wm = p.w_mod + (size_t)l * D * 6144 + col;
        float a[9];
#pragma unroll
        for (int s = 0; s < 9; ++s) a[s] = 0.f;
#pragma unroll 1
        for (int k0 = w * 128; k0 < w * 128 + 128; k0 += 32) { float wv[32];
#pragma unroll
            for (int j = 0; j < 32; ++j) wv[j] = wm[(size_t)(k0 + j) * 6144];
#pragma unroll
            for (int j = 0; j < 32; ++j)
#pragma unroll
                for (int s = 0; s < 9; ++s) a[s] += sc[s * 1024 + k0 + j] * wv[j]; }
#pragma unroll
        for (int s = 0; s < 9; ++s) part[(w * 9 + s) * 64 + lane] = a[s];
        __syncthreads();
        for (int i = tix; i < 9 * 64; i += NTHR) { const int s = i >> 6, ln = i & 63; float v = p.b_mod[(size_t)l * 6144 + cg * 64 + ln];
#pragma unroll
            for (int ww = 0; ww < 8; ++ww) v += part[(ww * 9 + s) * 64 + ln];
            ((float*)(ws + OFF_MOD))[((size_t)l * 9 + s) * 6144 + cg * 64 + ln] = v; }
        __syncthreads();
    }
}

__device__ __forceinline__ void cvt_load_tile(const float* src, int N, int tile, int tix, float (&r)[8]) {
    const int nTn = N / 64, kb = tile / nTn, nb = tile - kb * nTn;
#pragma unroll
    for (int q = 0; q < 8; ++q) r[q] = src[(size_t)(kb * 64 + q * 8 + (tix >> 6)) * N + nb * 64 + (tix & 63)];
}
__device__ __forceinline__ void cvt_store_tile(const LAS float* scr, bf16_t* dst, int K, int N, int mode, int tile, int tix, float fp8scale) {
    const int nTn = N / 64, kb = tile / nTn, nb = tile - kb * nTn, n = tix >> 3, kc = tix & 7; float f[8];
#pragma unroll
    for (int j = 0; j < 8; ++j) f[j] = scr[(kc * 8 + j) * 65 + n];
    const int gn = nb * 64 + n; const int row = mode == 0 ? gn : ((gn >> 7) * 256 + (mode == 2 ? 128 : 0) + (gn & 127));
    if (fp8scale > 0.f) *(u32x2*)((unsigned char*)dst + (size_t)row * K + kb * 64 + kc * 8) = pack8_fp8(f, fp8scale);
    else *(u32x4*)(dst + (size_t)row * K + kb * 64 + kc * 8) = pack8(f);
}
__device__ __forceinline__ void phase_expert_cvt(const P& p, int l, LAS unsigned char* lds, int it0, int it1, int stride) {
    const int tix = opaque_tid();
    bf16_t* w1t = (bf16_t*)(p.ws + OFF_W1T); bf16_t* w2t = (bf16_t*)(p.ws + OFF_W2T);
    float cur[8], nxt[8];
#define CVT_LOAD(itv, regs) do { const int e_ = (itv) / 192, r_ = (itv) - e_ * 192, wh_ = r_ >> 6, tl_ = r_ & 63; const size_t eo_ = ((size_t)l * 64 + e_) * D * 256; \
        if (wh_ == 0) cvt_load_tile(p.exp_gate + eo_, 256, tl_, tix, regs); else if (wh_ == 1) cvt_load_tile(p.exp_up + eo_, 256, tl_, tix, regs); else cvt_load_tile(p.exp_down + eo_, D, tl_, tix, regs); } while (0)
    int it = it0, buf = 0;
    if (it < it1) CVT_LOAD(it, cur);
    for (; it < it1; it += stride) {
        LAS float* scr = (LAS float*)lds + buf * (64 * 65);
#pragma unroll
        for (int q = 0; q < 8; ++q) scr[(q * 8 + (tix >> 6)) * 65 + (tix & 63)] = cur[q];
        __syncthreads();
        if (it + stride < it1) CVT_LOAD(it + stride, nxt);
        { const int e = it / 192, r = it - e * 192, which = r >> 6, tile = r & 63;
            if (which == 0) cvt_store_tile(scr, (bf16_t*)((unsigned char*)w1t + (size_t)e * 512 * D), D, 256, 1, tile, tix, W8_SCALE);
            else if (which == 1) cvt_store_tile(scr, (bf16_t*)((unsigned char*)w1t + (size_t)e * 512 * D), D, 256, 2, tile, tix, W8_SCALE);
            else cvt_store_tile(scr, (bf16_t*)((unsigned char*)w2t + (size_t)e * D * 256), 256, D, 0, tile, tix, W2_SCALE); }
#pragma unroll
        for (int q = 0; q < 8; ++q) cur[q] = nxt[q];
        buf ^= 1;
    }
#undef CVT_LOAD
    __syncthreads();
}

template <int SRC, bool FINAL>
__device__ __forceinline__ void phase_norm(const P& p, int l, const float* normw, int sc_off, int sh_off, bool lat_only) {
    const int tix = opaque_tid();
    unsigned char* ws = p.ws;
    const int gw = blockIdx.x * 8 + (tix >> 6), lane = tix & 63;
#define CB(i) (SRC == 2 ? lane * 16 + (i) * 8 : (i) * 512 + lane * 8)
    const bf16_t* HB = (const bf16_t*)(ws + OFF_HB);
    const float* modg = (const float*)(ws + OFF_MOD) + (size_t)(FINAL ? l : l - 1) * 9 * 6144 + 5120;
    bf16_t* dst = (bf16_t*)(ws + OFF_AB);
    const float* mod = (const float*)(ws + OFF_MOD) + (size_t)l * 9 * 6144;
    float nw[16];
#pragma unroll
    for (int i = 0; i < 2; ++i)
#pragma unroll
        for (int j = 0; j < 8; ++j) nw[i * 8 + j] = normw[CB(i) + j];
    constexpr int NRAW = SRC == 0 ? 4 : (SRC == 1 ? 2 : 10);
    constexpr bool D3 = (SRC != 2);
    u32x4 cur[NRAW], nxt[NRAW], nx2[D3 ? NRAW : 1];
    auto valid = [&](int row) { return !((lat_only || FINAL) && (row % TPS) < CTXL); };
    auto load = [&](int row, u32x4 (&r)[NRAW]) {
        if (SRC == 0) { const float* xr = src_row_f32(p, row);
#pragma unroll
            for (int i = 0; i < 2; ++i) { r[2 * i] = *(const u32x4*)(xr + CB(i)); r[2 * i + 1] = *(const u32x4*)(xr + CB(i) + 4); } }
        else {
#pragma unroll
            for (int i = 0; i < 2; ++i) { const size_t o = (size_t)row * D + CB(i); r[i] = *(const u32x4*)(HB + o); }
            if (SRC == 2) {
#pragma unroll
                for (int k = 0; k < 8; ++k) r[2 + k] = *(const u32x4*)(ws + slot_off(k) + (size_t)row * D + lane * 16); } }
    };
    int mcur = -1; f32x4 msc[2][2], msh[2][2];
#pragma unroll
    for (int i = 0; i < 2; ++i)
#pragma unroll
        for (int h = 0; h < 2; ++h) { msc[i][h] = (f32x4){0.f, 0.f, 0.f, 0.f}; msh[i][h] = (f32x4){0.f, 0.f, 0.f, 0.f}; }
    int gcur = -1; f32x4 mgf[2][2];
#pragma unroll
    for (int i = 0; i < 2; ++i) { mgf[i][0] = (f32x4){0.f, 0.f, 0.f, 0.f}; mgf[i][1] = (f32x4){0.f, 0.f, 0.f, 0.f}; }
    const int end = gw * 33 + 33;
    int row = gw * 33;
    while (row < end && !valid(row)) ++row;
    if (row < end) load(row, cur);
    int nrow = row + 1;
    while (nrow < end && !valid(nrow)) ++nrow;
    if (nrow < end) load(nrow, nxt);
    while (row < end) {
        int n2row = nrow + 1;
        while (n2row < end && !valid(n2row)) ++n2row;
        if constexpr (D3) { if (n2row < end) load(n2row, nx2); }
        const int b = row / TPS, pos = row - b * TPS;
        float v[16];
        if (SRC == 0) {
#pragma unroll
            for (int i = 0; i < 2; ++i)
#pragma unroll
                for (int j = 0; j < 4; ++j) { v[i * 8 + j] = __uint_as_float(cur[2 * i][j]); v[i * 8 + 4 + j] = __uint_as_float(cur[2 * i + 1][j]); } }
        else {
            if (SRC == 2) { const int gi = pos < CTXL ? 8 : b;
                if (gi != gcur) { const float* grow = modg + (size_t)gi * 6144;
#pragma unroll
                    for (int i = 0; i < 2; ++i) { mgf[i][0] = *(const f32x4*)(grow + CB(i)) * (1.f / SLOT_SCALE); mgf[i][1] = *(const f32x4*)(grow + CB(i) + 4) * (1.f / SLOT_SCALE); }
                    gcur = gi; } }
#pragma unroll
            for (int i = 0; i < 2; ++i) { float f[8]; unpack8(cur[i], f);
                if (SRC == 2) { float sm[8];
#pragma unroll
                    for (int j = 0; j < 8; ++j) sm[j] = 0.f;
#pragma unroll
                    for (int k = 0; k < 8; ++k) { const int w0 = (int)cur[2 + k][2 * i], w1 = (int)cur[2 + k][2 * i + 1];
                        const f32x2_t q0 = __builtin_amdgcn_cvt_pk_f32_fp8(w0, false), q1 = __builtin_amdgcn_cvt_pk_f32_fp8(w0, true), q2 = __builtin_amdgcn_cvt_pk_f32_fp8(w1, false), q3 = __builtin_amdgcn_cvt_pk_f32_fp8(w1, true);
                        sm[0] += q0[0]; sm[1] += q0[1]; sm[2] += q1[0]; sm[3] += q1[1]; sm[4] += q2[0]; sm[5] += q2[1]; sm[6] += q3[0]; sm[7] += q3[1]; }
#pragma unroll
                    for (int j = 0; j < 4; ++j) { f[j] += mgf[i][0][j] * sm[j]; f[4 + j] += mgf[i][1][j] * sm[4 + j]; } }
#pragma unroll
                for (int j = 0; j < 8; ++j) v[i * 8 + j] = f[j]; }
            if (SRC == 2 && !FINAL) {
#pragma unroll
                for (int i = 0; i < 2; ++i) { float f[8];
#pragma unroll
                    for (int j = 0; j < 8; ++j) f[j] = v[i * 8 + j];
                    *(u32x4*)((bf16_t*)(ws + OFF_HB) + (size_t)row * D + CB(i)) = pack8(f); } } }
        float ss = 0.f;
#pragma unroll
        for (int j = 0; j < 16; ++j) ss += v[j] * v[j];
        ss = wave_sum(ss);
        const float rstd = rsqrtf(ss * (1.f / D) + EPS);
        if (FINAL) { float* o = p.out + ((size_t)b * SEQ + (pos - CTXL)) * D;
#pragma unroll
            for (int i = 0; i < 2; ++i) { f32x4 a, c;
#pragma unroll
                for (int j = 0; j < 4; ++j) { a[j] = v[i * 8 + j] * rstd * nw[i * 8 + j]; c[j] = v[i * 8 + 4 + j] * rstd * nw[i * 8 + 4 + j]; }
                *(f32x4*)(o + CB(i)) = a; *(f32x4*)(o + CB(i) + 4) = c; } }
        else { const int mi = pos < CTXL ? 8 : b;
            if (mi != mcur) { const float* mrow = mod + (size_t)mi * 6144;
#pragma unroll
                for (int i = 0; i < 2; ++i) { const int col = CB(i);
                    msc[i][0] = *(const f32x4*)(mrow + sc_off + col); msc[i][1] = *(const f32x4*)(mrow + sc_off + col + 4);
                    msh[i][0] = *(const f32x4*)(mrow + sh_off + col); msh[i][1] = *(const f32x4*)(mrow + sh_off + col + 4); }
                mcur = mi; }
            float fo[2][8]; float amax = 0.f;
#pragma unroll
            for (int i = 0; i < 2; ++i)
#pragma unroll
                for (int j = 0; j < 4; ++j) { fo[i][j] = v[i * 8 + j] * rstd * nw[i * 8 + j] * (1.f + msc[i][0][j]) + msh[i][0][j]; fo[i][4 + j] = v[i * 8 + 4 + j] * rstd * nw[i * 8 + 4 + j] * (1.f + msc[i][1][j]) + msh[i][1][j];
                    amax = fmaxf(amax, fmaxf(fabsf(fo[i][j]), fabsf(fo[i][4 + j]))); }
            if (SRC == 1) {
#pragma unroll
                for (int i = 0; i < 2; ++i) { const int col = CB(i); *(u32x4*)(dst + (size_t)row * D + col) = pack8(fo[i]); *(u32x2*)(ws + OFF_F8 + (size_t)row * D + col) = pack8_fp8(fo[i], 1.f); } }
            else {
                amax = fmaxf(wave_max(amax), 1e-20f); const float inv = 127.f / amax;
                if (lane == 0) ((float*)(ws + OFF_SCL))[SCL_RA + row] = amax * (1.f / 127.f);
#pragma unroll
                for (int i = 0; i < 2; ++i) *(u32x2*)(ws + OFF_AB + (size_t)row * D + CB(i)) = pack8_i8(fo[i], inv); } }
        if constexpr (D3) {
#pragma unroll
            for (int i = 0; i < NRAW; ++i) { cur[i] = nxt[i]; nxt[i] = nx2[i]; }
        } else {
#pragma unroll
            for (int i = 0; i < NRAW; ++i) cur[i] = nxt[i];
            if (n2row < end) load(n2row, nxt); }
        row = nrow; nrow = n2row;
    }
}
#undef CB

__device__ __forceinline__ void prep_run(const P& p, int l, bf16_t* U, int row0, int nblk, int g, int lane) {
    const int tix = opaque_tid();
    int colbase, kind;
    const float* cw = nullptr; const float* cb = nullptr; int cstride = 0, cc = 0;
    if (g < 8) { kind = 0; colbase = C_X + 128 * g; cc = 128 * g + 2 * lane; cw = p.ssd_conv_w + (size_t)l * 5 * 1024; cb = p.ssd_conv_b + (size_t)l * 1024; cstride = 1024; }
    else if (g < 14) { kind = 1; colbase = C_GQ + 128 * (g - 8); cc = 128 * (g - 8) + 2 * lane; cw = p.gdn_conv_w + (size_t)l * 5 * 768; cstride = 768; }
    else if (g < 16) { kind = 2; colbase = C_HQ + 128 * (g - 14); }
    else { kind = 3; colbase = C_HF + 128 * (g - 16); cc = (128 * (g - 16) + 2 * lane) & 255; }
    bf16_t* base = U + (size_t)row0 * UC + colbase + 2 * lane;
    if (kind >= 2) {
        float lo0 = 0.f, lo1 = 0.f;
        if (kind == 3 && l == 1) { const float a0 = p.hgrn_lb[cc], a1 = p.hgrn_lb[256 + cc], b0 = p.hgrn_lb[cc + 1], b1 = p.hgrn_lb[256 + cc + 1];
            lo0 = 1.f / (1.f + __expf(a0 - a1)); lo1 = 1.f / (1.f + __expf(b0 - b1)); }
        for (int blk = 0; blk < nblk; ++blk) { bf16_t* bb = base + (size_t)blk * 64 * UC; unsigned raw[64];
#pragma unroll
            for (int t = 0; t < 64; ++t) raw[t] = *(const unsigned*)(bb + (size_t)t * UC);
#pragma unroll
            for (int t = 0; t < 64; ++t) { float a = bflo(raw[t]), b = bfhi(raw[t]);
                if (kind == 2) { a = siluf_(a); b = siluf_(b); } else { a = (1.f - lo0) * sigmoidf_(-a); b = (1.f - lo1) * sigmoidf_(-b); }
                *(unsigned*)(bb + (size_t)t * UC) = pk2(a, b); } }
        return;
    }
    float w0[5], w1[5], bias0 = 0.f, bias1 = 0.f;
#pragma unroll
    for (int j = 0; j < 5; ++j) { w0[j] = cw[j * cstride + cc]; w1[j] = cw[j * cstride + cc + 1]; }
    if (kind == 0) { bias0 = cb[cc]; bias1 = cb[cc + 1]; }
    const bool l2 = (kind == 1) && (g < 12); const float l2s = (g < 10) ? 0.125f : 1.f;
    float pa0 = 0.f, pa1 = 0.f, pb0 = 0.f, pb1 = 0.f;
    for (int blk = 0; blk < nblk; ++blk) {
        float r0[68], r1[68];
        r0[0] = pa0; r1[0] = pa1; r0[1] = pb0; r1[1] = pb1;
        bf16_t* bb = base + (size_t)blk * 64 * UC;
#pragma unroll
        for (int t = 0; t < 64; ++t) { const unsigned v = *(const unsigned*)(bb + (size_t)t * UC); r0[2 + t] = bflo(v); r1[2 + t] = bfhi(v); }
        if (blk + 1 < nblk) {
#pragma unroll
            for (int t = 64; t < 66; ++t) { const unsigned v = *(const unsigned*)(bb + (size_t)t * UC); r0[2 + t] = bflo(v); r1[2 + t] = bfhi(v); } }
        else { r0[66] = r0[67] = r1[66] = r1[67] = 0.f; }
#pragma unroll
        for (int t = 0; t < 64; ++t) {
            float a = bias0, b = bias1;
#pragma unroll
            for (int j = 0; j < 5; ++j) { a += r0[t + j] * w0[j]; b += r1[t + j] * w1[j]; }
            a = siluf_(a); b = siluf_(b);
            if (l2) { float ss = a * a + b * b;
#pragma unroll
                for (int o = 1; o < 32; o <<= 1) ss += __shfl_xor(ss, o);
                const float f = rsqrtf(ss + 1e-6f) * l2s; a *= f; b *= f; }
            *(unsigned*)(bb + (size_t)t * UC) = pk2(a, b);
        }
        pa0 = r0[64]; pa1 = r1[64]; pb0 = r0[65]; pb1 = r1[65];
    }
}
__device__ __forceinline__ void phase_prep(const P& p, int l) {
    const int tix = opaque_tid();
    bf16_t* U = (bf16_t*)(p.ws + OFF_UB);
    const int gw = blockIdx.x * 8 + (tix >> 6), lane = tix & 63, NW = gridDim.x * 8;
    constexpr int NG = 14;
    constexpr int NCTX = NBATCH * NG, NLAT = NBATCH * 128 * NG;
    if (gw < NCTX) { const int b = gw / NG, g = gw - b * NG; prep_run(p, l, U, b * TPS, 4, g, lane); }
    const int nfree = NW - NCTX;
    for (int slot = 0; ; ++slot) {
        int j;
        if (slot < 4) { if (gw < NCTX) continue; j = slot * nfree + (gw - NCTX); }
        else j = 4 * nfree + (slot - 4) * NW + gw;
        if (j >= NLAT) break;
        const int g = j % NG, rr = j / NG, b = rr >> 7, gr = rr & 127; prep_run(p, l, U, b * TPS + CTXL + gr * 64, 1, g, lane);
    }
}

__device__ __forceinline__ int chain_row(int b, int dir, int i) { const int pos = dir == 0 ? i : (i < CTXL ? (CTXL - 1 - i) : (TPS + CTXL - 1 - i)); return b * TPS + pos; }
__device__ __forceinline__ bf16x8 ldfrag(const LAS unsigned char* base, int row, int stride, int k0) { return *(const LAS bf16x8*)(base + (size_t)(row * stride + k0) * 2); }
#define DPP_SHR_ADD(v, ctrl, rmask) (v) += __builtin_bit_cast(float, __builtin_amdgcn_update_dpp(0, __builtin_bit_cast(int, (v)), (ctrl), (rmask), 0xf, true))
__device__ __forceinline__ float row16_incl_scan(float v) {
    DPP_SHR_ADD(v, 0x111, 0xf); DPP_SHR_ADD(v, 0x112, 0xf); DPP_SHR_ADD(v, 0x114, 0xf); DPP_SHR_ADD(v, 0x118, 0xf);
    return v;
}
__device__ __forceinline__ float wave_incl_scan(float v) {
    v = row16_incl_scan(v);
    DPP_SHR_ADD(v, 0x142, 0xa);
    DPP_SHR_ADD(v, 0x143, 0xc);
    return v;
}
typedef short bf16x4 __attribute__((ext_vector_type(4)));
__device__ __forceinline__ bf16x4 ldfrag4(const LAS unsigned char* base, int row, int stride, int k0) { return *(const LAS bf16x4*)(base + (size_t)(row * stride + k0) * 2); }
__device__ __forceinline__ bf16x4 accfrag(const f32x4 a) { u32x2 o; o.x = pk2(a[0], a[1]); o.y = pk2(a[2], a[3]); return __builtin_bit_cast(bf16x4, o); }
#define MFMA16(a, b, c) __builtin_amdgcn_mfma_f32_16x16x16bf16_1k((a), (b), (c), 0, 0, 0)
__device__ __forceinline__ void scan_ssd_mma(const P& p, int l, int b, int hd, int dir, LAS unsigned char* lds) {
    const int tix = opaque_tid();
    const bf16_t* U = (const bf16_t*)(p.ws + OFF_UB); bf16_t* Y = (bf16_t*)(p.ws + (dir == 0 ? OFF_AB : OFF_Y2));
    const int w = __builtin_amdgcn_readfirstlane(tix >> 6), lane = tix & 63, l15 = lane & 15, lq = lane >> 4, g = hd >> 2;
    const float A = -__expf(p.ssd_a_log[(l * 2 + dir) * 8 + hd]), dtb = p.ssd_dt_bias[(l * 2 + dir) * 8 + hd], Dk = p.ssd_d[l * 8 + hd];
    constexpr int SC = 136, SX = 72;
    constexpr int SB = 44544;
    LAS unsigned char* BT = lds + 2 * SB;
    LAS unsigned char* XT = BT + 18432;
    LAS unsigned char* LS = XT + 9216;
    constexpr int NCH = TPS / 64;
    f32x4 Ht[8];
#pragma unroll
    for (int j = 0; j < 8; ++j) Ht[j] = (f32x4){0.f, 0.f, 0.f, 0.f};
    u32x4 preA[5], preB[5]; bf16_t pdtA = 0, pdtB = 0;
    auto issue = [&](int c, u32x4 (&pre)[5], bf16_t& pdt) {
#pragma unroll
        for (int j = 0; j < 5; ++j) { const int q = tix + NTHR * j, t = q / 40, pc = q - t * 40;
            const bf16_t* r = U + (size_t)chain_row(b, dir, c * 64 + t) * UC;
            const int col = pc < 8 ? (C_X + hd * 64 + pc * 8) : (pc < 24 ? (C_B + g * 128 + (pc - 8) * 8) : (C_C + g * 128 + (pc - 24) * 8));
            pre[j] = *(const u32x4*)(r + col); }
        if (w == 0) pdt = U[(size_t)chain_row(b, dir, c * 64 + lane) * UC + C_DT + dir * 8 + hd];
    };
    issue(0, preA, pdtA); issue(1, preB, pdtB);
    const int pt = w & 3, th = w >> 2;
    static_assert(NCH % 2 == 0, "chunk loop is unrolled by two");
    auto chunk = [&](int c, u32x4 (&pre)[5], bf16_t& pdt) {
        LAS unsigned char* CS = lds + (c & 1) * SB; LAS unsigned char* BS = CS + 17408; LAS unsigned char* XS = CS + 34816;
        LAS float* CUM = (LAS float*)(CS + 44032); LAS float* DTV = CUM + 64;
#pragma unroll
        for (int j = 0; j < 5; ++j) { const int q = tix + NTHR * j, t = q / 40, pc = q - t * 40;
            LAS unsigned char* dst = pc < 8 ? (XS + (size_t)(t * SX + pc * 8) * 2) : (pc < 24 ? (BS + (size_t)(t * SC + (pc - 8) * 8) * 2) : (CS + (size_t)(t * SC + (pc - 24) * 8) * 2));
            *(LAS u32x4*)dst = pre[j]; }
        if (w == 0) { const float dt = softplusf_(bf2f(pdt) + dtb); float a = dt * A;
            a = wave_incl_scan(a);
            CUM[lane] = a; DTV[lane] = dt; }
        __syncthreads();
        if (c + 2 < NCH) issue(c + 2, pre, pdt);
        const float cum63 = CUM[63];
        { const int s = tix & 63, pb = tix >> 6; float f[8]; unpack8(*(const LAS u32x4*)(XS + (size_t)(s * SX + pb * 8) * 2), f); const float dt = DTV[s];
#pragma unroll
            for (int j = 0; j < 8; ++j) *(LAS bf16_t*)(XT + (size_t)((pb * 8 + j) * SX + s) * 2) = f2bf(f[j] * dt);
            const float sc = __expf(cum63 - CUM[s]);
#pragma unroll
            for (int h2 = 0; h2 < 2; ++h2) { unpack8(*(const LAS u32x4*)(BS + (size_t)(s * SC + pb * 16 + h2 * 8) * 2), f);
#pragma unroll
                for (int j = 0; j < 8; ++j) *(LAS bf16_t*)(BT + (size_t)((pb * 16 + h2 * 8 + j) * SX + s) * 2) = f2bf(f[j] * sc); } }
        { const int tm = w >> 1;
            float ct[4];
#pragma unroll
            for (int r = 0; r < 4; ++r) ct[r] = CUM[tm * 16 + 4 * lq + r];
#pragma unroll
            for (int tt = 0; tt < 2; ++tt) { const int tn = 2 * (w & 1) + tt; f32x4 acc = (f32x4){0.f, 0.f, 0.f, 0.f};
#pragma unroll
                for (int kk = 0; kk < 4; ++kk) acc = __builtin_amdgcn_mfma_f32_16x16x32_bf16(ldfrag(CS, tm * 16 + l15, SC, kk * 32 + 8 * lq), ldfrag(BS, tn * 16 + l15, SC, kk * 32 + 8 * lq), acc, 0, 0, 0);
                const int s = tn * 16 + l15; const float cs = CUM[s];
#pragma unroll
                for (int r = 0; r < 4; ++r) { const int t = tm * 16 + 4 * lq + r; const float v = (s <= t) ? acc[r] * __expf(ct[r] - cs) : 0.f;
                    *(LAS bf16_t*)(LS + (size_t)(t * SX + s) * 2) = f2bf(v); } } }
        __syncthreads();
        { bf16x4 hb[8]; const int yrow0 = chain_row(b, dir, c * 64);
#pragma unroll
            for (int nt = 0; nt < 8; ++nt) hb[nt] = accfrag(Ht[nt]);
#pragma unroll
            for (int tt = 0; tt < 2; ++tt) { const int tm = 2 * th + tt; f32x4 acc = (f32x4){0.f, 0.f, 0.f, 0.f};
#pragma unroll
                for (int nt = 0; nt < 8; ++nt) acc = MFMA16(ldfrag4(CS, tm * 16 + l15, SC, nt * 16 + 4 * lq), hb[nt], acc);
#pragma unroll
                for (int r = 0; r < 4; ++r) acc[r] *= __expf(CUM[tm * 16 + 4 * lq + r]);
#pragma unroll
                for (int kk = 0; kk < 2; ++kk) acc = __builtin_amdgcn_mfma_f32_16x16x32_bf16(ldfrag(LS, tm * 16 + l15, SX, kk * 32 + 8 * lq), ldfrag(XT, pt * 16 + l15, SX, kk * 32 + 8 * lq), acc, 0, 0, 0);
                const int pcol = pt * 16 + l15;
#pragma unroll
                for (int r = 0; r < 4; ++r) { const int t = tm * 16 + 4 * lq + r; float y = acc[r];
                    if (dir == 0) y += Dk * bf2f(*(const LAS bf16_t*)(XS + (size_t)(t * SX + pcol) * 2));
                    Y[(size_t)(yrow0 + (dir == 0 ? t : -t)) * D + hd * 64 + pcol] = f2bf(y); } }
            const float dec = __expf(cum63);
            const bf16x8 xf0 = ldfrag(XT, pt * 16 + l15, SX, 8 * lq), xf1 = ldfrag(XT, pt * 16 + l15, SX, 32 + 8 * lq);
#pragma unroll
            for (int nt = 0; nt < 8; ++nt) { f32x4 acc = Ht[nt] * dec;
                acc = __builtin_amdgcn_mfma_f32_16x16x32_bf16(ldfrag(BT, nt * 16 + l15, SX, 8 * lq), xf0, acc, 0, 0, 0);
                acc = __builtin_amdgcn_mfma_f32_16x16x32_bf16(ldfrag(BT, nt * 16 + l15, SX, 32 + 8 * lq), xf1, acc, 0, 0, 0);
                Ht[nt] = acc; } }
    };
#pragma unroll 1
    for (int c = 0; c < NCH; c += 2) { chunk(c, preA, pdtA); chunk(c + 1, preB, pdtB); }
    __syncthreads();
}
__device__ __forceinline__ void scan_hgrn_mma(const P& p, int l, int b, int hd, int dir, LAS unsigned char* lds) {
    const int tix = opaque_tid();
    const bf16_t* U = (const bf16_t*)(p.ws + OFF_UB); bf16_t* Y = (bf16_t*)(p.ws + (dir == 0 ? OFF_AB : OFF_Y2));
    const int w = __builtin_amdgcn_readfirstlane(tix >> 6), lane = tix & 63, l15 = lane & 15, lq = lane >> 4;
    constexpr int SX = 72, SP = 40;
    LAS unsigned char* QS = lds;
    LAS unsigned char* KS = lds + 9216;
    LAS unsigned char* VS = lds + 18432;
    LAS unsigned char* KE = lds + 27648;
    LAS unsigned char* VT = lds + 48128;
    LAS unsigned char* ATT = lds + 68608;
    LAS float* ER = (LAS float*)(lds + 73728);
    LAS unsigned char* ST = lds + 74752;
    constexpr int NCH = TPS / 64;
    for (int i = tix; i < (74752 + 9216 - 27648) / 4; i += NTHR) ((LAS unsigned*)KE)[i] = 0u;
    f32x4 Sacc[4];
#pragma unroll
    for (int i = 0; i < 4; ++i) Sacc[i] = (f32x4){0.f, 0.f, 0.f, 0.f};
    u32x4 preA[3], preB[3];
    auto issue = [&](int c, u32x4 (&pre)[3]) {
#pragma unroll
        for (int j = 0; j < 3; ++j) { const int q = tix + NTHR * j, t = q / 24, pc = q - t * 24;
            const bf16_t* r = U + (size_t)chain_row(b, dir, c * 64 + t) * UC;
            const int col = pc < 8 ? (C_HQ + hd * 64 + pc * 8) : (pc < 16 ? (C_HF + dir * 256 + hd * 64 + (pc - 8) * 8) : (C_HI + hd * 64 + (pc - 16) * 8));
            pre[j] = *(const u32x4*)(r + col); }
    };
    issue(0, preA); issue(1, preB);
    static_assert(NCH % 2 == 0, "chunk loop is unrolled by two");
#pragma unroll 1
    for (int cc = 0; cc < NCH; cc += 2)
#pragma unroll
    for (int half = 0; half < 2; ++half) { const int c = cc + half; u32x4 (&pre)[3] = half ? preB : preA;
#pragma unroll
        for (int j = 0; j < 3; ++j) { const int q = tix + NTHR * j, t = q / 24, pc = q - t * 24;
            LAS unsigned char* dst = (pc < 8 ? QS : (pc < 16 ? KS : VS)) + (size_t)(t * SX + (pc & 7) * 8) * 2;
            *(LAS u32x4*)dst = pre[j]; }
        __syncthreads();
        if (c + 2 < NCH) issue(c + 2, pre);
        if (tix < 256) { const int k = tix & 63, j = tix >> 6; float r = 0.f, rr[16], kv[16], qv[16];
#pragma unroll
            for (int t = 0; t < 16; ++t) { kv[t] = bf2f(*(const LAS bf16_t*)(KS + (size_t)((16 * j + t) * SX + k) * 2)); qv[t] = bf2f(*(const LAS bf16_t*)(QS + (size_t)((16 * j + t) * SX + k) * 2)); }
#pragma unroll
            for (int t = 0; t < 16; ++t) { r += __logf(fmaxf(1.f - kv[t], 1e-30f)); rr[t] = r; }
#pragma unroll
            for (int t = 0; t < 16; ++t) { *(LAS bf16_t*)(QS + (size_t)((16 * j + t) * SX + k) * 2) = f2bf(qv[t] * __expf(rr[t])); *(LAS bf16_t*)(KS + (size_t)((16 * j + t) * SX + k) * 2) = f2bf(kv[t] * __expf(-fmaxf(rr[t], -80.f))); }
            ER[j * 64 + k] = __expf(r);
#pragma unroll
            for (int t = 0; t < 16; ++t) *(LAS bf16_t*)(KE + (size_t)((j * 64 + k) * SP + t) * 2) = f2bf(kv[t] * __expf(r - rr[t])); }
        else { const int v = (tix - 256) & 63, j = (tix - 256) >> 6; bf16_t tv[16];
#pragma unroll
            for (int t = 0; t < 16; ++t) tv[t] = *(const LAS bf16_t*)(VS + (size_t)((16 * j + t) * SX + v) * 2);
            u32x4 o0, o1; o0.x = tv[0] | ((unsigned)tv[1] << 16); o0.y = tv[2] | ((unsigned)tv[3] << 16); o0.z = tv[4] | ((unsigned)tv[5] << 16); o0.w = tv[6] | ((unsigned)tv[7] << 16);
            o1.x = tv[8] | ((unsigned)tv[9] << 16); o1.y = tv[10] | ((unsigned)tv[11] << 16); o1.z = tv[12] | ((unsigned)tv[13] << 16); o1.w = tv[14] | ((unsigned)tv[15] << 16);
            *(LAS u32x4*)(VT + (size_t)((j * 64 + v) * SP) * 2) = o0; *(LAS u32x4*)(VT + (size_t)((j * 64 + v) * SP + 8) * 2) = o1; }
        __syncthreads();
        if (w < 4) { const int j = w; f32x4 acc = (f32x4){0.f, 0.f, 0.f, 0.f};
#pragma unroll
            for (int kk = 0; kk < 2; ++kk) acc = __builtin_amdgcn_mfma_f32_16x16x32_bf16(ldfrag(QS, 16 * j + l15, SX, kk * 32 + 8 * lq), ldfrag(KS, 16 * j + l15, SX, kk * 32 + 8 * lq), acc, 0, 0, 0);
#pragma unroll
            for (int r = 0; r < 4; ++r) { const int t = 4 * lq + r; *(LAS bf16_t*)(ATT + (size_t)((j * 16 + t) * SP + l15) * 2) = f2bf(l15 <= t ? acc[r] : 0.f); } }
        __syncthreads();
        if (w < 4) { const int vt = w; const int yrow0 = chain_row(b, dir, c * 64), ysg = dir == 0 ? 1 : -1;
#pragma unroll
            for (int j = 0; j < 4; ++j) {
                bf16x4 sb[4];
#pragma unroll
                for (int kt = 0; kt < 4; ++kt) sb[kt] = accfrag(Sacc[kt]);
                const bf16x4 vfr = ldfrag4(VT, j * 64 + vt * 16 + l15, SP, 4 * lq);
                f32x4 o = (f32x4){0.f, 0.f, 0.f, 0.f};
#pragma unroll
                for (int kt = 0; kt < 4; ++kt) o = MFMA16(ldfrag4(QS, 16 * j + l15, SX, 16 * kt + 4 * lq), sb[kt], o);
                o = MFMA16(ldfrag4(ATT, j * 16 + l15, SP, 4 * lq), vfr, o);
#pragma unroll
                for (int r = 0; r < 4; ++r) Y[(size_t)(yrow0 + ysg * (16 * j + 4 * lq + r)) * D + 512 + hd * 64 + vt * 16 + l15] = f2bf(o[r]);
#pragma unroll
                for (int kt = 0; kt < 4; ++kt) { f32x4 acc = Sacc[kt];
#pragma unroll
                    for (int r = 0; r < 4; ++r) acc[r] *= ER[j * 64 + kt * 16 + 4 * lq + r];
                    Sacc[kt] = MFMA16(ldfrag4(KE, j * 64 + kt * 16 + l15, SP, 4 * lq), vfr, acc); }
            } }
        __syncthreads();
    }
}
__device__ __forceinline__ void scan_gdn_mma(const P& p, int l, int b, int hd, int dir, LAS unsigned char* lds) {
    const int tix = opaque_tid();
    const bf16_t* U = (const bf16_t*)(p.ws + OFF_UB); bf16_t* Y = (bf16_t*)(p.ws + (dir == 0 ? OFF_AB : OFF_Y2));
    const int w = __builtin_amdgcn_readfirstlane(tix >> 6), lane = tix & 63, l15 = lane & 15, lq = lane >> 4;
    const float Aa = __expf(p.gdn_a_log[(l * 2 + dir) * 4 + hd]), dtb = p.gdn_dt_bias[(l * 2 + dir) * 4 + hd];
    constexpr int SX = 72, SP = 40;
    LAS unsigned char* QS = lds;
    LAS unsigned char* KS = lds + 9216;
    LAS unsigned char* VS = lds + 18432;
    LAS unsigned char* QG = lds + 27648;
    LAS unsigned char* KE = lds + 36864;
    LAS float* AM = (LAS float*)(lds + 57344);
    LAS unsigned char* QKM = lds + 61952;
    LAS unsigned char* TM = lds + 67072;
    LAS unsigned char* RT = lds + 72192;
    LAS unsigned char* VNT = lds + 77312;
    LAS unsigned char* MT = lds + 82432;
    LAS float* GAM = (LAS float*)(lds + 100864); LAS float* BETA = (LAS float*)(lds + 101120); LAS float* EGAM = (LAS float*)(lds + 101376);
    constexpr int NCH = TPS / 64;
    for (int i = tix; i < (82432 + 9216 - 36864) / 4; i += NTHR) ((LAS unsigned*)KE)[i] = 0u;
    f32x4 Macc[4];
#pragma unroll
    for (int i = 0; i < 4; ++i) Macc[i] = (f32x4){0.f, 0.f, 0.f, 0.f};
    u32x4 preA[3], preB[3]; bf16_t paA = 0, pbA = 0, paB = 0, pbB = 0;
    auto issue = [&](int c, u32x4 (&pre)[3], bf16_t& pa, bf16_t& pb) {
#pragma unroll
        for (int j = 0; j < 3; ++j) { const int q = tix + NTHR * j, t = q / 24, pc = q - t * 24;
            const bf16_t* r = U + (size_t)chain_row(b, dir, c * 64 + t) * UC;
            const int col = pc < 8 ? (C_GQ + hd * 64 + pc * 8) : (pc < 16 ? (C_GK + hd * 64 + (pc - 8) * 8) : (C_GV + hd * 64 + (pc - 16) * 8));
            pre[j] = *(const u32x4*)(r + col); }
        if (w == 0) { const bf16_t* r = U + (size_t)chain_row(b, dir, c * 64 + lane) * UC; pa = r[C_GA + dir * 4 + hd]; pb = r[C_GB + dir * 4 + hd]; }
    };
    issue(0, preA, paA, pbA); issue(1, preB, paB, pbB);
    static_assert(NCH % 2 == 0, "chunk loop is unrolled by two");
#pragma unroll 1
    for (int cc = 0; cc < NCH; cc += 2)
#pragma unroll
    for (int half = 0; half < 2; ++half) { const int c = cc + half; u32x4 (&pre)[3] = half ? preB : preA; bf16_t& pa = half ? paB : paA; bf16_t& pb = half ? pbB : pbA;
        const int tix = opaque_tid(), lane = tix & 63, l15 = lane & 15, lq = lane >> 4;
#pragma unroll
        for (int j = 0; j < 3; ++j) { const int q = tix + NTHR * j, t = q / 24, pc = q - t * 24;
            LAS unsigned char* dst = (pc < 8 ? QS : (pc < 16 ? KS : VS)) + (size_t)(t * SX + (pc & 7) * 8) * 2;
            *(LAS u32x4*)dst = pre[j]; }
        if (w == 0) { float g = -Aa * softplusf_(bf2f(pa) + dtb); const float be = sigmoidf_(bf2f(pb));
            g = row16_incl_scan(g);
            GAM[lane] = g; BETA[lane] = be; EGAM[lane] = __expf(g); }
        __syncthreads();
        if (c + 2 < NCH) issue(c + 2, pre, pa, pb);
        { const int t = tix >> 3, kb = tix & 7; float f[8]; unpack8(*(const LAS u32x4*)(QS + (size_t)(t * SX + kb * 8) * 2), f); const float eg = EGAM[t];
#pragma unroll
            for (int i = 0; i < 8; ++i) f[i] *= eg;
            *(LAS u32x4*)(QG + (size_t)(t * SX + kb * 8) * 2) = pack8(f);
            unpack8(*(const LAS u32x4*)(KS + (size_t)(t * SX + kb * 8) * 2), f); const float ek = __expf(GAM[(t & 48) + 15] - GAM[t]);
#pragma unroll
            for (int i = 0; i < 8; ++i) *(LAS bf16_t*)(KE + (size_t)(((t >> 4) * 64 + kb * 8 + i) * SP + (t & 15)) * 2) = f2bf(f[i] * ek); }
        { const int j = w & 3, which = w >> 2;
            if (which == 0) {
                f32x4 kk = (f32x4){0.f, 0.f, 0.f, 0.f};
#pragma unroll
                for (int q = 0; q < 2; ++q) kk = __builtin_amdgcn_mfma_f32_16x16x32_bf16(ldfrag(KS, 16 * j + l15, SX, q * 32 + 8 * lq), ldfrag(KS, 16 * j + l15, SX, q * 32 + 8 * lq), kk, 0, 0, 0);
                const float gs = GAM[16 * j + l15], bs = BETA[16 * j + l15];
                f32x4 Q, QT, ST;
#pragma unroll
                for (int r = 0; r < 4; ++r) { const int t = 4 * lq + r; const float gt = GAM[16 * j + t], bt = BETA[16 * j + t];
                    Q[r] = (l15 < t) ? -bt * kk[r] * __expf(gt - gs) : 0.f;
                    QT[r] = (t < l15) ? -bs * kk[r] * __expf(gs - gt) : 0.f;
                    ST[r] = QT[r] + ((t == l15) ? 1.f : 0.f); }
#pragma unroll
                for (int lv = 0; lv < 3; ++lv) { const bf16x4 qa = accfrag(QT), qb = accfrag(Q);
                    const f32x4 Q2 = MFMA16(qa, qb, ((f32x4){0.f, 0.f, 0.f, 0.f}));
                    if (lv < 2) QT = MFMA16(qb, qa, ((f32x4){0.f, 0.f, 0.f, 0.f}));
                    Q = Q2;
                    ST = MFMA16(accfrag(Q), accfrag(ST), ST); }
                *(LAS bf16x4*)(TM + (size_t)(j * 64 + lane) * 8) = accfrag(ST);
            } else {
                f32x4 qk = (f32x4){0.f, 0.f, 0.f, 0.f};
#pragma unroll
                for (int q = 0; q < 2; ++q) qk = __builtin_amdgcn_mfma_f32_16x16x32_bf16(ldfrag(KS, 16 * j + l15, SX, q * 32 + 8 * lq), ldfrag(QS, 16 * j + l15, SX, q * 32 + 8 * lq), qk, 0, 0, 0);
                const float gt = GAM[16 * j + l15];
#pragma unroll
                for (int r = 0; r < 4; ++r) { const int s2 = 4 * lq + r; qk[r] = (s2 <= l15) ? qk[r] * __expf(gt - GAM[16 * j + s2]) : 0.f; }
                *(LAS bf16x4*)(QKM + (size_t)(j * 64 + lane) * 8) = accfrag(qk);
            } }
        __syncthreads();
        if (w < 4) { const int vt = w; const int yrow0 = chain_row(b, dir, c * 64), ysg = dir == 0 ? 1 : -1;
#pragma unroll
            for (int j = 0; j < 4; ++j) {
                bf16x4 mb[4];
#pragma unroll
                for (int kt = 0; kt < 4; ++kt) mb[kt] = accfrag(Macc[kt]);
                f32x4 km = (f32x4){0.f, 0.f, 0.f, 0.f}, o = (f32x4){0.f, 0.f, 0.f, 0.f};
#pragma unroll
                for (int kt = 0; kt < 4; ++kt) km = MFMA16(ldfrag4(KS, 16 * j + l15, SX, 16 * kt + 4 * lq), mb[kt], km);
#pragma unroll
                for (int kt = 0; kt < 4; ++kt) o = MFMA16(ldfrag4(QG, 16 * j + l15, SX, 16 * kt + 4 * lq), mb[kt], o);
                f32x4 rv;
#pragma unroll
                for (int r = 0; r < 4; ++r) { const int s2 = 16 * j + 4 * lq + r; const float vv = bf2f(*(const LAS bf16_t*)(VS + (size_t)(s2 * SX + vt * 16 + l15) * 2));
                    rv[r] = BETA[s2] * (vv - EGAM[s2] * km[r]); }
                const f32x4 vn = MFMA16(*(const LAS bf16x4*)(TM + (size_t)(j * 64 + lane) * 8), accfrag(rv), ((f32x4){0.f, 0.f, 0.f, 0.f}));
                const bf16x4 vb = accfrag(vn);
                o = MFMA16(*(const LAS bf16x4*)(QKM + (size_t)(j * 64 + lane) * 8), vb, o);
#pragma unroll
                for (int r = 0; r < 4; ++r) Y[(size_t)(yrow0 + ysg * (16 * j + 4 * lq + r)) * D + 768 + hd * 64 + vt * 16 + l15] = f2bf(o[r]);
                const float dec = EGAM[16 * j + 15];
#pragma unroll
                for (int kt = 0; kt < 4; ++kt) Macc[kt] = MFMA16(ldfrag4(KE, j * 64 + kt * 16 + l15, SP, 4 * lq), vb, Macc[kt] * dec);
            } }
        __syncthreads();
    }
}
constexpr int CVT_GRAB = 6;
static_assert((64 * 192) % CVT_GRAB == 0, "tile split");
__device__ __forceinline__ void phase_scan(const P& p, int l, LAS unsigned char* lds) {
    const int tix = opaque_tid();
    for (int ch = blockIdx.x; ch < 256; ch += gridDim.x) {
        const int x = ch & 7, m = ch >> 3; int dir, hd16, b;
        if (m < 16) { const int gidx = x + 8 * (m >> 3), r8 = m & 7; b = gidx >> 1; hd16 = (gidx & 1) * 4 + (r8 >> 1); dir = r8 & 1; }
        else { const int idx = x * 8 + (m & 7); b = idx >> 3; hd16 = (m < 24 ? 8 : 12) + ((idx >> 1) & 3); dir = idx & 1; }
        if (hd16 < 8) scan_ssd_mma(p, l, b, hd16, dir, lds);
        else if (hd16 < 12) scan_hgrn_mma(p, l, b, hd16 - 8, dir, lds);
        else scan_gdn_mma(p, l, b, hd16 - 12, dir, lds);
        __syncthreads();
        unsigned* qhead = (unsigned*)(p.ws + OFF_CVTQ) + 64 * l;
        for (;;) {
            if (tix == 0) *(LAS int*)(lds + LDS_TAB) = (int)__hip_atomic_fetch_add(qhead, (unsigned)CVT_GRAB, __ATOMIC_RELAXED, __HIP_MEMORY_SCOPE_AGENT);
            __syncthreads();
            const int t0 = *(const LAS int*)(lds + LDS_TAB);
            __syncthreads();
            if (t0 >= 64 * 192) break;
            phase_expert_cvt(p, l, lds, t0, t0 + CVT_GRAB, 1);
        }
    }
}

__device__ __forceinline__ void phase_post(const P& p, int l, bool lat_only) {
    const int tix = opaque_tid();
    const bf16_t* U = (const bf16_t*)(p.ws + OFF_UB); bf16_t* Y1 = (bf16_t*)(p.ws + OFF_AB); const bf16_t* Y2 = (const bf16_t*)(p.ws + OFF_Y2);
    const int gw = blockIdx.x * 8 + (tix >> 6), lane = tix & 63;
    const int col = 16 * lane;
    const int gc = lane < 32 ? col : (lane < 48 ? C_HG + (col - 512) : C_GG + (col - 768));
    float nw[16];
#pragma unroll
    for (int j = 0; j < 16; ++j) nw[j] = lane < 32 ? p.ssd_norm[l * 512 + col + j] : (lane < 48 ? p.hgrn_norm[l * 64 + ((col + j) & 63)] : p.gdn_norm[l * 64 + ((col + j) & 63)]);
    u32x4 cur[6], nxt[6], nx2[6];
    auto valid = [&](int row) { return !(lat_only && (row % TPS) < CTXL); };
    auto load = [&](int row, u32x4 (&r)[6]) {
#pragma unroll
        for (int i = 0; i < 2; ++i) { r[i] = *(const u32x4*)(Y1 + (size_t)row * D + col + i * 8); r[2 + i] = *(const u32x4*)(Y2 + (size_t)row * D + col + i * 8); r[4 + i] = *(const u32x4*)(U + (size_t)row * UC + gc + i * 8); }
    };
    const int end = gw * 33 + 33;
    int row = gw * 33;
    while (row < end && !valid(row)) ++row;
    if (row < end) load(row, cur);
    int nrow = row + 1;
    while (nrow < end && !valid(nrow)) ++nrow;
    if (nrow < end) load(nrow, nxt);
    while (row < end) {
        int n2row = nrow + 1;
        while (n2row < end && !valid(n2row)) ++n2row;
        if (n2row < end) load(n2row, nx2);
        float y[16], gt[16];
#pragma unroll
        for (int i = 0; i < 2; ++i) { float a[8], c[8], g8[8];
            unpack8(cur[i], a); unpack8(cur[2 + i], c); unpack8(cur[4 + i], g8);
#pragma unroll
            for (int j = 0; j < 8; ++j) { y[i * 8 + j] = a[j] + c[j]; gt[i * 8 + j] = siluf_(g8[j]); } }
        if (lane < 32) {
#pragma unroll
            for (int j = 0; j < 16; ++j) y[j] *= gt[j]; }
        float ss = 0.f;
#pragma unroll
        for (int j = 0; j < 16; ++j) ss += y[j] * y[j];
        ss += __shfl_xor(ss, 1); ss += __shfl_xor(ss, 2);
        float s16 = ss; s16 += __shfl_xor(s16, 4); s16 += __shfl_xor(s16, 8);
        const float rstd = lane < 32 ? rsqrtf(s16 * (1.f / 256.f) + EPS) : rsqrtf(ss * (1.f / 64.f) + EPS);
#pragma unroll
        for (int i = 0; i < 2; ++i) { float f[8];
#pragma unroll
            for (int j = 0; j < 8; ++j) { const float t = y[i * 8 + j] * rstd * nw[i * 8 + j]; f[j] = lane < 32 ? t : t * gt[i * 8 + j]; }
            *(u32x4*)(Y1 + (size_t)row * D + col + i * 8) = pack8(f); }
#pragma unroll
        for (int i = 0; i < 6; ++i) { cur[i] = nxt[i]; nxt[i] = nx2[i]; }
        row = nrow; nrow = n2row;
    }
}

__device__ __forceinline__ void phase_topk(const P& p, int l, bool lat_only, LAS unsigned char* lds) {
    const int tix = opaque_tid();
    unsigned char* ws = p.ws;
    LAS int* hist = (LAS int*)lds;
    for (int i = tix; i < 256; i += NTHR) hist[i] = 0;
    __syncthreads();
    const int t = tix;
    if (t < 264) {
        const int row = blockIdx.x * 264 + t;
        const bool active = !(lat_only && (row % TPS) < CTXL);
        if (active) {
            const float* sp = (const float*)(ws + OFF_SC) + (size_t)row * 64;
            float sc[64], sel[64];
#pragma unroll
            for (int i = 0; i < 16; ++i) { const f32x4 v = *(const f32x4*)(sp + 4 * i); sc[4 * i] = v[0]; sc[4 * i + 1] = v[1]; sc[4 * i + 2] = v[2]; sc[4 * i + 3] = v[3]; }
#pragma unroll
            for (int e = 0; e < 64; ++e) sel[e] = sc[e] + p.router_bias[l * 64 + e];
            int idx[8]; float gv[8]; float gs = 0.f;
#pragma unroll
            for (int r = 0; r < 8; ++r) { float best = -3.0e38f, bs = 0.f; int bi = 0;
#pragma unroll
                for (int e = 0; e < 64; ++e) { const bool gt = sel[e] > best; best = gt ? sel[e] : best; bs = gt ? sc[e] : bs; bi = gt ? e : bi; }
#pragma unroll
                for (int e = 0; e < 64; ++e) sel[e] = (e == bi) ? -3.0e38f : sel[e];
                idx[r] = bi; gv[r] = bs; gs += bs; }
            const float inv = 2.5f / gs;
            int* te = (int*)(ws + OFF_TOKE) + (size_t)row * 8; float* tg = (float*)(ws + OFF_TOKG) + (size_t)row * 8; int* tl = (int*)(ws + OFF_TOKLR) + (size_t)row * 12;
#pragma unroll
            for (int r = 0; r < 8; ++r) { const int s = idx[r]; const int lr = atomicAdd((int*)&hist[s], 1); te[r] = idx[r]; tg[r] = gv[r] * inv; tl[r] = lr; }
            tl[8] = atomicAdd((int*)&hist[64], 1);
        }
    }
    __syncthreads();
    for (int i = tix; i < 256; i += NTHR) ((int*)(ws + OFF_BCNT))[blockIdx.x * 256 + i] = (i < NSEG) ? hist[i] : 0;
}
__device__ __forceinline__ void phase_lists(const P& p, int l, bool lat_only, LAS unsigned char* lds) {
    const int tix = opaque_tid();
    unsigned char* ws = p.ws;
    LAS int* tot = (LAS int*)lds; LAS int* base = tot + 256; LAS int* segp = base + 256;
    const int* bc = (const int*)(ws + OFF_BCNT);
    const int t = tix;
    { LAS int* pa = (LAS int*)lds + 1024; LAS int* pb = pa + 512;
        const int sg = t & 127, part = t >> 7; int a = 0, bs = 0;
        if (sg < NSEG) {
#pragma unroll 16
            for (int k = 0; k < GRID / 4; ++k) { const int bb = part * (GRID / 4) + k; const int v = bc[bb * 256 + sg]; a += v; bs += bb < (int)blockIdx.x ? v : 0; } }
        pa[t] = a; pb[t] = bs;
        __syncthreads();
        if (t < 256) { const bool in = t < NSEG; tot[t] = in ? pa[t] + pa[128 + t] + pa[256 + t] + pa[384 + t] : 0; base[t] = in ? pb[t] + pb[128 + t] + pb[256 + t] + pb[384 + t] : 0; } }
    __syncthreads();
    if (t == 0) { int acc = 0; for (int s = 0; s < NSEG; ++s) { segp[s] = acc; acc += (tot[s] + 255) >> 8; } segp[NSEG] = acc; }
    __syncthreads();
    int* rinfo = (int*)(ws + OFF_RINFO); float* rgate = (float*)(ws + OFF_RGATE);
    if (t < 264) {
        const int row = blockIdx.x * 264 + t;
        const bool active = !(lat_only && (row % TPS) < CTXL);
        if (active) {
            const int* te = (const int*)(ws + OFF_TOKE) + (size_t)row * 8; const float* tg = (const float*)(ws + OFF_TOKG) + (size_t)row * 8; const int* tl = (const int*)(ws + OFF_TOKLR) + (size_t)row * 12;
#pragma unroll
            for (int r = 0; r < 8; ++r) { const int s = te[r]; const int slot = 256 * segp[s] + base[s] + tl[r]; rinfo[slot] = row * 16 + r; rgate[slot] = tg[r]; }
            const int slot = 256 * segp[64] + base[64] + tl[8]; rinfo[slot] = row * 16 + 8; rgate[slot] = 1.f;
        }
    }
    for (int s = blockIdx.x; s < NSEG; s += gridDim.x) { const int n = tot[s], e = ((n + 255) >> 8) << 8; for (int r = n + t; r < e; r += NTHR) { rinfo[256 * segp[s] + r] = -1; rgate[256 * segp[s] + r] = 0.f; } }
    if (blockIdx.x == 0 && t <= NSEG) ((int*)(ws + OFF_SEGP))[t] = segp[t];
}
__device__ __forceinline__ const LAS int* load_segp(const P& p, LAS unsigned char* lds, bool build) {
    const int tix = opaque_tid();
    LAS int* segp = (LAS int*)(lds + LDS_TAB);
    __syncthreads();
    if (tix <= NSEG) segp[tix] = ((const int*)(p.ws + OFF_SEGP))[tix];
    __syncthreads();
    if (build) { LAS unsigned char* segt = lds + LDS_SEGT; const int np = segp[NSEG];
        for (int pp = tix; pp < np; pp += NTHR) { int lo = 0, hi = NSEG; while (hi - lo > 1) { const int mid = (lo + hi) >> 1; if (segp[mid] <= pp) lo = mid; else hi = mid; } segt[pp] = (unsigned char)lo; } }
    __syncthreads();
    return segp;
}

enum { PH_PRO = 0, PH_NORM1, PH_WIN, PH_PREP, PH_SCAN, PH_POST, PH_WOUT, PH_NORM2, PH_ROUTER, PH_TOPK, PH_LISTS, PH_MOE, PH_FINAL };

__device__ __forceinline__ P launder_params(const P& p0) {
    P p;
    p.x = launder_ptr(p0.x); p.c = launder_ptr(p0.c); p.ctx = launder_ptr(p0.ctx); p.c_ctx = launder_ptr(p0.c_ctx); p.w_mod = launder_ptr(p0.w_mod); p.b_mod = launder_ptr(p0.b_mod);
    p.norm_mix = launder_ptr(p0.norm_mix); p.w_in = launder_ptr(p0.w_in); p.ssd_conv_w = launder_ptr(p0.ssd_conv_w); p.ssd_conv_b = launder_ptr(p0.ssd_conv_b);
    p.ssd_dt_bias = launder_ptr(p0.ssd_dt_bias); p.ssd_a_log = launder_ptr(p0.ssd_a_log); p.ssd_d = launder_ptr(p0.ssd_d); p.ssd_norm = launder_ptr(p0.ssd_norm);
    p.hgrn_lb = launder_ptr(p0.hgrn_lb); p.hgrn_norm = launder_ptr(p0.hgrn_norm); p.gdn_conv_w = launder_ptr(p0.gdn_conv_w); p.gdn_dt_bias = launder_ptr(p0.gdn_dt_bias);
    p.gdn_a_log = launder_ptr(p0.gdn_a_log); p.gdn_norm = launder_ptr(p0.gdn_norm); p.w_out = launder_ptr(p0.w_out); p.norm_ffn = launder_ptr(p0.norm_ffn);
    p.router_w = launder_ptr(p0.router_w); p.router_bias = launder_ptr(p0.router_bias); p.exp_gate = launder_ptr(p0.exp_gate); p.exp_up = launder_ptr(p0.exp_up);
    p.exp_down = launder_ptr(p0.exp_down); p.sh_gate = launder_ptr(p0.sh_gate); p.sh_up = launder_ptr(p0.sh_up); p.sh_down = launder_ptr(p0.sh_down);
    p.norm_final = launder_ptr(p0.norm_final); p.out = launder_ptr(p0.out); p.ws = launder_ptr(p0.ws);
    return p;
}
template <int PH>
__device__ __forceinline__ void run_phase(const P& p0, const int l0, LAS unsigned char* lds, const int step = 0) {
    const P p = launder_params(p0);
    int l = l0; asm volatile("" : "+s"(l));
    unsigned char* ws = p.ws;
    const float* mod = (const float*)(ws + OFF_MOD) + (size_t)l * 9 * 6144;
    const bool lat_only = (l == 1);
    if constexpr (PH == PH_PRO) phase_prologue(p, lds);
    if constexpr (PH == PH_NORM1) { if (l == 0) { phase_norm<0, false>(p, l, p.norm_mix + l * D, 1024, 0, false); phase_transposes(p, lds); } else phase_norm<2, false>(p, l, p.norm_mix + l * D, 1024, 0, false); }
    if constexpr (PH == PH_WIN) { SchedDense S{(const bf16_t*)(ws + OFF_WINT + (size_t)l * NWIN * D), D, NWIN / 256, NPAN * (NWIN / 256), (int)gridDim.x, (int)blockIdx.x, 0, 1};
        EpiU E{(bf16_t*)(ws + OFF_UB), p.hgrn_lb, (const float*)(ws + OFF_SCL) + SCL_RA, (const float*)(ws + OFF_SCL) + SCL_WIN + l * 4096, l, lds}; pg8::gemm_phase<EpiU, SchedDense, 2>(lds, ws + OFF_AB, D, S, E); }
    if constexpr (PH == PH_PREP) phase_prep(p, l);
    if constexpr (PH == PH_SCAN) phase_scan(p, l, lds);
    if constexpr (PH == PH_POST) phase_post(p, l, lat_only);
    if constexpr (PH == PH_WOUT) { SchedDense S{(const bf16_t*)(ws + OFF_WOUTT) + (size_t)l * D * D, D, 4, (lat_only ? 256 : NPAN) * 4, (int)gridDim.x, (int)blockIdx.x, lat_only ? 1 : 0, 2};
        EpiRes E{p.x, p.ctx, (bf16_t*)(ws + OFF_HB), mod, l}; pg8::gemm_phase(lds, (const bf16_t*)(ws + OFF_AB), D, S, E);
        }
    if constexpr (PH == PH_NORM2) phase_norm<1, false>(p, l, p.norm_ffn + l * D, 4096, 3072, lat_only);
    if constexpr (PH == PH_ROUTER) { SchedDense S{(const bf16_t*)(ws + OFF_RT) + (size_t)l * 256 * D, D, 1, (lat_only ? 256 : NPAN), (int)gridDim.x, (int)blockIdx.x, lat_only ? 1 : 0, 2};
        EpiRouter E{(float*)(ws + OFF_SC)}; pg8::gemm_phase(lds, (const bf16_t*)(ws + OFF_AB), D, S, E); }
    if constexpr (PH == PH_TOPK) phase_topk(p, l, lat_only, lds);
    if constexpr (PH == PH_LISTS) phase_lists(p, l, lat_only, lds);
    if constexpr (PH == PH_MOE) {
        const LAS int* segp = load_segp(p, lds, step == 0 || !MK_ONE_LAUNCH);
        const int G = (int)gridDim.x, bid = (int)blockIdx.x;
        if (step > 0) {
            SchedS2 S{segp, (const bf16_t*)(ws + OFF_W2T), (const bf16_t*)(ws + OFF_SH2T + (size_t)l * D * 256), 0, 4 * segp[NSEG], G, bid, 4 * segp[NSEG - 1]};
            EpiMoE E{(const int*)(ws + OFF_RINFO), mod, ws, lds + LDS_XS};
            pg8::gemm_phase<EpiMoE, SchedS2, 1>(lds, ws + OFF_HACT, 256, S, E); }
        else { SchedS1 S{segp, (const int*)(ws + OFF_RINFO), (const bf16_t*)(ws + OFF_W1T), (const bf16_t*)(ws + OFF_SH1T + (size_t)l * 512 * D), 0, 2 * segp[NSEG], G, bid};
            EpiGLU E{(bf16_t*)(ws + OFF_HACT), (const float*)(ws + OFF_RGATE), (const int*)(ws + OFF_RINFO), lds}; pg8::gemm_phase<EpiGLU, SchedS1, 1>(lds, ws + OFF_F8, D, S, E); }
    }
    if constexpr (PH == PH_FINAL) phase_norm<2, true>(p, l, p.norm_final, 0, 0, true);
}

template <int PH>
__global__ void __launch_bounds__(NTHR, 2) k_phase(P p, int l, int step) {
    extern __shared__ __attribute__((aligned(16))) unsigned char smem[];
    run_phase<PH>(p, l, (LAS unsigned char*)smem, step);
}

#if MK_ONE_LAUNCH
__global__ void __launch_bounds__(NTHR, 2) k_mega(P p) {
    extern __shared__ __attribute__((aligned(16))) unsigned char smem[];
    LAS unsigned char* lds = (LAS unsigned char*)smem;
    if (threadIdx.x < 4) ((LAS unsigned*)(lds + LDS_BARW))[threadIdx.x] = 0u;
    __syncthreads();
    XcdBarrier bar = xcd_barrier_post((unsigned*)(p.ws + OFF_BAR), (volatile LAS unsigned*)(lds + LDS_BARW));
    run_phase<PH_PRO>(p, 0, lds); xcd_barrier(bar);
    for (int l = 0; l < 2; ++l) {
        run_phase<PH_NORM1>(p, l, lds); xcd_barrier(bar);
        run_phase<PH_WIN>(p, l, lds); xcd_barrier(bar);
        run_phase<PH_PREP>(p, l, lds); xcd_barrier(bar);
        run_phase<PH_SCAN>(p, l, lds); xcd_barrier(bar);
        run_phase<PH_POST>(p, l, lds); xcd_barrier(bar);
        run_phase<PH_WOUT>(p, l, lds); xcd_barrier(bar);
        run_phase<PH_NORM2>(p, l, lds); xcd_barrier(bar);
        run_phase<PH_ROUTER>(p, l, lds); xcd_barrier(bar);
        run_phase<PH_TOPK>(p, l, lds); xcd_barrier(bar);
        run_phase<PH_LISTS>(p, l, lds); xcd_barrier(bar);
        for (int st = 0; st < 2; ++st) { run_phase<PH_MOE>(p, l, lds, st); xcd_barrier(bar); }
    }
    run_phase<PH_FINAL>(p, 1, lds);
}
#endif

template <int PH> static void launch_phase(const P& p, int l, hipStream_t stream, int step = 0) {
    static bool attr = false;
    if (!attr) { (void)hipFuncSetAttribute((const void*)k_phase<PH>, hipFuncAttributeMaxDynamicSharedMemorySize, LDS_BYTES); attr = true; }
    hipLaunchKernelGGL(k_phase<PH>, dim3(GRID), dim3(NTHR), LDS_BYTES, stream, p, l, step);
}

extern "C" void kernel_launch(void* const* d_in, const int* in_sizes, int n_in, void* d_out, int out_size, void* d_ws, size_t ws_size, hipStream_t stream) {
    if (n_in != 31 || ws_size < WS_END || out_size != NBATCH * SEQ * D) { fprintf(stderr, "kernel_launch: unexpected shapes: n_in %d ws %zu (need %zu) out %d\n", n_in, ws_size, (size_t)WS_END, out_size); return; }
    P p{};
    const float** f = (const float**)&p;
    for (int i = 0; i < 31; ++i) f[i] = (const float*)d_in[i];
    p.out = (float*)d_out; p.ws = (unsigned char*)d_ws;
#if MK_ONE_LAUNCH
    static bool attr = false;
    if (!attr) { (void)hipFuncSetAttribute((const void*)k_mega, hipFuncAttributeMaxDynamicSharedMemorySize, LDS_BYTES); attr = true; }
    (void)hipMemsetAsync(d_ws, 0, 16384, stream);
    hipLaunchKernelGGL(k_mega, dim3(GRID), dim3(NTHR), LDS_BYTES, stream, p);
#else
    launch_phase<PH_PRO>(p, 0, stream);
    for (int l = 0; l < 2; ++l) {
        launch_phase<PH_NORM1>(p, l, stream); launch_phase<PH_WIN>(p, l, stream); launch_phase<PH_PREP>(p, l, stream); launch_phase<PH_SCAN>(p, l, stream);
        launch_phase<PH_POST>(p, l, stream); launch_phase<PH_WOUT>(p, l, stream); launch_phase<PH_NORM2>(p, l, stream); launch_phase<PH_ROUTER>(p, l, stream);
        launch_phase<PH_TOPK>(p, l, stream); launch_phase<PH_LISTS>(p, l, stream);
        for (int st = 0; st < 2; ++st) launch_phase<PH_MOE>(p, l, stream, st);
    }
    launch_phase<PH_FINAL>(p, 1, stream);
#endif
}
```

```cpp
#include <hip/hip_runtime.h>
#include <stdint.h>
#include <stdio.h>

#ifndef MK_ONE_LAUNCH
#define MK_ONE_LAUNCH 1
#endif

#define LAS __attribute__((address_space(3)))
typedef unsigned short bf16_t;
typedef short bf16x8 __attribute__((ext_vector_type(8)));
typedef float f32x4 __attribute__((ext_vector_type(4)));
typedef unsigned u32x4 __attribute__((ext_vector_type(4)));
typedef unsigned u32x2 __attribute__((ext_vector_type(2)));

constexpr int D = 1024, NBATCH = 8, SEQ = 8192, CTXL = 256, TPS = SEQ + CTXL;
constexpr int NROW = NBATCH * TPS;
constexpr int NPAN = NROW / 256;
constexpr int UC = 3872;
constexpr int NWIN = 4096;
constexpr int GRID = 256, NTHR = 512;
constexpr float EPS = 1e-6f;
constexpr int C_Z = 0, C_X = 512, C_B = 1024, C_C = 1280, C_DT = 1536;
constexpr int C_HQ = 1552, C_HF = 1808, C_HI = 2320, C_HG = 2576;
constexpr int C_GQ = 2832, C_GK = 3088, C_GV = 3344, C_GA = 3600, C_GB = 3608, C_GG = 3616;
constexpr int NSEG = 65;
constexpr int MAXPROWS = 9 * NROW + NSEG * 256;
static_assert(MAXPROWS / 256 <= 4096, "panel table");

constexpr size_t al256(size_t x) { return (x + 255) & ~(size_t)255; }
constexpr size_t OFF_BAR = 0;
constexpr size_t OFF_CVTQ = 14336;
constexpr size_t OFF_MOD = 16384;
constexpr size_t OFF_WINT = al256(OFF_MOD + (size_t)2 * 9 * 6144 * 4);
constexpr size_t OFF_WOUTT = OFF_WINT + (size_t)2 * NWIN * D * 2;
constexpr size_t OFF_SH1T = OFF_WOUTT + (size_t)2 * D * D * 2;
constexpr size_t OFF_SH2T = OFF_SH1T + (size_t)2 * 512 * D * 2;
constexpr size_t OFF_RT = OFF_SH2T + (size_t)2 * D * 256 * 2;
constexpr size_t OFF_SCL = OFF_RT + (size_t)2 * 256 * D * 2;
constexpr size_t SCL_BYTES = (size_t)2 << 20;
constexpr size_t ACT_BYTES = (size_t)NROW * D * 2;
constexpr size_t OFF_HB = OFF_SCL + SCL_BYTES;
constexpr size_t OFF_AB = OFF_HB + ACT_BYTES;
constexpr size_t OFF_Y2 = OFF_AB + ACT_BYTES;
constexpr size_t OFF_UB = OFF_Y2 + ACT_BYTES;
constexpr size_t UB_BYTES = (size_t)NROW * UC * 2;
constexpr size_t OFF_XW = OFF_UB + UB_BYTES;
constexpr size_t OFF_W1T = OFF_XW;
constexpr size_t OFF_W2T = OFF_W1T + (size_t)64 * 512 * D * 2;
constexpr size_t WS_END = OFF_W2T + (size_t)64 * D * 256 * 2;
constexpr size_t OFF_F8 = OFF_Y2;
constexpr size_t OFF_SEGP = OFF_UB;
constexpr size_t OFF_RINFO = OFF_SEGP + 1024;
constexpr size_t OFF_RGATE = al256(OFF_RINFO + (size_t)MAXPROWS * 4);
constexpr size_t OFF_HACT = al256(OFF_RGATE + (size_t)MAXPROWS * 4);
constexpr size_t OFF_SLOTU = al256(OFF_HACT + (size_t)MAXPROWS * 256);
constexpr size_t SLOT_BYTES = (size_t)NROW * D;
static_assert(OFF_SLOTU + 5 * SLOT_BYTES <= OFF_XW, "MoE scratch overflow");
constexpr size_t OFF_SC = OFF_SLOTU;
constexpr size_t OFF_TOKE = OFF_SC + (size_t)NROW * 64 * 4;
constexpr size_t OFF_TOKG = OFF_TOKE + (size_t)NROW * 8 * 4;
constexpr size_t OFF_TOKLR = OFF_TOKG + (size_t)NROW * 8 * 4;
constexpr size_t OFF_BCNT = OFF_TOKLR + (size_t)NROW * 12 * 4;
static_assert(WS_END < ((size_t)1 << 32), "32-bit workspace offsets");
constexpr float SLOT_SCALE = 32.f;
constexpr float HACT_SCALE = 8.f, W2_SCALE = 4.f;
static_assert(HACT_SCALE * W2_SCALE == SLOT_SCALE, "slot scale");
__host__ __device__ constexpr size_t slot_off(int k) { return k == 0 ? OFF_AB + SLOT_BYTES : (k < 3 ? OFF_Y2 + (size_t)(k - 1) * SLOT_BYTES : OFF_SLOTU + (size_t)(k - 3) * SLOT_BYTES); }

constexpr int SCL_WIN = 0;
constexpr int SCL_WOUT = SCL_WIN + 2 * 4096;
constexpr int SCL_SH1 = SCL_WOUT + 2 * 1024;
constexpr int SCL_W1 = SCL_SH1 + 2 * 512;
constexpr int SCL_RA = SCL_W1 + 64 * 512;
constexpr int SCL_RF = SCL_RA + NROW;
constexpr int SCL_RY = SCL_RF + NROW;
static_assert((size_t)(SCL_RY + NROW) * 4 <= SCL_BYTES, "scale region overflow");
constexpr int LDS_STAGE = 131072;
constexpr int LDS_BARW = LDS_STAGE;
constexpr int LDS_TAB = LDS_STAGE + 1024;
constexpr int LDS_XS = LDS_STAGE + 2048;
constexpr int XS_WAVE = 2304;
constexpr int LDS_AUX = LDS_XS + 8 * XS_WAVE;
constexpr int LDS_SEGT = LDS_AUX + 4096;
constexpr int LDS_BYTES = LDS_SEGT + 4096;

struct P {
    const float *x, *c, *ctx, *c_ctx, *w_mod, *b_mod, *norm_mix, *w_in, *ssd_conv_w, *ssd_conv_b, *ssd_dt_bias, *ssd_a_log, *ssd_d, *ssd_norm,
        *hgrn_lb, *hgrn_norm, *gdn_conv_w, *gdn_dt_bias, *gdn_a_log, *gdn_norm, *w_out, *norm_ffn, *router_w, *router_bias, *exp_gate, *exp_up,
        *exp_down, *sh_gate, *sh_up, *sh_down, *norm_final;
    float* out;
    unsigned char* ws;
};

__device__ __forceinline__ float bf2f(bf16_t v) { return __uint_as_float((unsigned)v << 16); }
__device__ __forceinline__ float bflo(unsigned v) { return __uint_as_float(v << 16); }
__device__ __forceinline__ float bfhi(unsigned v) { return __uint_as_float(v & 0xffff0000u); }
typedef float f32x2_t __attribute__((ext_vector_type(2)));
typedef __bf16 bf16x2_t __attribute__((ext_vector_type(2)));
__device__ __forceinline__ unsigned pk2(float lo, float hi) { const f32x2_t v = {lo, hi}; const bf16x2_t b = __builtin_convertvector(v, bf16x2_t); return __builtin_bit_cast(unsigned, b); }
__device__ __forceinline__ unsigned pk4_fp8(float a, float b, float c, float d) { int w = 0; w = __builtin_amdgcn_cvt_pk_fp8_f32(a, b, w, false); w = __builtin_amdgcn_cvt_pk_fp8_f32(c, d, w, true); return (unsigned)w; }
__device__ __forceinline__ u32x2 pack8_fp8(const float (&f)[8], float sc) { u32x2 o; o.x = pk4_fp8(f[0] * sc, f[1] * sc, f[2] * sc, f[3] * sc); o.y = pk4_fp8(f[4] * sc, f[5] * sc, f[6] * sc, f[7] * sc); return o; }
__device__ __forceinline__ unsigned pk4_i8(float a, float b, float c, float d, float inv) {
    unsigned w = 0;
    w = __builtin_amdgcn_cvt_pk_u8_f32(__builtin_rintf(a * inv) + 128.f, 0, w); w = __builtin_amdgcn_cvt_pk_u8_f32(__builtin_rintf(b * inv) + 128.f, 1, w);
    w = __builtin_amdgcn_cvt_pk_u8_f32(__builtin_rintf(c * inv) + 128.f, 2, w); w = __builtin_amdgcn_cvt_pk_u8_f32(__builtin_rintf(d * inv) + 128.f, 3, w);
    return w ^ 0x80808080u; }
__device__ __forceinline__ u32x2 pack8_i8(const float (&f)[8], float inv) { u32x2 o; o.x = pk4_i8(f[0], f[1], f[2], f[3], inv); o.y = pk4_i8(f[4], f[5], f[6], f[7], inv); return o; }
__device__ __forceinline__ float wave_max(float v) {
#pragma unroll
    for (int o = 1; o < 64; o <<= 1) v = fmaxf(v, __shfl_xor(v, o));
    return v;
}
__device__ __forceinline__ bf16_t f2bf(float f) { return (bf16_t)(pk2(f, 0.f) & 0xffffu); }
__device__ __forceinline__ float sigmoidf_(float x) { return __builtin_amdgcn_rcpf(1.f + __expf(-x)); }
__device__ __forceinline__ float siluf_(float x) { return x * __builtin_amdgcn_rcpf(1.f + __expf(-x)); }
__device__ __forceinline__ float softplusf_(float x) { return fmaxf(x, 0.f) + log1pf(__expf(-fabsf(x))); }
__device__ __forceinline__ int opaque_tid() { int t = threadIdx.x; asm volatile("" : "+v"(t)); return t; }
__device__ __forceinline__ float wave_sum(float v) {
#pragma unroll
    for (int o = 1; o < 64; o <<= 1) v += __shfl_xor(v, o);
    return v;
}
__device__ __forceinline__ int row_b(int row) { return row / TPS; }
__device__ __forceinline__ int row_pos(int row) { return row % TPS; }
__device__ __forceinline__ int mod_idx(int row) { return (row % TPS) < CTXL ? 8 : row / TPS; }
__device__ __forceinline__ const float* src_row_f32(const P& p, int row) {
    const int b = row / TPS, pos = row - b * TPS;
    return pos < CTXL ? p.ctx + ((size_t)b * CTXL + pos) * D : p.x + ((size_t)b * SEQ + (pos - CTXL)) * D;
}
__device__ __forceinline__ void unpack8(const u32x4 v, float (&f)[8]) {
    f[0] = bflo(v.x); f[1] = bfhi(v.x); f[2] = bflo(v.y); f[3] = bfhi(v.y); f[4] = bflo(v.z); f[5] = bfhi(v.z); f[6] = bflo(v.w); f[7] = bfhi(v.w);
}
__device__ __forceinline__ u32x4 pack8(const float (&f)[8]) { u32x4 o; o.x = pk2(f[0], f[1]); o.y = pk2(f[2], f[3]); o.z = pk2(f[4], f[5]); o.w = pk2(f[6], f[7]); return o; }

#define GAS __attribute__((address_space(1)))
template <class T> __device__ __forceinline__ T* launder_ptr(T* ptr) { unsigned long long v = (unsigned long long)ptr; asm volatile("" : "+s"(v)); return (T*)(GAS T*)v; }
#define XB_TMO      128
#define XB_XCNT(j)  (256  + 64 * (j))
#define XB_XSUB(j)  (1280 + 64 * (j))
#define XB_XGEN(j)  (2304 + 64 * (j))
#define XB_TOP      3328
#define XB_TOPGEN   3392
#define XCD_BAR_WORDS 3456
#define XB_SPIN_CAP (1u << 18)
__device__ __forceinline__ unsigned xb_ld(unsigned* p)              { return __hip_atomic_load(p, __ATOMIC_RELAXED, __HIP_MEMORY_SCOPE_AGENT); }
__device__ __forceinline__ unsigned xb_add(unsigned* p, unsigned v) { return __hip_atomic_fetch_add(p, v, __ATOMIC_RELAXED, __HIP_MEMORY_SCOPE_AGENT); }
__device__ __forceinline__ unsigned xb_xcc_id() { return (unsigned)__builtin_amdgcn_s_getreg((3 << 11) | 20) & 0xFu; }
#define XB_SPIN(cond, bar) do { unsigned _sp = 0; while (cond) { __builtin_amdgcn_s_sleep(1); \
    if ((++_sp & 255u) == 0u) { if (xb_ld(&(bar)[XB_TMO])) break; if (_sp > XB_SPIN_CAP) { atomicAdd(&(bar)[XB_TMO], 1u); break; } } } } while (0)
struct XcdBarrier { unsigned* bar; unsigned x; volatile LAS unsigned* st; };
__device__ __forceinline__ XcdBarrier xcd_barrier_post(unsigned* bar, volatile LAS unsigned* st) {
    XcdBarrier b; b.bar = bar; b.x = xb_xcc_id(); b.st = st;
    if (threadIdx.x == 0) (void)xb_add(&bar[XB_XCNT(b.x)], 1u);
    return b;
}
__device__ __forceinline__ void xcd_barrier_complete(unsigned* bar, unsigned x, unsigned& nloc, unsigned& nx) {
    const unsigned G = gridDim.x * gridDim.y * gridDim.z;
    unsigned sum, cnt, mine, sp = 0u;
    for (;;) {
        sum = 0u; cnt = 0u; mine = 0u;
#pragma unroll
        for (unsigned j = 0; j < 16; ++j) { const unsigned c = xb_ld(&bar[XB_XCNT(j)]); sum += c; cnt += (c > 0u) ? 1u : 0u; mine = (j == x) ? c : mine; }
        if (sum == G) break;
        __builtin_amdgcn_s_sleep(1);
        if ((++sp & 255u) == 0u) { if (xb_ld(&bar[XB_TMO])) break; if (sp > XB_SPIN_CAP) { atomicAdd(&bar[XB_TMO], 1u); break; } }
    }
    nloc = mine > 0u ? mine : 1u; nx = cnt > 0u ? cnt : 1u;
}
__device__ __forceinline__ void xcd_barrier(const XcdBarrier& b) {
    asm volatile("s_waitcnt vmcnt(0)" ::: "memory");
    __syncthreads();
    if (threadIdx.x == 0) {
        unsigned* bar = launder_ptr(b.bar);
        __builtin_amdgcn_s_waitcnt(0);
        const unsigned bx = xb_xcc_id();
        unsigned nloc = b.st[0], nx = b.st[1];
        if (nloc == 0u) { xcd_barrier_complete(bar, bx, nloc, nx); b.st[0] = nloc; b.st[1] = nx; }
        const unsigned old = xb_add(&bar[XB_XSUB(bx)], 1u);
        const unsigned gen = old / nloc;
        if (old + 1u == (gen + 1u) * nloc) {
            __builtin_amdgcn_fence(__ATOMIC_RELEASE, "agent");
            asm volatile("s_waitcnt vmcnt(0)" ::: "memory");
            const unsigned og = xb_add(&bar[XB_TOP], 1u);
            const unsigned tg = og / nx;
            if (og + 1u == (tg + 1u) * nx) xb_add(&bar[XB_TOPGEN], 1u);
            else XB_SPIN(xb_ld(&bar[XB_TOPGEN]) == tg, bar);
            __builtin_amdgcn_fence(__ATOMIC_ACQUIRE, "agent");
            xb_add(&bar[XB_XGEN(bx)], 1u);
            asm volatile("s_waitcnt vmcnt(0)" ::: "memory");
        } else {
            XB_SPIN(xb_ld(&bar[XB_XGEN(bx)]) == gen, bar);
            __builtin_amdgcn_fence(__ATOMIC_ACQUIRE, "agent");
            asm volatile("s_waitcnt vmcnt(0)" ::: "memory");
        }
    }
    __syncthreads();
}

namespace pg8 {
constexpr int BM = 256, BK = 64, HALF = 128, HTB = HALF * BK * 2, STAGE_BYTES = 8 * HTB;
__device__ __forceinline__ int lds_byte(int r, int c) { const int st = (r >> 4) * 2 + (c >> 5), rr = r & 15, cc = c & 31, ob = rr * 64 + cc * 2; return st * 1024 + (ob ^ (((ob >> 9) & 1) << 5)); }
__device__ __forceinline__ void stage_rc(int b, int& R, int& C) { const int st = b / 1024, sb = b % 1024, swz = sb ^ (((sb >> 9) & 1) << 5); R = (st >> 1) * 16 + swz / 64; C = (st & 1) * 32 + (swz % 64) / 2; }
__device__ __forceinline__ int perm32(int rho) { const int n = rho >> 4, i = rho & 15; return 8 * (i >> 2) + 4 * n + (i & 3); }
constexpr bool GEMM_SP2 = true;
constexpr bool GEMM_ALIGN = true;
struct Unit { int pm, pn, aux; };
typedef int i32x8 __attribute__((ext_vector_type(8)));
typedef int i32x8a __attribute__((ext_vector_type(8), aligned(16)));
typedef int i32x4 __attribute__((ext_vector_type(4)));
__device__ __forceinline__ i32x8 cat8(const bf16x8 lo, const bf16x8 hi) { const i32x4 a = __builtin_bit_cast(i32x4, lo), b = __builtin_bit_cast(i32x4, hi); return (i32x8){a[0], a[1], a[2], a[3], b[0], b[1], b[2], b[3]}; }
constexpr float W8_SCALE = 16.f;

template <class Epi, class Sched, int MODE = 0, bool SP2 = GEMM_SP2, bool ALIGN_EPI = GEMM_ALIGN>
__device__ __forceinline__ void gemm_phase(LAS unsigned char* lds, const void* Abase, const int K, const Sched& S, const Epi& E) {
    const int tid = opaque_tid(), wid = __builtin_amdgcn_readfirstlane(tid >> 6), lane = tid & 63, wr = wid >> 2, wc = wid & 3, fr = lane & 15, fq = lane >> 4;
    constexpr bool FP8 = (MODE == 1); constexpr int ESZ = MODE ? 1 : 2;
    const int nt = K * ESZ / (BK * 2);
    constexpr int PM = (int)Epi::PERM;
    unsigned voffB[2], voffB1[2];
#pragma unroll
    for (int i = 0; i < 2; ++i) { int R, C; stage_rc(tid * 16 + i * 8192, R, C);
        if constexpr (PM == 2) { const int w_ = R >> 5, n_ = (R >> 4) & 1, i_ = R & 15, rb = 64 * w_ + 16 * (i_ >> 2) + 4 * n_ + (i_ & 3);
            voffB[i] = (unsigned)(rb * K * ESZ + C * 2); voffB1[i] = (unsigned)((rb + 8) * K * ESZ + C * 2); }
        else { const int Rb = PM ? ((R & ~31) + perm32(R & 31)) : R;
            voffB[i] = (unsigned)(Rb * K * ESZ + C * 2); voffB1[i] = 0u; } }
    const size_t kstep = (size_t)(BK * 2);
    const size_t hstep = PM == 2 ? (size_t)0 : (size_t)HALF * K * ESZ;
#define PG8_VB1 (PM == 2 ? voffB1 : voffB)
    const unsigned ldsw = (unsigned)wid * 1024u;
    const int aoff = lds_byte(wr * 64 + fr, fq * 8), boff = lds_byte(wc * 32 + fr, fq * 8);
#define PG8_SA(b, h) (((b) * 2 + (h)) * HTB)
#define PG8_SB(b, h) ((4 + (b) * 2 + (h)) * HTB)
#define PG8_STAGE(bufoff, gbase, voff) do { _Pragma("unroll") for (int _i = 0; _i < 2; ++_i) \
        __builtin_amdgcn_global_load_lds((const unsigned*)((const char*)(gbase) + (voff)[_i]), (LAS unsigned*)(lds + (bufoff) + ldsw + _i * 8192), 16, 0, 0); } while (0)
#define PG8_LDA(dst, b, h) do { _Pragma("unroll") for (int m = 0; m < 4; ++m) { \
        if constexpr (FP8) dst##8[m] = cat8(*(const LAS bf16x8*)(lds + PG8_SA(b, h) + aoff + m * 2048), *(const LAS bf16x8*)(lds + PG8_SA(b, h) + aoff + m * 2048 + 1024));   \
        else { _Pragma("unroll") for (int k = 0; k < 2; ++k) dst[m][k] = *(const LAS bf16x8*)(lds + PG8_SA(b, h) + aoff + m * 2048 + k * 1024); } } } while (0)
#define PG8_LDB(dst, b, h) do { _Pragma("unroll") for (int n = 0; n < 2; ++n) { \
        if constexpr (FP8) dst##8[n] = cat8(*(const LAS bf16x8*)(lds + PG8_SB(b, h) + boff + n * 2048), *(const LAS bf16x8*)(lds + PG8_SB(b, h) + boff + n * 2048 + 1024)); \
        else { _Pragma("unroll") for (int k = 0; k < 2; ++k) dst[n][k] = *(const LAS bf16x8*)(lds + PG8_SB(b, h) + boff + n * 2048 + k * 1024); } } } while (0)
#define PG8_MMA(ai, bj, At, Bt) do { __builtin_amdgcn_s_setprio(1); _Pragma("unroll") for (int m = 0; m < 4; ++m) _Pragma("unroll") for (int n = 0; n < 2; ++n) { \
        if constexpr (FP8) asm volatile("v_mfma_f32_16x16x128_f8f6f4 %0, %1, %2, %0" : "+v"(acc[ai][bj][m][n]) : "v"(Bt##8[n]), "v"(At##8[m]));   \
        else if constexpr (MODE == 2) { _Pragma("unroll") for (int k = 0; k < 2; ++k) acc[ai][bj][m][n] = __builtin_bit_cast(f32x4, __builtin_amdgcn_mfma_i32_16x16x64_i8(__builtin_bit_cast(i32x4, Bt[n][k]), __builtin_bit_cast(i32x4, At[m][k]), __builtin_bit_cast(i32x4, acc[ai][bj][m][n]), 0, 0, 0)); } \
        else { _Pragma("unroll") for (int k = 0; k < 2; ++k) acc[ai][bj][m][n] = __builtin_amdgcn_mfma_f32_16x16x32_bf16(Bt[n][k], At[m][k], acc[ai][bj][m][n], 0, 0, 0); } } \
        __builtin_amdgcn_s_setprio(0); } while (0)
#define PG8_WAIT_V(n) asm volatile("s_waitcnt vmcnt(" #n ")" ::: "memory")
#define PG8_WAIT_L(n) asm volatile("s_waitcnt lgkmcnt(" #n ")" ::: "memory")
#define PG8_BAR __builtin_amdgcn_s_barrier()
#define PG8_SCHED __builtin_amdgcn_sched_barrier(0)
    Unit cur, nxt; int ui = 0;
    if (!S.next(0, cur)) return;
    f32x4 acc[2][2][4][2];
#pragma unroll
    for (int a = 0; a < 2; ++a)
#pragma unroll
        for (int b = 0; b < 2; ++b)
#pragma unroll
            for (int m = 0; m < 4; ++m)
#pragma unroll
                for (int n = 0; n < 2; ++n) acc[a][b][m][n] = (f32x4){0.f, 0.f, 0.f, 0.f};
    bf16x8 At[4][2], B0[2][2], B1[2][2];
    i32x8 At8[4], B08[2], B18[2];
    unsigned cvA[2][2], nvA[2][2];
    S.avoff(cur, cvA);
    const char* gA = (const char*)Abase;
    const char* cB = S.bptr(cur);
    if constexpr (Epi::AUX) E.stage_aux(lds, cur, 0);
    if constexpr (SP2) {
        PG8_STAGE(PG8_SB(0, 0), cB, voffB); PG8_STAGE(PG8_SB(0, 1), cB + hstep, PG8_VB1); PG8_STAGE(PG8_SA(0, 0), gA, cvA[0]); PG8_STAGE(PG8_SA(0, 1), gA, cvA[1]);
        if (wr == 1) PG8_BAR;
        PG8_WAIT_V(2); PG8_BAR;
        PG8_STAGE(PG8_SB(1, 0), cB + kstep, voffB); PG8_STAGE(PG8_SA(1, 0), gA + kstep, cvA[0]); PG8_STAGE(PG8_SB(1, 1), cB + hstep + kstep, PG8_VB1);
        PG8_WAIT_V(6); PG8_BAR;
    } else {
    PG8_STAGE(PG8_SB(0, 0), cB, voffB); PG8_STAGE(PG8_SA(0, 0), gA, cvA[0]); PG8_STAGE(PG8_SB(0, 1), cB + hstep, PG8_VB1); PG8_STAGE(PG8_SA(0, 1), gA, cvA[1]);
    if (wr == 1) PG8_BAR;
    PG8_WAIT_V(4); PG8_BAR;
    PG8_STAGE(PG8_SB(1, 0), cB + kstep, voffB); PG8_STAGE(PG8_SA(1, 0), gA + kstep, cvA[0]); PG8_STAGE(PG8_SB(1, 1), cB + hstep + kstep, PG8_VB1);
    PG8_WAIT_V(6); PG8_BAR;
    }
    for (;;) {
        const bool has_next = S.next(ui + 1, nxt);
        const char* nB = has_next ? S.bptr(nxt) : cB;
        if (has_next && !Sched::TAB_AVOFF) S.avoff(nxt, nvA);
        else {
#pragma unroll
            for (int h = 0; h < 2; ++h)
#pragma unroll
                for (int i = 0; i < 2; ++i) nvA[h][i] = cvA[h][i];
        }
#pragma unroll 1
        for (int t = 0; t < nt; t += 2) {
            const bool last = (t == nt - 2);
            if constexpr (Sched::TAB_AVOFF) { if (last && has_next) S.avoff_tab(nvA, (const LAS int*)(lds + LDS_AUX + ((ui + 1) & 1) * 2048)); }
            const char* a1 = gA + (size_t)(t + 1) * kstep;
            const char* a2 = last ? gA : gA + (size_t)(t + 2) * kstep; const char* b2 = last ? nB : cB + (size_t)(t + 2) * kstep;
            const char* a3 = a2 + kstep; const char* b3 = b2 + kstep;
            unsigned v2[2][2];
#pragma unroll
            for (int h = 0; h < 2; ++h)
#pragma unroll
                for (int i = 0; i < 2; ++i) v2[h][i] = last ? nvA[h][i] : cvA[h][i];
            if constexpr (SP2) {
            PG8_LDB(B0, 0, 0); PG8_LDB(B1, 0, 1); PG8_SCHED; PG8_LDA(At, 0, 0); PG8_STAGE(PG8_SA(1, 1), a1, cvA[1]);
            PG8_WAIT_V(8); PG8_WAIT_L(0); PG8_BAR; PG8_MMA(0, 0, At, B0); PG8_MMA(0, 1, At, B1); PG8_BAR; PG8_SCHED;
            if constexpr (Epi::AUX) { if (t == 0) E.stage_aux(lds, has_next ? nxt : cur, (ui + 1) & 1); }
            PG8_LDA(At, 0, 1); PG8_STAGE(PG8_SB(0, 0), b2, voffB); PG8_STAGE(PG8_SB(0, 1), b2 + hstep, PG8_VB1); PG8_STAGE(PG8_SA(0, 0), a2, v2[0]);
            PG8_WAIT_V(8); PG8_WAIT_L(0); PG8_BAR; PG8_MMA(1, 0, At, B0); PG8_MMA(1, 1, At, B1); PG8_BAR; PG8_SCHED;
            PG8_LDB(B0, 1, 0); PG8_LDB(B1, 1, 1); PG8_SCHED; PG8_LDA(At, 1, 0); PG8_STAGE(PG8_SA(0, 1), a2, v2[1]);
            PG8_WAIT_V(8); PG8_WAIT_L(0); PG8_BAR; PG8_MMA(0, 0, At, B0); PG8_MMA(0, 1, At, B1); PG8_BAR; PG8_SCHED;
            PG8_LDA(At, 1, 1); PG8_STAGE(PG8_SB(1, 0), b3, voffB); PG8_STAGE(PG8_SB(1, 1), b3 + hstep, PG8_VB1); PG8_STAGE(PG8_SA(1, 0), a3, v2[0]);
            PG8_WAIT_V(8); PG8_WAIT_L(0); PG8_BAR; PG8_MMA(1, 0, At, B0); PG8_MMA(1, 1, At, B1); PG8_BAR; PG8_SCHED;
            } else {
            PG8_LDB(B0, 0, 0); PG8_SCHED; PG8_LDA(At, 0, 0); PG8_STAGE(PG8_SA(1, 1), a1, cvA[1]);
            PG8_WAIT_L(8); PG8_BAR; PG8_WAIT_L(0); PG8_MMA(0, 0, At, B0); PG8_BAR; PG8_SCHED;
            PG8_LDB(B1, 0, 1); PG8_STAGE(PG8_SB(0, 0), b2, voffB);
            PG8_BAR; PG8_WAIT_L(0); PG8_MMA(0, 1, At, B1); PG8_BAR;
            PG8_LDA(At, 0, 1); PG8_STAGE(PG8_SA(0, 0), a2, v2[0]);
            PG8_BAR; PG8_WAIT_L(0); PG8_MMA(1, 0, At, B0); PG8_BAR; PG8_SCHED;
            PG8_STAGE(PG8_SB(0, 1), b2 + hstep, PG8_VB1);
            PG8_WAIT_V(6); PG8_BAR; PG8_MMA(1, 1, At, B1); PG8_BAR;
            PG8_LDB(B0, 1, 0); PG8_SCHED; PG8_LDA(At, 1, 0); PG8_STAGE(PG8_SA(0, 1), a2, v2[1]);
            PG8_WAIT_L(8); PG8_BAR; PG8_WAIT_L(0); PG8_MMA(0, 0, At, B0); PG8_BAR; PG8_SCHED;
            PG8_LDB(B1, 1, 1); PG8_STAGE(PG8_SB(1, 0), b3, voffB);
            PG8_BAR; PG8_WAIT_L(0); PG8_MMA(0, 1, At, B1); PG8_BAR;
            PG8_LDA(At, 1, 1); PG8_STAGE(PG8_SA(1, 0), a3, v2[0]);
            PG8_BAR; PG8_WAIT_L(0); PG8_MMA(1, 0, At, B0); PG8_BAR; PG8_SCHED;
            PG8_STAGE(PG8_SB(1, 1), b3 + hstep, PG8_VB1);
            PG8_WAIT_V(6); PG8_BAR; PG8_MMA(1, 1, At, B1); PG8_BAR;
            }
        }
        if constexpr (ALIGN_EPI) { if (wr == 0) PG8_BAR; }
        if constexpr (FP8) asm volatile("s_nop 15\n\ts_nop 15" ::: "memory");
        E(acc, cur, wr, wc, ui, fq);
        if (!has_next) break;
#pragma unroll
        for (int a = 0; a < 2; ++a)
#pragma unroll
            for (int b = 0; b < 2; ++b)
#pragma unroll
                for (int m = 0; m < 4; ++m)
#pragma unroll
                    for (int n = 0; n < 2; ++n) acc[a][b][m][n] = (f32x4){0.f, 0.f, 0.f, 0.f};
        cur = nxt; cB = nB; ++ui;
#pragma unroll
        for (int h = 0; h < 2; ++h)
#pragma unroll
            for (int i = 0; i < 2; ++i) cvA[h][i] = nvA[h][i];
        if constexpr (ALIGN_EPI) { if (wr == 1) PG8_BAR; }
    }
    PG8_WAIT_V(0);
    if constexpr (!ALIGN_EPI) { if (wr == 0) PG8_BAR; }
    PG8_BAR;
#undef PG8_SA
#undef PG8_VB1
#undef PG8_SB
#undef PG8_STAGE
#undef PG8_LDA
#undef PG8_LDB
#undef PG8_MMA
#undef PG8_WAIT_V
#undef PG8_WAIT_L
#undef PG8_BAR
#undef PG8_SCHED
}
}
using pg8::Unit; using pg8::W8_SCALE; using pg8::i32x4;

struct SchedDense {
    static constexpr bool TAB_AVOFF = false;
    const bf16_t* Bt; int K, nN, nUnits, G, c, latOnly, esz;
    __device__ __forceinline__ bool next(int i, Unit& u) const {
        const int L = i * G + c; if (L >= nUnits) return false;
        int wgid = L; { const int qq = nUnits / 8, rr = nUnits % 8, xcd = wgid % 8, off = wgid / 8; wgid = (xcd < rr ? xcd * (qq + 1) : rr * (qq + 1) + (xcd - rr) * qq) + off; }
        const int nM = nUnits / nN, nig = 8 * nN, gid = wgid / nig, fm = gid * 8, gsz = (nM - fm) < 8 ? (nM - fm) : 8;
        const int q = fm + ((wgid % nig) % gsz); u.pn = (wgid % nig) / gsz;
        u.pm = latOnly ? (q >> 5) * 33 + 1 + (q & 31) : q; u.aux = 0; return true;
    }
    __device__ __forceinline__ void avoff(const Unit& u, unsigned (&v)[2][2]) const {
        int R[2], C[2]; { const int t_ = opaque_tid(); pg8::stage_rc(t_ * 16, R[0], C[0]); pg8::stage_rc(t_ * 16 + 8192, R[1], C[1]); }
#pragma unroll
        for (int h = 0; h < 2; ++h)
#pragma unroll
            for (int i = 0; i < 2; ++i) v[h][i] = (unsigned)((u.pm * 256 + h * 128 + R[i]) * K * esz + C[i] * 2);
    }
    __device__ __forceinline__ const char* bptr(const Unit& u) const { return (const char*)Bt + (size_t)u.pn * 256 * K * esz; }
};
__device__ __forceinline__ int seg_find(const LAS int* segpan, int pp) { return ((const LAS unsigned char*)segpan)[(LDS_SEGT - LDS_TAB) + pp]; }
struct SchedS1 {
    static constexpr bool TAB_AVOFF = true;
    const LAS int* segpan; const int* rinfo; const bf16_t* w1t; const bf16_t* sh1t; int P0, nUnits, G, c;
    __device__ __forceinline__ bool next(int i, Unit& u) const {
        int L = i * G + c; if (L >= nUnits || c < 0) return false;
        { const int qq = nUnits / 8, rr = nUnits % 8, xcd = L % 8, off = L / 8; L = (xcd < rr ? xcd * (qq + 1) : rr * (qq + 1) + (xcd - rr) * qq) + off; }
        const int pp = P0 + (L >> 1); u.pn = L & 1; u.pm = pp; const int s = seg_find(segpan, pp); u.aux = s; return true;
    }
    __device__ __forceinline__ void avoff(const Unit& u, unsigned (&v)[2][2]) const {
        int R[2], C[2]; { const int t_ = opaque_tid(); pg8::stage_rc(t_ * 16, R[0], C[0]); pg8::stage_rc(t_ * 16 + 8192, R[1], C[1]); }
#pragma unroll
        for (int h = 0; h < 2; ++h)
#pragma unroll
            for (int i = 0; i < 2; ++i) { const int info = rinfo[u.pm * 256 + h * 128 + R[i]]; const int tok = info < 0 ? 0 : (info >> 4); v[h][i] = (unsigned)(tok * D + 2 * C[i]); }
    }
    __device__ __forceinline__ void avoff_tab(unsigned (&v)[2][2], const LAS int* tab) const {
        int R[2], C[2]; { const int t_ = opaque_tid(); pg8::stage_rc(t_ * 16, R[0], C[0]); pg8::stage_rc(t_ * 16 + 8192, R[1], C[1]); }
#pragma unroll
        for (int h = 0; h < 2; ++h)
#pragma unroll
            for (int i = 0; i < 2; ++i) { const int info = tab[h * 128 + R[i]]; const int tok = info < 0 ? 0 : (info >> 4); v[h][i] = (unsigned)(tok * D + 2 * C[i]); }
    }
    __device__ __forceinline__ const char* bptr(const Unit& u) const {
        return u.aux < 64 ? (const char*)w1t + ((size_t)u.aux * 512 + u.pn * 256) * D : (const char*)sh1t + (size_t)u.pn * 256 * D;
    }
};
struct SchedS2 {
    static constexpr bool TAB_AVOFF = false;
    const LAS int* segpan; const bf16_t* w2t; const bf16_t* sh2t; int P0, nUnits, G, c, nR;
    __device__ __forceinline__ bool next(int i, Unit& u) const {
        int L = i * G + c; if (L >= nUnits || c < 0) return false;
        { const int qq = nUnits / 8, rr = nUnits % 8, qr = nR / 8, rq = nR % 8, xcd = L % 8, off = L / 8;
            const int t0 = xcd * qq + (xcd < rr ? xcd : rr), r0 = xcd * qr + (xcd < rq ? xcd : rq);
            const int cS = (qq + (xcd < rr ? 1 : 0)) - (qr + (xcd < rq ? 1 : 0));
            L = off < cS ? nR + (t0 - r0) + off : r0 + (off - cS); }
        const int pp = P0 + (L >> 2); u.pn = L & 3; u.pm = pp; const int s = seg_find(segpan, pp); u.aux = s; return true;
    }
    __device__ __forceinline__ void avoff(const Unit& u, unsigned (&v)[2][2]) const {
        int R[2], C[2]; { const int t_ = opaque_tid(); pg8::stage_rc(t_ * 16, R[0], C[0]); pg8::stage_rc(t_ * 16 + 8192, R[1], C[1]); }
#pragma unroll
        for (int h = 0; h < 2; ++h)
#pragma unroll
            for (int i = 0; i < 2; ++i) v[h][i] = (unsigned)((u.pm * 256 + h * 128 + R[i]) * 256 + C[i] * 2);
    }
    __device__ __forceinline__ const char* bptr(const Unit& u) const {
        return u.aux < 64 ? (const char*)w2t + ((size_t)u.aux * 1024 + u.pn * 256) * 256 : (const char*)sh2t + (size_t)u.pn * 256 * 256;
    }
};

struct EpiU {
    static constexpr bool AUX = true; static constexpr bool PERM = true;
    bf16_t* U; const float* hgrn_lb; const float* rs; const float* cs; int layer; LAS unsigned char* ldsb;
    __device__ __forceinline__ void stage_aux(LAS unsigned char* lds, const Unit& u, int par) const {
        const int tid_ = opaque_tid(), w_ = __builtin_amdgcn_readfirstlane(tid_ >> 6);
        if (w_ < 4) __builtin_amdgcn_global_load_lds((const unsigned*)(rs + u.pm * 256 + w_ * 64 + (tid_ & 63)), (LAS unsigned*)(lds + LDS_AUX + par * 2048 + w_ * 256), 4, 0, 0);
        else __builtin_amdgcn_global_load_lds((const unsigned*)(cs + u.pn * 256 + (w_ - 4) * 64 + (tid_ & 63)), (LAS unsigned*)(lds + LDS_AUX + par * 2048 + 1024 + (w_ - 4) * 256), 4, 0, 0);
    }
    __device__ __forceinline__ void operator()(const f32x4 (&acc)[2][2][4][2], const Unit& u, int wr, int wc, int ui, int) const {
        const int ln_ = opaque_tid() & 63, fr = ln_ & 15, fq = ln_ >> 4;
        const int row0 = u.pm * 256 + wr * 64 + fr, col0 = u.pn * 256 + wc * 32 + 8 * fq;
        const LAS float* tabr = (const LAS float*)(ldsb + LDS_AUX + (ui & 1) * 2048); const LAS float* tabc = tabr + 256;
        float rsv[8];
#pragma unroll
        for (int i = 0; i < 8; ++i) rsv[i] = tabr[wr * 64 + fr + (i >> 2) * 128 + (i & 3) * 16];
#pragma unroll
        for (int bj = 0; bj < 2; ++bj) { const int col = col0 + bj * 128;
            if (col < UC) {
                const int kind = (col >= C_HQ && col < C_HF) ? 1 : ((col >= C_HF && col < C_HI) ? 2 : 0);
                const f32x4 cs0 = *(const LAS f32x4*)(tabc + (col - u.pn * 256)), cs1 = *(const LAS f32x4*)(tabc + (col - u.pn * 256) + 4);
                float om[8];
#pragma unroll
                for (int j = 0; j < 8; ++j) om[j] = 1.f;
                if (kind == 2 && layer == 1) { const int ch = (col - C_HF) & 255;
#pragma unroll
                    for (int j = 0; j < 8; ++j) om[j] = 1.f - 1.f / (1.f + __expf(hgrn_lb[ch + j] - hgrn_lb[256 + ch + j])); }
#pragma unroll
                for (int ai = 0; ai < 2; ++ai)
#pragma unroll
                    for (int m = 0; m < 4; ++m) { bf16_t* rowp = U + (size_t)(row0 + ai * 128 + m * 16) * UC;
                        float v[8];
                        { const i32x4 q0 = __builtin_bit_cast(i32x4, acc[ai][bj][m][0]), q1 = __builtin_bit_cast(i32x4, acc[ai][bj][m][1]); const float rr = rsv[ai * 4 + m];
#pragma unroll
                            for (int j = 0; j < 4; ++j) { v[j] = (float)q0[j] * (rr * cs0[j]); v[4 + j] = (float)q1[j] * (rr * cs1[j]); } }
                        if (kind == 1) {
#pragma unroll
                            for (int j = 0; j < 8; ++j) v[j] = siluf_(v[j]); }
                        else if (kind == 2) {
#pragma unroll
                            for (int j = 0; j < 8; ++j) v[j] = om[j] * sigmoidf_(-v[j]); }
                        *(u32x4*)(rowp + col) = pack8(v); } } }
    }
};
struct EpiRes {
    static constexpr bool AUX = false; static constexpr bool PERM = true;
    const float* xin; const float* cin; bf16_t* HB; const float* mod;
    int layer;
    __device__ __forceinline__ void operator()(const f32x4 (&acc)[2][2][4][2], const Unit& u, int wr, int wc, int, int) const {
        const int ln_ = opaque_tid() & 63, fr = ln_ & 15, fq = ln_ >> 4;
        const int row0 = u.pm * 256 + wr * 64 + fr, col0 = u.pn * 256 + wc * 32 + 8 * fq;
        const int mi = (u.pm % 33 == 0) ? 8 : u.pm / 33;
        const float* gm = mod + (size_t)mi * 6144 + 2048;
#pragma unroll
        for (int bj = 0; bj < 2; ++bj) { const int col = col0 + bj * 128;
            const f32x4 g0 = *(const f32x4*)(gm + col), g1 = *(const f32x4*)(gm + col + 4);
#pragma unroll
            for (int ai = 0; ai < 2; ++ai) {
                f32x4 ra[4], rb[4];
                if (layer == 0) {
#pragma unroll
                    for (int m = 0; m < 4; ++m) { const int row = row0 + ai * 128 + m * 16; const int b_ = row / TPS, pos_ = row - b_ * TPS;
                        const float* xr = (pos_ < CTXL ? cin + ((size_t)b_ * CTXL + pos_) * D : xin + ((size_t)b_ * SEQ + (pos_ - CTXL)) * D) + col; ra[m] = *(const f32x4*)xr; rb[m] = *(const f32x4*)(xr + 4); } }
                else {
#pragma unroll
                    for (int m = 0; m < 4; ++m) { const int row = row0 + ai * 128 + m * 16; const u32x4 hv = *(const u32x4*)(HB + (size_t)row * D + col); float o[8]; unpack8(hv, o);
                        ra[m] = (f32x4){o[0], o[1], o[2], o[3]}; rb[m] = (f32x4){o[4], o[5], o[6], o[7]}; } }
#pragma unroll
                for (int m = 0; m < 4; ++m) { const int row = row0 + ai * 128 + m * 16;
                    float o[8];
                    const f32x4 v0 = acc[ai][bj][m][0], v1 = acc[ai][bj][m][1];
#pragma unroll
                    for (int j = 0; j < 4; ++j) { o[j] = ra[m][j] + g0[j] * v0[j]; o[4 + j] = rb[m][j] + g1[j] * v1[j]; }
                    *(u32x4*)(HB + (size_t)row * D + col) = pack8(o); } } }
    }
};
struct EpiRouter {
    static constexpr bool AUX = false; static constexpr bool PERM = false;
    float* SC;
    __device__ __forceinline__ void operator()(const f32x4 (&acc)[2][2][4][2], const Unit& u, int wr, int wc, int, int) const {
        const int ln_ = opaque_tid() & 63, fr = ln_ & 15, fq = ln_ >> 4;
        if (wc >= 2) return;
        const int row0 = u.pm * 256 + wr * 64 + fr, col0 = wc * 32 + 4 * fq;
#pragma unroll
        for (int ai = 0; ai < 2; ++ai)
#pragma unroll
            for (int m = 0; m < 4; ++m)
#pragma unroll
                for (int n = 0; n < 2; ++n) { const f32x4 v = acc[ai][0][m][n]; f32x4 o;
#pragma unroll
                    for (int j = 0; j < 4; ++j) o[j] = sigmoidf_(v[j]);
                    *(f32x4*)(SC + (size_t)(row0 + ai * 128 + m * 16) * 64 + col0 + n * 16) = o; }
    }
};
struct EpiGLU {
    static constexpr bool AUX = true; static constexpr bool PERM = true;
    bf16_t* H; const float* rgate; const int* rinfo; LAS unsigned char* ldsb;
    __device__ __forceinline__ void stage_aux(LAS unsigned char* lds, const Unit& u, int par) const {
        const int tid_ = opaque_tid(), w_ = __builtin_amdgcn_readfirstlane(tid_ >> 6);
        if (w_ < 4) __builtin_amdgcn_global_load_lds((const unsigned*)(rinfo + u.pm * 256 + w_ * 64 + (tid_ & 63)), (LAS unsigned*)(lds + LDS_AUX + par * 2048 + w_ * 256), 4, 0, 0);
        else __builtin_amdgcn_global_load_lds((const unsigned*)(rgate + u.pm * 256 + (w_ - 4) * 64 + (tid_ & 63)), (LAS unsigned*)(lds + LDS_AUX + par * 2048 + 1024 + (w_ - 4) * 256), 4, 0, 0);
    }
    __device__ __forceinline__ void operator()(const f32x4 (&acc)[2][2][4][2], const Unit& u, int wr, int wc, int ui, int) const {
        const int ln_ = opaque_tid() & 63, fr = ln_ & 15, fq = ln_ >> 4;
        const int row0 = u.pm * 256 + wr * 64 + fr, col0 = u.pn * 128 + wc * 32 + 8 * fq;
        const LAS float* tab = (const LAS float*)(ldsb + LDS_AUX + (ui & 1) * 2048 + 1024);
        float rg[8];
#pragma unroll
        for (int i = 0; i < 8; ++i) rg[i] = tab[wr * 64 + fr + (i >> 2) * 128 + (i & 3) * 16];
        float rgs[8];
#pragma unroll
        for (int i = 0; i < 8; ++i) rgs[i] = rg[i] * (HACT_SCALE / (W8_SCALE * W8_SCALE));
#pragma unroll
        for (int ai = 0; ai < 2; ++ai)
#pragma unroll
            for (int m = 0; m < 4; ++m) { float o[8];
#pragma unroll
                for (int n = 0; n < 2; ++n)
#pragma unroll
                    for (int j = 0; j < 4; ++j) { const float g = acc[ai][0][m][n][j], up = acc[ai][1][m][n][j];
                        o[n * 4 + j] = (rgs[ai * 4 + m] * g) * up * __builtin_amdgcn_rcpf(1.f + __builtin_amdgcn_exp2f(g * (-1.4426950408889634f / W8_SCALE))); }
                *(u32x2*)((unsigned char*)H + (size_t)(row0 + ai * 128 + m * 16) * 256 + col0) = pack8_fp8(o, 1.f); }
    }
};
struct EpiMoE {
    static constexpr int PERM = 2;
    static constexpr bool AUX = true;
    const int* rinfo; const float* mod; unsigned char* ws; LAS unsigned char* xs;
    __device__ __forceinline__ void stage_aux(LAS unsigned char* lds, const Unit& u, int par) const {
        const int tid_ = opaque_tid(), w_ = __builtin_amdgcn_readfirstlane(tid_ >> 6);
        if (w_ < 4) __builtin_amdgcn_global_load_lds((const unsigned*)(rinfo + u.pm * 256 + w_ * 64 + (tid_ & 63)), (LAS unsigned*)(lds + LDS_AUX + par * 2048 + w_ * 256), 4, 0, 0);
    }
    __device__ __forceinline__ void operator()(const f32x4 (&acc)[2][2][4][2], const Unit& u, int wr, int wc, int ui, int) const {
        const int tid_ = opaque_tid(), ln_ = tid_ & 63, fr = ln_ & 15, fq = ln_ >> 4;
        const LAS int* tab = (const LAS int*)(xs - LDS_XS + LDS_AUX + (ui & 1) * 2048);
        if (u.aux < 64) {
            LAS unsigned char* sx = xs + (tid_ >> 6) * XS_WAVE;
            const int tr = ln_ >> 2, tc = ln_ & 3;
            int inf[8];
#pragma unroll
            for (int i = 0; i < 8; ++i) inf[i] = tab[wr * 64 + tr + (i >> 2) * 128 + (i & 3) * 16];
#pragma unroll
            for (int ai = 0; ai < 2; ++ai)
#pragma unroll
                for (int m = 0; m < 4; ++m) { u32x4 w;
#pragma unroll
                    for (int bj = 0; bj < 2; ++bj)
#pragma unroll
                        for (int n = 0; n < 2; ++n) { const f32x4 v = acc[ai][bj][m][n];
                            w[bj * 2 + n] = pk4_fp8(v[0], v[1], v[2], v[3]); }
                    *(LAS u32x4*)(sx + fr * 80 + fq * 16) = w;
                    const u32x4 t = *(const LAS u32x4*)(sx + tr * 80 + tc * 16);
                    const int info = inf[ai * 4 + m];
                    if (info >= 0) { const unsigned tok = (unsigned)info >> 4, k = (unsigned)info & 15u;
                        const unsigned base = k == 0u ? (unsigned)(OFF_AB + SLOT_BYTES) : (k < 3u ? (unsigned)(OFF_Y2 - SLOT_BYTES) : (unsigned)(OFF_SLOTU - 3 * SLOT_BYTES));
                        *(u32x4*)(ws + (base + k * (unsigned)SLOT_BYTES + tok * (unsigned)D + (unsigned)(u.pn * 256 + wc * 64 + tc * 16))) = t; } }
        } else {
            const int col0 = u.pn * 256 + wc * 64 + 16 * fq;
            int inf[8];
#pragma unroll
            for (int i = 0; i < 8; ++i) inf[i] = tab[wr * 64 + fr + (i >> 2) * 128 + (i & 3) * 16];
            int bcur = -1; f32x4 gq[2][2];
#pragma unroll
            for (int bj = 0; bj < 2; ++bj) { gq[bj][0] = (f32x4){0.f, 0.f, 0.f, 0.f}; gq[bj][1] = (f32x4){0.f, 0.f, 0.f, 0.f}; }
#pragma unroll
            for (int ai = 0; ai < 2; ++ai) {
                u32x4 old[4][2];
#pragma unroll
                for (int m = 0; m < 4; ++m) { const int info = inf[ai * 4 + m];
                    old[m][0] = (u32x4){0u, 0u, 0u, 0u}; old[m][1] = (u32x4){0u, 0u, 0u, 0u};
                    if (info >= 0) { const int tok = info >> 4;
                        const bf16_t* src = (const bf16_t*)(ws + OFF_HB) + (size_t)tok * D + col0;
                        old[m][0] = *(const u32x4*)src; old[m][1] = *(const u32x4*)(src + 8); } }
#pragma unroll
                for (int m = 0; m < 4; ++m) { const int info = inf[ai * 4 + m];
                    if (info >= 0) { const int tok = info >> 4;
                        bf16_t* dst = (bf16_t*)(ws + OFF_HB) + (size_t)tok * D + col0;
                        const int bb = mod_idx(tok);
                        if (bb != bcur) { const float* gf = mod + (size_t)bb * 6144 + 5120 + col0;
#pragma unroll
                            for (int bj = 0; bj < 2; ++bj) { gq[bj][0] = *(const f32x4*)(gf + bj * 8); gq[bj][1] = *(const f32x4*)(gf + bj * 8 + 4); }
                            bcur = bb; }
#pragma unroll
                        for (int bj = 0; bj < 2; ++bj) { float o[8]; unpack8(old[m][bj], o);
                            const f32x4 v0 = acc[ai][bj][m][0], v1 = acc[ai][bj][m][1];
#pragma unroll
                            for (int j = 0; j < 4; ++j) { o[j] += gq[bj][0][j] * (v0[j] * (1.f / SLOT_SCALE)); o[4 + j] += gq[bj][1][j] * (v1[j] * (1.f / SLOT_SCALE)); }
                            *(u32x4*)(dst + bj * 8) = pack8(o); } } }
            }
            __builtin_amdgcn_s_waitcnt(0x0F70);
        }
    }
};

__device__ __forceinline__ void transpose_load(const float* src, int K, int N, int tile, float (&r)[8]) {
    const int t = opaque_tid();
    const int nTn = (N + 63) / 64, kb = tile / nTn, nb = tile - kb * nTn, k0 = kb * 64, n0 = nb * 64, n = t & 63;
#pragma unroll
    for (int q = 0; q < 8; ++q) r[q] = (n0 + n < N) ? src[(size_t)(k0 + q * 8 + (t >> 6)) * N + n0 + n] : 0.f;
}
__device__ __forceinline__ void transpose_store(LAS float* scr, int K, int N, bf16_t* dst, int mode, int tile, float fp8scale, const float* qs) {
    const int t = opaque_tid();
    const int nTn = (N + 63) / 64, kb = tile / nTn, nb = tile - kb * nTn, k0 = kb * 64, n0 = nb * 64;
    { const int n = t >> 3, kc = t & 7;
        if (n0 + n < N) { float f[8];
#pragma unroll
            for (int j = 0; j < 8; ++j) f[j] = scr[(kc * 8 + j) * 65 + n];
            const int gn = n0 + n; const int row = mode == 0 ? gn : ((gn >> 7) * 256 + (mode == 2 ? 128 : 0) + (gn & 127));
            if (qs) *(u32x2*)((unsigned char*)dst + (size_t)row * K + k0 + kc * 8) = pack8_i8(f, 1.f / qs[row]);
            else if (fp8scale > 0.f) *(u32x2*)((unsigned char*)dst + (size_t)row * K + k0 + kc * 8) = pack8_fp8(f, fp8scale);
            else *(u32x4*)(dst + (size_t)row * K + k0 + kc * 8) = pack8(f); } }
}
__device__ __forceinline__ void transpose_job(const float* src, int K, int N, bf16_t* dst, int mode, LAS float* scr, float fp8scale = 0.f, const float* qs = nullptr) {
    const int t = opaque_tid();
    const int nt = (K / 64) * ((N + 63) / 64), G = (int)gridDim.x;
    float cur[8], nxt[8];
    int tile = blockIdx.x;
    if (tile < nt) transpose_load(src, K, N, tile, cur);
    for (; tile < nt; tile += G) {
#pragma unroll
        for (int q = 0; q < 8; ++q) scr[(q * 8 + (t >> 6)) * 65 + (t & 63)] = cur[q];
        __syncthreads();
        if (tile + G < nt) transpose_load(src, K, N, tile + G, nxt);
        transpose_store(scr, K, N, dst, mode, tile, fp8scale, qs);
        __syncthreads();
#pragma unroll
        for (int q = 0; q < 8; ++q) cur[q] = nxt[q];
    }
}

__device__ __forceinline__ void phase_transposes(const P& p, LAS unsigned char* lds) {
    const int tix = opaque_tid();
    unsigned char* ws = p.ws;
    LAS float* scr = (LAS float*)lds;
    __syncthreads();
    for (int l = 0; l < 2; ++l) {
        transpose_job(p.w_in + (size_t)l * D * UC, D, UC, (bf16_t*)(ws + OFF_WINT + (size_t)l * NWIN * D), 0, scr, 0.f, (const float*)(ws + OFF_SCL) + SCL_WIN + l * 4096);
        transpose_job(p.w_out + (size_t)l * D * D, D, D, (bf16_t*)(ws + OFF_WOUTT) + (size_t)l * D * D, 0, scr);
        transpose_job(p.sh_gate + (size_t)l * D * 256, D, 256, (bf16_t*)(ws + OFF_SH1T + (size_t)l * 512 * D), 1, scr, W8_SCALE);
        transpose_job(p.sh_up + (size_t)l * D * 256, D, 256, (bf16_t*)(ws + OFF_SH1T + (size_t)l * 512 * D), 2, scr, W8_SCALE);
        transpose_job(p.sh_down + (size_t)l * 256 * D, 256, D, (bf16_t*)(ws + OFF_SH2T + (size_t)l * D * 256), 0, scr, W2_SCALE);
        transpose_job(p.router_w + (size_t)l * D * 64, D, 64, (bf16_t*)(ws + OFF_RT) + (size_t)l * 256 * D, 0, scr);
        { u32x4* z = (u32x4*)(ws + OFF_WINT + ((size_t)l * NWIN + UC) * D); const int n = (NWIN - UC) * D / 16;
            for (int i = blockIdx.x * NTHR + tix; i < n; i += gridDim.x * NTHR) z[i] = (u32x4){0u, 0u, 0u, 0u}; }
        { u32x4* z = (u32x4*)((bf16_t*)(ws + OFF_RT) + ((size_t)l * 256 + 64) * D); const int n = 192 * D / 8;
            for (int i = blockIdx.x * NTHR + tix; i < n; i += gridDim.x * NTHR) z[i] = (u32x4){0u, 0u, 0u, 0u}; }
    }
}
__device__ __forceinline__ void colscale_job(const float* src, int K, int N, float* cs, int Npad, LAS unsigned char* lds, int wg0) {
    const int tix = opaque_tid(), w = tix >> 6, lane = tix & 63;
    LAS float* red = (LAS float*)lds;
    for (int g = ((int)blockIdx.x - wg0 + (int)gridDim.x) % (int)gridDim.x; g < Npad / 64; g += gridDim.x) { const int n = g * 64 + lane; float m = 0.f;
        if (n < N) { const int k0 = w * (K / 8);
#pragma unroll 1
            for (int kk = k0; kk < k0 + K / 8; kk += 32) { float wv[32];
#pragma unroll
                for (int j = 0; j < 32; ++j) wv[j] = src[(size_t)(kk + j) * N + n];
#pragma unroll
                for (int j = 0; j < 32; ++j) m = fmaxf(m, fabsf(wv[j])); } }
        red[w * 64 + lane] = m;
        __syncthreads();
        if (w == 0) {
#pragma unroll
            for (int ww = 1; ww < 8; ++ww) m = fmaxf(m, red[ww * 64 + lane]);
            cs[n] = fmaxf(m, 1e-20f) * (1.f / 127.f); }
        __syncthreads(); }
}
__device__ __forceinline__ void phase_prologue(const P& p, LAS unsigned char* lds) {
    const int tix = opaque_tid();
    unsigned char* ws = p.ws;
    for (int l = 0; l < 2; ++l) colscale_job(p.w_in + (size_t)l * D * UC, D, UC, (float*)(ws + OFF_SCL) + SCL_WIN + l * 4096, 4096, lds, 192 - 64 * l);
    __syncthreads();
    LAS float* sc = (LAS float*)lds;
    LAS float* part = (LAS float*)(lds + 9 * 1024 * 4);
    __syncthreads();
    { float cv[18];
#pragma unroll
        for (int q = 0; q < 18; ++q) { const int i = tix + q * NTHR, s = i >> 10, k = i & 1023; cv[q] = s < 8 ? p.c[s * 1024 + k] : p.c_ctx[k]; }
#pragma unroll
        for (int q = 0; q < 18; ++q) sc[tix + q * NTHR] = siluf_(cv[q]); }
    __syncthreads();
    const int w = tix >> 6, lane = tix & 63;
    for (int item = blockIdx.x; item < 2 * 96; item += gridDim.x) {
        const int l = item / 96, cg = item - l * 96, col = cg * 64 + lane;
        const float* wm = p.w_mod + (size_t)l * D * 6144 + col;
        float a[9];
#pragma unroll
        for (int s = 0; s < 9; ++s) a[s] = 0.f;
#pragma unroll 1
        for (int k0 = w * 128; k0 < w * 128 + 128; k0 += 32) { float wv[32];
#pragma unroll
            for (int j = 0; j < 32; ++j) wv[j] = wm[(size_t)(k0 + j) * 6144];
#pragma unroll
            for (int j = 0; j < 32; ++j)
#pragma unroll
                for (int s = 0; s < 9; ++s) a[s] += sc[s * 1024 + k0 + j] * wv[j]; }
#pragma unroll
        for (int s = 0; s < 9; ++s) part[(w * 9 + s) * 64 + lane] = a[s];
        __syncthreads();
        for (int i = tix; i < 9 * 64; i += NTHR) { const int s = i >> 6, ln = i & 63; float v = p.b_mod[(size_t)l * 6144 + cg * 64 + ln];
#pragma unroll
            for (int ww = 0; ww < 8; ++ww) v += part[(ww * 9 + s) * 64 + ln];
            ((float*)(ws + OFF_MOD))[((size_t)l * 9 + s) * 6144 + cg * 64 + ln] = v; }
        __syncthreads();
    }
}

__device__ __forceinline__ void cvt_load_tile(const float* src, int N, int tile, int tix, float (&r)[8]) {
    const int nTn = N / 64, kb = tile / nTn, nb = tile - kb * nTn;
#pragma unroll
    for (int q = 0; q < 8; ++q) r[q] = src[(size_t)(kb * 64 + q * 8 + (tix >> 6)) * N + nb * 64 + (tix & 63)];
}
__device__ __forceinline__ void cvt_store_tile(const LAS float* scr, bf16_t* dst, int K, int N, int mode, int tile, int tix, float fp8scale) {
    const int nTn = N / 64, kb = tile / nTn, nb = tile - kb * nTn, n = tix >> 3, kc = tix & 7; float f[8];
#pragma unroll
    for (int j = 0; j < 8; ++j) f[j] = scr[(kc * 8 + j) * 65 + n];
    const int gn = nb * 64 + n; const int row = mode == 0 ? gn : ((gn >> 7) * 256 + (mode == 2 ? 128 : 0) + (gn & 127));
    if (fp8scale > 0.f) *(u32x2*)((unsigned char*)dst + (size_t)row * K + kb * 64 + kc * 8) = pack8_fp8(f, fp8scale);
    else *(u32x4*)(dst + (size_t)row * K + kb * 64 + kc * 8) = pack8(f);
}
__device__ __forceinline__ void phase_expert_cvt(const P& p, int l, LAS unsigned char* lds, int it0, int it1, int stride) {
    const int tix = opaque_tid();
    bf16_t* w1t = (bf16_t*)(p.ws + OFF_W1T); bf16_t* w2t = (bf16_t*)(p.ws + OFF_W2T);
    float cur[8], nxt[8];
#define CVT_LOAD(itv, regs) do { const int e_ = (itv) / 192, r_ = (itv) - e_ * 192, wh_ = r_ >> 6, tl_ = r_ & 63; const size_t eo_ = ((size_t)l * 64 + e_) * D * 256; \
        if (wh_ == 0) cvt_load_tile(p.exp_gate + eo_, 256, tl_, tix, regs); else if (wh_ == 1) cvt_load_tile(p.exp_up + eo_, 256, tl_, tix, regs); else cvt_load_tile(p.exp_down + eo_, D, tl_, tix, regs); } while (0)
    int it = it0, buf = 0;
    if (it < it1) CVT_LOAD(it, cur);
    for (; it < it1; it += stride) {
        LAS float* scr = (LAS float*)lds + buf * (64 * 65);
#pragma unroll
        for (int q = 0; q < 8; ++q) scr[(q * 8 + (tix >> 6)) * 65 + (tix & 63)] = cur[q];
        __syncthreads();
        if (it + stride < it1) CVT_LOAD(it + stride, nxt);
        { const int e = it / 192, r = it - e * 192, which = r >> 6, tile = r & 63;
            if (which == 0) cvt_store_tile(scr, (bf16_t*)((unsigned char*)w1t + (size_t)e * 512 * D), D, 256, 1, tile, tix, W8_SCALE);
            else if (which == 1) cvt_store_tile(scr, (bf16_t*)((unsigned char*)w1t + (size_t)e * 512 * D), D, 256, 2, tile, tix, W8_SCALE);
            else cvt_store_tile(scr, (bf16_t*)((unsigned char*)w2t + (size_t)e * D * 256), 256, D, 0, tile, tix, W2_SCALE); }
#pragma unroll
        for (int q = 0; q < 8; ++q) cur[q] = nxt[q];
        buf ^= 1;
    }
#undef CVT_LOAD
    __syncthreads();
}

template <int SRC, bool FINAL>
__device__ __forceinline__ void phase_norm(const P& p, int l, const float* normw, int sc_off, int sh_off, bool lat_only) {
    const int tix = opaque_tid();
    unsigned char* ws = p.ws;
    const int gw = blockIdx.x * 8 + (tix >> 6), lane = tix & 63;
#define CB(i) (SRC == 2 ? lane * 16 + (i) * 8 : (i) * 512 + lane * 8)
    const bf16_t* HB = (const bf16_t*)(ws + OFF_HB);
    const float* modg = (const float*)(ws + OFF_MOD) + (size_t)(FINAL ? l : l - 1) * 9 * 6144 + 5120;
    bf16_t* dst = (bf16_t*)(ws + OFF_AB);
    const float* mod = (const float*)(ws + OFF_MOD) + (size_t)l * 9 * 6144;
    float nw[16];
#pragma unroll
    for (int i = 0; i < 2; ++i)
#pragma unroll
        for (int j = 0; j < 8; ++j) nw[i * 8 + j] = normw[CB(i) + j];
    constexpr int NRAW = SRC == 0 ? 4 : (SRC == 1 ? 2 : 10);
    constexpr bool D3 = (SRC != 2);
    u32x4 cur[NRAW], nxt[NRAW], nx2[D3 ? NRAW : 1];
    auto valid = [&](int row) { return !((lat_only || FINAL) && (row % TPS) < CTXL); };
    auto load = [&](int row, u32x4 (&r)[NRAW]) {
        if (SRC == 0) { const float* xr = src_row_f32(p, row);
#pragma unroll
            for (int i = 0; i < 2; ++i) { r[2 * i] = *(const u32x4*)(xr + CB(i)); r[2 * i + 1] = *(const u32x4*)(xr + CB(i) + 4); } }
        else {
#pragma unroll
            for (int i = 0; i < 2; ++i) { const size_t o = (size_t)row * D + CB(i); r[i] = *(const u32x4*)(HB + o); }
            if (SRC == 2) {
#pragma unroll
                for (int k = 0; k < 8; ++k) r[2 + k] = __builtin_nontemporal_load((const u32x4*)(ws + slot_off(k) + (size_t)row * D + lane * 16)); } }
    };
    int mcur = -1; f32x4 msc[2][2], msh[2][2];
#pragma unroll
    for (int i = 0; i < 2; ++i)
#pragma unroll
        for (int h = 0; h < 2; ++h) { msc[i][h] = (f32x4){0.f, 0.f, 0.f, 0.f}; msh[i][h] = (f32x4){0.f, 0.f, 0.f, 0.f}; }
    int gcur = -1; f32x4 mgf[2][2];
#pragma unroll
    for (int i = 0; i < 2; ++i) { mgf[i][0] = (f32x4){0.f, 0.f, 0.f, 0.f}; mgf[i][1] = (f32x4){0.f, 0.f, 0.f, 0.f}; }
    const int end = gw * 33 + 33;
    int row = gw * 33;
    while (row < end && !valid(row)) ++row;
    if (row < end) load(row, cur);
    int nrow = row + 1;
    while (nrow < end && !valid(nrow)) ++nrow;
    if (nrow < end) load(nrow, nxt);
    while (row < end) {
        int n2row = nrow + 1;
        while (n2row < end && !valid(n2row)) ++n2row;
        if constexpr (D3) { if (n2row < end) load(n2row, nx2); }
        const int b = row / TPS, pos = row - b * TPS;
        float v[16];
        if (SRC == 0) {
#pragma unroll
            for (int i = 0; i < 2; ++i)
#pragma unroll
                for (int j = 0; j < 4; ++j) { v[i * 8 + j] = __uint_as_float(cur[2 * i][j]); v[i * 8 + 4 + j] = __uint_as_float(cur[2 * i + 1][j]); } }
        else {
            if (SRC == 2) { const int gi = pos < CTXL ? 8 : b;
                if (gi != gcur) { const float* grow = modg + (size_t)gi * 6144;
#pragma unroll
                    for (int i = 0; i < 2; ++i) { mgf[i][0] = *(const f32x4*)(grow + CB(i)) * (1.f / SLOT_SCALE); mgf[i][1] = *(const f32x4*)(grow + CB(i) + 4) * (1.f / SLOT_SCALE); }
                    gcur = gi; } }
#pragma unroll
            for (int i = 0; i < 2; ++i) { float f[8]; unpack8(cur[i], f);
                if (SRC == 2) { float sm[8];
#pragma unroll
                    for (int j = 0; j < 8; ++j) sm[j] = 0.f;
#pragma unroll
                    for (int k = 0; k < 8; ++k) { const int w0 = (int)cur[2 + k][2 * i], w1 = (int)cur[2 + k][2 * i + 1];
                        const f32x2_t q0 = __builtin_amdgcn_cvt_pk_f32_fp8(w0, false), q1 = __builtin_amdgcn_cvt_pk_f32_fp8(w0, true), q2 = __builtin_amdgcn_cvt_pk_f32_fp8(w1, false), q3 = __builtin_amdgcn_cvt_pk_f32_fp8(w1, true);
                        sm[0] += q0[0]; sm[1] += q0[1]; sm[2] += q1[0]; sm[3] += q1[1]; sm[4] += q2[0]; sm[5] += q2[1]; sm[6] += q3[0]; sm[7] += q3[1]; }
#pragma unroll
                    for (int j = 0; j < 4; ++j) { f[j] += mgf[i][0][j] * sm[j]; f[4 + j] += mgf[i][1][j] * sm[4 + j]; } }
#pragma unroll
                for (int j = 0; j < 8; ++j) v[i * 8 + j] = f[j]; }
            if (SRC == 2 && !FINAL) {
#pragma unroll
                for (int i = 0; i < 2; ++i) { float f[8];
#pragma unroll
                    for (int j = 0; j < 8; ++j) f[j] = v[i * 8 + j];
                    *(u32x4*)((bf16_t*)(ws + OFF_HB) + (size_t)row * D + CB(i)) = pack8(f); } } }
        float ss = 0.f;
#pragma unroll
        for (int j = 0; j < 16; ++j) ss += v[j] * v[j];
        ss = wave_sum(ss);
        const float rstd = rsqrtf(ss * (1.f / D) + EPS);
        if (FINAL) { float* o = p.out + ((size_t)b * SEQ + (pos - CTXL)) * D;
#pragma unroll
            for (int i = 0; i < 2; ++i) { f32x4 a, c;
#pragma unroll
                for (int j = 0; j < 4; ++j) { a[j] = v[i * 8 + j] * rstd * nw[i * 8 + j]; c[j] = v[i * 8 + 4 + j] * rstd * nw[i * 8 + 4 + j]; }
                *(f32x4*)(o + CB(i)) = a; *(f32x4*)(o + CB(i) + 4) = c; } }
        else { const int mi = pos < CTXL ? 8 : b;
            if (mi != mcur) { const float* mrow = mod + (size_t)mi * 6144;
#pragma unroll
                for (int i = 0; i < 2; ++i) { const int col = CB(i);
                    msc[i][0] = *(const f32x4*)(mrow + sc_off + col); msc[i][1] = *(const f32x4*)(mrow + sc_off + col + 4);
                    msh[i][0] = *(const f32x4*)(mrow + sh_off + col); msh[i][1] = *(const f32x4*)(mrow + sh_off + col + 4); }
                mcur = mi; }
            float fo[2][8]; float amax = 0.f;
#pragma unroll
            for (int i = 0; i < 2; ++i)
#pragma unroll
                for (int j = 0; j < 4; ++j) { fo[i][j] = v[i * 8 + j] * rstd * nw[i * 8 + j] * (1.f + msc[i][0][j]) + msh[i][0][j]; fo[i][4 + j] = v[i * 8 + 4 + j] * rstd * nw[i * 8 + 4 + j] * (1.f + msc[i][1][j]) + msh[i][1][j];
                    amax = fmaxf(amax, fmaxf(fabsf(fo[i][j]), fabsf(fo[i][4 + j]))); }
            if (SRC == 1) {
#pragma unroll
                for (int i = 0; i < 2; ++i) { const int col = CB(i); *(u32x4*)(dst + (size_t)row * D + col) = pack8(fo[i]); *(u32x2*)(ws + OFF_F8 + (size_t)row * D + col) = pack8_fp8(fo[i], 1.f); } }
            else {
                amax = fmaxf(wave_max(amax), 1e-20f); const float inv = 127.f / amax;
                if (lane == 0) ((float*)(ws + OFF_SCL))[SCL_RA + row] = amax * (1.f / 127.f);
#pragma unroll
                for (int i = 0; i < 2; ++i) *(u32x2*)(ws + OFF_AB + (size_t)row * D + CB(i)) = pack8_i8(fo[i], inv); } }
        if constexpr (D3) {
#pragma unroll
            for (int i = 0; i < NRAW; ++i) { cur[i] = nxt[i]; nxt[i] = nx2[i]; }
        } else {
#pragma unroll
            for (int i = 0; i < NRAW; ++i) cur[i] = nxt[i];
            if (n2row < end) load(n2row, nxt); }
        row = nrow; nrow = n2row;
    }
}
#undef CB

__device__ __forceinline__ void prep_run(const P& p, int l, bf16_t* U, int row0, int nblk, int g, int lane) {
    const int tix = opaque_tid();
    int colbase, kind;
    const float* cw = nullptr; const float* cb = nullptr; int cstride = 0, cc = 0;
    if (g < 8) { kind = 0; colbase = C_X + 128 * g; cc = 128 * g + 2 * lane; cw = p.ssd_conv_w + (size_t)l * 5 * 1024; cb = p.ssd_conv_b + (size_t)l * 1024; cstride = 1024; }
    else if (g < 14) { kind = 1; colbase = C_GQ + 128 * (g - 8); cc = 128 * (g - 8) + 2 * lane; cw = p.gdn_conv_w + (size_t)l * 5 * 768; cstride = 768; }
    else if (g < 16) { kind = 2; colbase = C_HQ + 128 * (g - 14); }
    else { kind = 3; colbase = C_HF + 128 * (g - 16); cc = (128 * (g - 16) + 2 * lane) & 255; }
    bf16_t* base = U + (size_t)row0 * UC + colbase + 2 * lane;
    if (kind >= 2) {
        float lo0 = 0.f, lo1 = 0.f;
        if (kind == 3 && l == 1) { const float a0 = p.hgrn_lb[cc], a1 = p.hgrn_lb[256 + cc], b0 = p.hgrn_lb[cc + 1], b1 = p.hgrn_lb[256 + cc + 1];
            lo0 = 1.f / (1.f + __expf(a0 - a1)); lo1 = 1.f / (1.f + __expf(b0 - b1)); }
        for (int blk = 0; blk < nblk; ++blk) { bf16_t* bb = base + (size_t)blk * 64 * UC; unsigned raw[64];
#pragma unroll
            for (int t = 0; t < 64; ++t) raw[t] = *(const unsigned*)(bb + (size_t)t * UC);
#pragma unroll
            for (int t = 0; t < 64; ++t) { float a = bflo(raw[t]), b = bfhi(raw[t]);
                if (kind == 2) { a = siluf_(a); b = siluf_(b); } else { a = (1.f - lo0) * sigmoidf_(-a); b = (1.f - lo1) * sigmoidf_(-b); }
                *(unsigned*)(bb + (size_t)t * UC) = pk2(a, b); } }
        return;
    }
    float w0[5], w1[5], bias0 = 0.f, bias1 = 0.f;
#pragma unroll
    for (int j = 0; j < 5; ++j) { w0[j] = cw[j * cstride + cc]; w1[j] = cw[j * cstride + cc + 1]; }
    if (kind == 0) { bias0 = cb[cc]; bias1 = cb[cc + 1]; }
    const bool l2 = (kind == 1) && (g < 12); const float l2s = (g < 10) ? 0.125f : 1.f;
    float pa0 = 0.f, pa1 = 0.f, pb0 = 0.f, pb1 = 0.f;
    for (int blk = 0; blk < nblk; ++blk) {
        float r0[68], r1[68];
        r0[0] = pa0; r1[0] = pa1; r0[1] = pb0; r1[1] = pb1;
        bf16_t* bb = base + (size_t)blk * 64 * UC;
#pragma unroll
        for (int t = 0; t < 64; ++t) { const unsigned v = *(const unsigned*)(bb + (size_t)t * UC); r0[2 + t] = bflo(v); r1[2 + t] = bfhi(v); }
        if (blk + 1 < nblk) {
#pragma unroll
            for (int t = 64; t < 66; ++t) { const unsigned v = *(const unsigned*)(bb + (size_t)t * UC); r0[2 + t] = bflo(v); r1[2 + t] = bfhi(v); } }
        else { r0[66] = r0[67] = r1[66] = r1[67] = 0.f; }
#pragma unroll
        for (int t = 0; t < 64; ++t) {
            float a = bias0, b = bias1;
#pragma unroll
            for (int j = 0; j < 5; ++j) { a += r0[t + j] * w0[j]; b += r1[t + j] * w1[j]; }
            a = siluf_(a); b = siluf_(b);
            if (l2) { float ss = a * a + b * b;
#pragma unroll
                for (int o = 1; o < 32; o <<= 1) ss += __shfl_xor(ss, o);
                const float f = rsqrtf(ss + 1e-6f) * l2s; a *= f; b *= f; }
            *(unsigned*)(bb + (size_t)t * UC) = pk2(a, b);
        }
        pa0 = r0[64]; pa1 = r1[64]; pb0 = r0[65]; pb1 = r1[65];
    }
}
__device__ __forceinline__ void phase_prep(const P& p, int l) {
    const int tix = opaque_tid();
    bf16_t* U = (bf16_t*)(p.ws + OFF_UB);
    const int gw = blockIdx.x * 8 + (tix >> 6), lane = tix & 63, NW = gridDim.x * 8;
    constexpr int NG = 14;
    constexpr int NCTX = NBATCH * NG, NLAT = NBATCH * 128 * NG;
    if (gw < NCTX) { const int b = gw / NG, g = gw - b * NG; prep_run(p, l, U, b * TPS, 4, g, lane); }
    const int nfree = NW - NCTX;
    for (int slot = 0; ; ++slot) {
        int j;
        if (slot < 4) { if (gw < NCTX) continue; j = slot * nfree + (gw - NCTX); }
        else j = 4 * nfree + (slot - 4) * NW + gw;
        if (j >= NLAT) break;
        const int g = j % NG, rr = j / NG, b = rr >> 7, gr = rr & 127; prep_run(p, l, U, b * TPS + CTXL + gr * 64, 1, g, lane);
    }
}

__device__ __forceinline__ int chain_row(int b, int dir, int i) { const int pos = dir == 0 ? i : (i < CTXL ? (CTXL - 1 - i) : (TPS + CTXL - 1 - i)); return b * TPS + pos; }
__device__ __forceinline__ bf16x8 ldfrag(const LAS unsigned char* base, int row, int stride, int k0) { return *(const LAS bf16x8*)(base + (size_t)(row * stride + k0) * 2); }
#define DPP_SHR_ADD(v, ctrl, rmask) (v) += __builtin_bit_cast(float, __builtin_amdgcn_update_dpp(0, __builtin_bit_cast(int, (v)), (ctrl), (rmask), 0xf, true))
__device__ __forceinline__ float row16_incl_scan(float v) {
    DPP_SHR_ADD(v, 0x111, 0xf); DPP_SHR_ADD(v, 0x112, 0xf); DPP_SHR_ADD(v, 0x114, 0xf); DPP_SHR_ADD(v, 0x118, 0xf);
    return v;
}
__device__ __forceinline__ float wave_incl_scan(float v) {
    v = row16_incl_scan(v);
    DPP_SHR_ADD(v, 0x142, 0xa);
    DPP_SHR_ADD(v, 0x143, 0xc);
    return v;
}
typedef short bf16x4 __attribute__((ext_vector_type(4)));
__device__ __forceinline__ bf16x4 ldfrag4(const LAS unsigned char* base, int row, int stride, int k0) { return *(const LAS bf16x4*)(base + (size_t)(row * stride + k0) * 2); }
__device__ __forceinline__ bf16x4 accfrag(const f32x4 a) { u32x2 o; o.x = pk2(a[0], a[1]); o.y = pk2(a[2], a[3]); return __builtin_bit_cast(bf16x4, o); }
#define MFMA16(a, b, c) __builtin_amdgcn_mfma_f32_16x16x16bf16_1k((a), (b), (c), 0, 0, 0)
__device__ __forceinline__ void scan_ssd_mma(const P& p, int l, int b, int hd, int dir, LAS unsigned char* lds) {
    const int tix = opaque_tid();
    const bf16_t* U = (const bf16_t*)(p.ws + OFF_UB); bf16_t* Y = (bf16_t*)(p.ws + (dir == 0 ? OFF_AB : OFF_Y2));
    const int w = __builtin_amdgcn_readfirstlane(tix >> 6), lane = tix & 63, l15 = lane & 15, lq = lane >> 4, g = hd >> 2;
    const float A = -__expf(p.ssd_a_log[(l * 2 + dir) * 8 + hd]), dtb = p.ssd_dt_bias[(l * 2 + dir) * 8 + hd], Dk = p.ssd_d[l * 8 + hd];
    constexpr int SC = 136, SX = 72;
    constexpr int SB = 44544;
    LAS unsigned char* BT = lds + 2 * SB;
    LAS unsigned char* XT = BT + 18432;
    LAS unsigned char* LS = XT + 9216;
    constexpr int NCH = TPS / 64;
    f32x4 Ht[8];
#pragma unroll
    for (int j = 0; j < 8; ++j) Ht[j] = (f32x4){0.f, 0.f, 0.f, 0.f};
    u32x4 preA[5], preB[5]; bf16_t pdtA = 0, pdtB = 0;
    auto issue = [&](int c, u32x4 (&pre)[5], bf16_t& pdt) {
#pragma unroll
        for (int j = 0; j < 5; ++j) { const int q = tix + NTHR * j, t = q / 40, pc = q - t * 40;
            const bf16_t* r = U + (size_t)chain_row(b, dir, c * 64 + t) * UC;
            const int col = pc < 8 ? (C_X + hd * 64 + pc * 8) : (pc < 24 ? (C_B + g * 128 + (pc - 8) * 8) : (C_C + g * 128 + (pc - 24) * 8));
            pre[j] = *(const u32x4*)(r + col); }
        if (w == 0) pdt = U[(size_t)chain_row(b, dir, c * 64 + lane) * UC + C_DT + dir * 8 + hd];
    };
    issue(0, preA, pdtA); issue(1, preB, pdtB);
    const int pt = w & 3, th = w >> 2;
    static_assert(NCH % 2 == 0, "chunk loop is unrolled by two");
    auto chunk = [&](int c, u32x4 (&pre)[5], bf16_t& pdt) {
        LAS unsigned char* CS = lds + (c & 1) * SB; LAS unsigned char* BS = CS + 17408; LAS unsigned char* XS = CS + 34816;
        LAS float* CUM = (LAS float*)(CS + 44032); LAS float* DTV = CUM + 64;
#pragma unroll
        for (int j = 0; j < 5; ++j) { const int q = tix + NTHR * j, t = q / 40, pc = q - t * 40;
            LAS unsigned char* dst = pc < 8 ? (XS + (size_t)(t * SX + pc * 8) * 2) : (pc < 24 ? (BS + (size_t)(t * SC + (pc - 8) * 8) * 2) : (CS + (size_t)(t * SC + (pc - 24) * 8) * 2));
            *(LAS u32x4*)dst = pre[j]; }
        if (w == 0) { const float dt = softplusf_(bf2f(pdt) + dtb); float a = dt * A;
            a = wave_incl_scan(a);
            CUM[lane] = a; DTV[lane] = dt; }
        __syncthreads();
        if (c + 2 < NCH) issue(c + 2, pre, pdt);
        const float cum63 = CUM[63];
        { const int s = tix & 63, pb = tix >> 6; float f[8]; unpack8(*(const LAS u32x4*)(XS + (size_t)(s * SX + pb * 8) * 2), f); const float dt = DTV[s];
#pragma unroll
            for (int j = 0; j < 8; ++j) *(LAS bf16_t*)(XT + (size_t)((pb * 8 + j) * SX + s) * 2) = f2bf(f[j] * dt);
            const float sc = __expf(cum63 - CUM[s]);
#pragma unroll
            for (int h2 = 0; h2 < 2; ++h2) { unpack8(*(const LAS u32x4*)(BS + (size_t)(s * SC + pb * 16 + h2 * 8) * 2), f);
#pragma unroll
                for (int j = 0; j < 8; ++j) *(LAS bf16_t*)(BT + (size_t)((pb * 16 + h2 * 8 + j) * SX + s) * 2) = f2bf(f[j] * sc); } }
        { const int tm = w >> 1;
            float ct[4];
#pragma unroll
            for (int r = 0; r < 4; ++r) ct[r] = CUM[tm * 16 + 4 * lq + r];
#pragma unroll
            for (int tt = 0; tt < 2; ++tt) { const int tn = 2 * (w & 1) + tt; f32x4 acc = (f32x4){0.f, 0.f, 0.f, 0.f};
#pragma unroll
                for (int kk = 0; kk < 4; ++kk) acc = __builtin_amdgcn_mfma_f32_16x16x32_bf16(ldfrag(CS, tm * 16 + l15, SC, kk * 32 + 8 * lq), ldfrag(BS, tn * 16 + l15, SC, kk * 32 + 8 * lq), acc, 0, 0, 0);
                const int s = tn * 16 + l15; const float cs = CUM[s];
#pragma unroll
                for (int r = 0; r < 4; ++r) { const int t = tm * 16 + 4 * lq + r; const float v = (s <= t) ? acc[r] * __expf(ct[r] - cs) : 0.f;
                    *(LAS bf16_t*)(LS + (size_t)(t * SX + s) * 2) = f2bf(v); } } }
        __syncthreads();
        { bf16x4 hb[8]; const int yrow0 = chain_row(b, dir, c * 64);
#pragma unroll
            for (int nt = 0; nt < 8; ++nt) hb[nt] = accfrag(Ht[nt]);
#pragma unroll
            for (int tt = 0; tt < 2; ++tt) { const int tm = 2 * th + tt; f32x4 acc = (f32x4){0.f, 0.f, 0.f, 0.f};
#pragma unroll
                for (int nt = 0; nt < 8; ++nt) acc = MFMA16(ldfrag4(CS, tm * 16 + l15, SC, nt * 16 + 4 * lq), hb[nt], acc);
#pragma unroll
                for (int r = 0; r < 4; ++r) acc[r] *= __expf(CUM[tm * 16 + 4 * lq + r]);
#pragma unroll
                for (int kk = 0; kk < 2; ++kk) acc = __builtin_amdgcn_mfma_f32_16x16x32_bf16(ldfrag(LS, tm * 16 + l15, SX, kk * 32 + 8 * lq), ldfrag(XT, pt * 16 + l15, SX, kk * 32 + 8 * lq), acc, 0, 0, 0);
                const int pcol = pt * 16 + l15;
#pragma unroll
                for (int r = 0; r < 4; ++r) { const int t = tm * 16 + 4 * lq + r; float y = acc[r];
                    if (dir == 0) y += Dk * bf2f(*(const LAS bf16_t*)(XS + (size_t)(t * SX + pcol) * 2));
                    Y[(size_t)(yrow0 + (dir == 0 ? t : -t)) * D + hd * 64 + pcol] = f2bf(y); } }
            const float dec = __expf(cum63);
            const bf16x8 xf0 = ldfrag(XT, pt * 16 + l15, SX, 8 * lq), xf1 = ldfrag(XT, pt * 16 + l15, SX, 32 + 8 * lq);
#pragma unroll
            for (int nt = 0; nt < 8; ++nt) { f32x4 acc = Ht[nt] * dec;
                acc = __builtin_amdgcn_mfma_f32_16x16x32_bf16(ldfrag(BT, nt * 16 + l15, SX, 8 * lq), xf0, acc, 0, 0, 0);
                acc = __builtin_amdgcn_mfma_f32_16x16x32_bf16(ldfrag(BT, nt * 16 + l15, SX, 32 + 8 * lq), xf1, acc, 0, 0, 0);
                Ht[nt] = acc; } }
    };
#pragma unroll 1
    for (int c = 0; c < NCH; c += 2) { chunk(c, preA, pdtA); chunk(c + 1, preB, pdtB); }
    __syncthreads();
}
__device__ __forceinline__ void scan_hgrn_mma(const P& p, int l, int b, int hd, int dir, LAS unsigned char* lds) {
    const int tix = opaque_tid();
    const bf16_t* U = (const bf16_t*)(p.ws + OFF_UB); bf16_t* Y = (bf16_t*)(p.ws + (dir == 0 ? OFF_AB : OFF_Y2));
    const int w = __builtin_amdgcn_readfirstlane(tix >> 6), lane = tix & 63, l15 = lane & 15, lq = lane >> 4;
    constexpr int SX = 72, SP = 40;
    LAS unsigned char* QS = lds;
    LAS unsigned char* KS = lds + 9216;
    LAS unsigned char* VS = lds + 18432;
    LAS unsigned char* KE = lds + 27648;
    LAS unsigned char* VT = lds + 48128;
    LAS unsigned char* ATT = lds + 68608;
    LAS float* ER = (LAS float*)(lds + 73728);
    LAS unsigned char* ST = lds + 74752;
    constexpr int NCH = TPS / 64;
    for (int i = tix; i < (74752 + 9216 - 27648) / 4; i += NTHR) ((LAS unsigned*)KE)[i] = 0u;
    f32x4 Sacc[4];
#pragma unroll
    for (int i = 0; i < 4; ++i) Sacc[i] = (f32x4){0.f, 0.f, 0.f, 0.f};
    u32x4 preA[3], preB[3];
    auto issue = [&](int c, u32x4 (&pre)[3]) {
#pragma unroll
        for (int j = 0; j < 3; ++j) { const int q = tix + NTHR * j, t = q / 24, pc = q - t * 24;
            const bf16_t* r = U + (size_t)chain_row(b, dir, c * 64 + t) * UC;
            const int col = pc < 8 ? (C_HQ + hd * 64 + pc * 8) : (pc < 16 ? (C_HF + dir * 256 + hd * 64 + (pc - 8) * 8) : (C_HI + hd * 64 + (pc - 16) * 8));
            pre[j] = *(const u32x4*)(r + col); }
    };
    issue(0, preA); issue(1, preB);
    static_assert(NCH % 2 == 0, "chunk loop is unrolled by two");
#pragma unroll 1
    for (int cc = 0; cc < NCH; cc += 2)
#pragma unroll
    for (int half = 0; half < 2; ++half) { const int c = cc + half; u32x4 (&pre)[3] = half ? preB : preA;
#pragma unroll
        for (int j = 0; j < 3; ++j) { const int q = tix + NTHR * j, t = q / 24, pc = q - t * 24;
            LAS unsigned char* dst = (pc < 8 ? QS : (pc < 16 ? KS : VS)) + (size_t)(t * SX + (pc & 7) * 8) * 2;
            *(LAS u32x4*)dst = pre[j]; }
        __syncthreads();
        if (c + 2 < NCH) issue(c + 2, pre);
        if (tix < 256) { const int k = tix & 63, j = tix >> 6; float r = 0.f, rr[16], kv[16], qv[16];
#pragma unroll
            for (int t = 0; t < 16; ++t) { kv[t] = bf2f(*(const LAS bf16_t*)(KS + (size_t)((16 * j + t) * SX + k) * 2)); qv[t] = bf2f(*(const LAS bf16_t*)(QS + (size_t)((16 * j + t) * SX + k) * 2)); }
#pragma unroll
            for (int t = 0; t < 16; ++t) { r += __logf(fmaxf(1.f - kv[t], 1e-30f)); rr[t] = r; }
#pragma unroll
            for (int t = 0; t < 16; ++t) { *(LAS bf16_t*)(QS + (size_t)((16 * j + t) * SX + k) * 2) = f2bf(qv[t] * __expf(rr[t])); *(LAS bf16_t*)(KS + (size_t)((16 * j + t) * SX + k) * 2) = f2bf(kv[t] * __expf(-fmaxf(rr[t], -80.f))); }
            ER[j * 64 + k] = __expf(r);
#pragma unroll
            for (int t = 0; t < 16; ++t) *(LAS bf16_t*)(KE + (size_t)((j * 64 + k) * SP + t) * 2) = f2bf(kv[t] * __expf(r - rr[t])); }
        else { const int v = (tix - 256) & 63, j = (tix - 256) >> 6; bf16_t tv[16];
#pragma unroll
            for (int t = 0; t < 16; ++t) tv[t] = *(const LAS bf16_t*)(VS + (size_t)((16 * j + t) * SX + v) * 2);
            u32x4 o0, o1; o0.x = tv[0] | ((unsigned)tv[1] << 16); o0.y = tv[2] | ((unsigned)tv[3] << 16); o0.z = tv[4] | ((unsigned)tv[5] << 16); o0.w = tv[6] | ((unsigned)tv[7] << 16);
            o1.x = tv[8] | ((unsigned)tv[9] << 16); o1.y = tv[10] | ((unsigned)tv[11] << 16); o1.z = tv[12] | ((unsigned)tv[13] << 16); o1.w = tv[14] | ((unsigned)tv[15] << 16);
            *(LAS u32x4*)(VT + (size_t)((j * 64 + v) * SP) * 2) = o0; *(LAS u32x4*)(VT + (size_t)((j * 64 + v) * SP + 8) * 2) = o1; }
        __syncthreads();
        if (w < 4) { const int j = w; f32x4 acc = (f32x4){0.f, 0.f, 0.f, 0.f};
#pragma unroll
            for (int kk = 0; kk < 2; ++kk) acc = __builtin_amdgcn_mfma_f32_16x16x32_bf16(ldfrag(QS, 16 * j + l15, SX, kk * 32 + 8 * lq), ldfrag(KS, 16 * j + l15, SX, kk * 32 + 8 * lq), acc, 0, 0, 0);
#pragma unroll
            for (int r = 0; r < 4; ++r) { const int t = 4 * lq + r; *(LAS bf16_t*)(ATT + (size_t)((j * 16 + t) * SP + l15) * 2) = f2bf(l15 <= t ? acc[r] : 0.f); } }
        __syncthreads();
        if (w < 4) { const int vt = w; const int yrow0 = chain_row(b, dir, c * 64), ysg = dir == 0 ? 1 : -1;
#pragma unroll
            for (int j = 0; j < 4; ++j) {
                bf16x4 sb[4];
#pragma unroll
                for (int kt = 0; kt < 4; ++kt) sb[kt] = accfrag(Sacc[kt]);
                const bf16x4 vfr = ldfrag4(VT, j * 64 + vt * 16 + l15, SP, 4 * lq);
                f32x4 o = (f32x4){0.f, 0.f, 0.f, 0.f};
#pragma unroll
                for (int kt = 0; kt < 4; ++kt) o = MFMA16(ldfrag4(QS, 16 * j + l15, SX, 16 * kt + 4 * lq), sb[kt], o);
                o = MFMA16(ldfrag4(ATT, j * 16 + l15, SP, 4 * lq), vfr, o);
#pragma unroll
                for (int r = 0; r < 4; ++r) Y[(size_t)(yrow0 + ysg * (16 * j + 4 * lq + r)) * D + 512 + hd * 64 + vt * 16 + l15] = f2bf(o[r]);
#pragma unroll
                for (int kt = 0; kt < 4; ++kt) { f32x4 acc = Sacc[kt];
#pragma unroll
                    for (int r = 0; r < 4; ++r) acc[r] *= ER[j * 64 + kt * 16 + 4 * lq + r];
                    Sacc[kt] = MFMA16(ldfrag4(KE, j * 64 + kt * 16 + l15, SP, 4 * lq), vfr, acc); }
            } }
        __syncthreads();
    }
}
__device__ __forceinline__ void scan_gdn_mma(const P& p, int l, int b, int hd, int dir, LAS unsigned char* lds) {
    const int tix = opaque_tid();
    const bf16_t* U = (const bf16_t*)(p.ws + OFF_UB); bf16_t* Y = (bf16_t*)(p.ws + (dir == 0 ? OFF_AB : OFF_Y2));
    const int w = __builtin_amdgcn_readfirstlane(tix >> 6), lane = tix & 63, l15 = lane & 15, lq = lane >> 4;
    const float Aa = __expf(p.gdn_a_log[(l * 2 + dir) * 4 + hd]), dtb = p.gdn_dt_bias[(l * 2 + dir) * 4 + hd];
    constexpr int SX = 72, SP = 40;
    LAS unsigned char* QS = lds;
    LAS unsigned char* KS = lds + 9216;
    LAS unsigned char* VS = lds + 18432;
    LAS unsigned char* QG = lds + 27648;
    LAS unsigned char* KE = lds + 36864;
    LAS float* AM = (LAS float*)(lds + 57344);
    LAS unsigned char* QKM = lds + 61952;
    LAS unsigned char* TM = lds + 67072;
    LAS unsigned char* RT = lds + 72192;
    LAS unsigned char* VNT = lds + 77312;
    LAS unsigned char* MT = lds + 82432;
    LAS float* GAM = (LAS float*)(lds + 100864); LAS float* BETA = (LAS float*)(lds + 101120); LAS float* EGAM = (LAS float*)(lds + 101376);
    constexpr int NCH = TPS / 64;
    for (int i = tix; i < (82432 + 9216 - 36864) / 4; i += NTHR) ((LAS unsigned*)KE)[i] = 0u;
    f32x4 Macc[4];
#pragma unroll
    for (int i = 0; i < 4; ++i) Macc[i] = (f32x4){0.f, 0.f, 0.f, 0.f};
    u32x4 preA[3], preB[3]; bf16_t paA = 0, pbA = 0, paB = 0, pbB = 0;
    auto issue = [&](int c, u32x4 (&pre)[3], bf16_t& pa, bf16_t& pb) {
#pragma unroll
        for (int j = 0; j < 3; ++j) { const int q = tix + NTHR * j, t = q / 24, pc = q - t * 24;
            const bf16_t* r = U + (size_t)chain_row(b, dir, c * 64 + t) * UC;
            const int col = pc < 8 ? (C_GQ + hd * 64 + pc * 8) : (pc < 16 ? (C_GK + hd * 64 + (pc - 8) * 8) : (C_GV + hd * 64 + (pc - 16) * 8));
            pre[j] = *(const u32x4*)(r + col); }
        if (w == 0) { const bf16_t* r = U + (size_t)chain_row(b, dir, c * 64 + lane) * UC; pa = r[C_GA + dir * 4 + hd]; pb = r[C_GB + dir * 4 + hd]; }
    };
    issue(0, preA, paA, pbA); issue(1, preB, paB, pbB);
    static_assert(NCH % 2 == 0, "chunk loop is unrolled by two");
#pragma unroll 1
    for (int cc = 0; cc < NCH; cc += 2)
#pragma unroll
    for (int half = 0; half < 2; ++half) { const int c = cc + half; u32x4 (&pre)[3] = half ? preB : preA; bf16_t& pa = half ? paB : paA; bf16_t& pb = half ? pbB : pbA;
        const int tix = opaque_tid(), lane = tix & 63, l15 = lane & 15, lq = lane >> 4;
#pragma unroll
        for (int j = 0; j < 3; ++j) { const int q = tix + NTHR * j, t = q / 24, pc = q - t * 24;
            LAS unsigned char* dst = (pc < 8 ? QS : (pc < 16 ? KS : VS)) + (size_t)(t * SX + (pc & 7) * 8) * 2;
            *(LAS u32x4*)dst = pre[j]; }
        if (w == 0) { float g = -Aa * softplusf_(bf2f(pa) + dtb); const float be = sigmoidf_(bf2f(pb));
            g = row16_incl_scan(g);
            GAM[lane] = g; BETA[lane] = be; EGAM[lane] = __expf(g); }
        __syncthreads();
        if (c + 2 < NCH) issue(c + 2, pre, pa, pb);
        { const int t = tix >> 3, kb = tix & 7; float f[8]; unpack8(*(const LAS u32x4*)(QS + (size_t)(t * SX + kb * 8) * 2), f); const float eg = EGAM[t];
#pragma unroll
            for (int i = 0; i < 8; ++i) f[i] *= eg;
            *(LAS u32x4*)(QG + (size_t)(t * SX + kb * 8) * 2) = pack8(f);
            unpack8(*(const LAS u32x4*)(KS + (size_t)(t * SX + kb * 8) * 2), f); const float ek = __expf(GAM[(t & 48) + 15] - GAM[t]);
#pragma unroll
            for (int i = 0; i < 8; ++i) *(LAS bf16_t*)(KE + (size_t)(((t >> 4) * 64 + kb * 8 + i) * SP + (t & 15)) * 2) = f2bf(f[i] * ek); }
        { const int j = w & 3, which = w >> 2;
            if (which == 0) {
                f32x4 kk = (f32x4){0.f, 0.f, 0.f, 0.f};
#pragma unroll
                for (int q = 0; q < 2; ++q) kk = __builtin_amdgcn_mfma_f32_16x16x32_bf16(ldfrag(KS, 16 * j + l15, SX, q * 32 + 8 * lq), ldfrag(KS, 16 * j + l15, SX, q * 32 + 8 * lq), kk, 0, 0, 0);
                const float gs = GAM[16 * j + l15], bs = BETA[16 * j + l15];
                f32x4 Q, QT, ST;
#pragma unroll
                for (int r = 0; r < 4; ++r) { const int t = 4 * lq + r; const float gt = GAM[16 * j + t], bt = BETA[16 * j + t];
                    Q[r] = (l15 < t) ? -bt * kk[r] * __expf(gt - gs) : 0.f;
                    QT[r] = (t < l15) ? -bs * kk[r] * __expf(gs - gt) : 0.f;
                    ST[r] = QT[r] + ((t == l15) ? 1.f : 0.f); }
#pragma unroll
                for (int lv = 0; lv < 3; ++lv) { const bf16x4 qa = accfrag(QT), qb = accfrag(Q);
                    const f32x4 Q2 = MFMA16(qa, qb, ((f32x4){0.f, 0.f, 0.f, 0.f}));
                    if (lv < 2) QT = MFMA16(qb, qa, ((f32x4){0.f, 0.f, 0.f, 0.f}));
                    Q = Q2;
                    ST = MFMA16(accfrag(Q), accfrag(ST), ST); }
                *(LAS bf16x4*)(TM + (size_t)(j * 64 + lane) * 8) = accfrag(ST);
            } else {
                f32x4 qk = (f32x4){0.f, 0.f, 0.f, 0.f};
#pragma unroll
                for (int q = 0; q < 2; ++q) qk = __builtin_amdgcn_mfma_f32_16x16x32_bf16(ldfrag(KS, 16 * j + l15, SX, q * 32 + 8 * lq), ldfrag(QS, 16 * j + l15, SX, q * 32 + 8 * lq), qk, 0, 0, 0);
                const float gt = GAM[16 * j + l15];
#pragma unroll
                for (int r = 0; r < 4; ++r) { const int s2 = 4 * lq + r; qk[r] = (s2 <= l15) ? qk[r] * __expf(gt - GAM[16 * j + s2]) : 0.f; }
                *(LAS bf16x4*)(QKM + (size_t)(j * 64 + lane) * 8) = accfrag(qk);
            } }
        __syncthreads();
        if (w < 4) { const int vt = w; const int yrow0 = chain_row(b, dir, c * 64), ysg = dir == 0 ? 1 : -1;
#pragma unroll
            for (int j = 0; j < 4; ++j) {
                bf16x4 mb[4];
#pragma unroll
                for (int kt = 0; kt < 4; ++kt) mb[kt] = accfrag(Macc[kt]);
                f32x4 km = (f32x4){0.f, 0.f, 0.f, 0.f}, o = (f32x4){0.f, 0.f, 0.f, 0.f};
#pragma unroll
                for (int kt = 0; kt < 4; ++kt) km = MFMA16(ldfrag4(KS, 16 * j + l15, SX, 16 * kt + 4 * lq), mb[kt], km);
#pragma unroll
                for (int kt = 0; kt < 4; ++kt) o = MFMA16(ldfrag4(QG, 16 * j + l15, SX, 16 * kt + 4 * lq), mb[kt], o);
                f32x4 rv;
#pragma unroll
                for (int r = 0; r < 4; ++r) { const int s2 = 16 * j + 4 * lq + r; const float vv = bf2f(*(const LAS bf16_t*)(VS + (size_t)(s2 * SX + vt * 16 + l15) * 2));
                    rv[r] = BETA[s2] * (vv - EGAM[s2] * km[r]); }
                const f32x4 vn = MFMA16(*(const LAS bf16x4*)(TM + (size_t)(j * 64 + lane) * 8), accfrag(rv), ((f32x4){0.f, 0.f, 0.f, 0.f}));
                const bf16x4 vb = accfrag(vn);
                o = MFMA16(*(const LAS bf16x4*)(QKM + (size_t)(j * 64 + lane) * 8), vb, o);
#pragma unroll
                for (int r = 0; r < 4; ++r) Y[(size_t)(yrow0 + ysg * (16 * j + 4 * lq + r)) * D + 768 + hd * 64 + vt * 16 + l15] = f2bf(o[r]);
                const float dec = EGAM[16 * j + 15];
#pragma unroll
                for (int kt = 0; kt < 4; ++kt) Macc[kt] = MFMA16(ldfrag4(KE, j * 64 + kt * 16 + l15, SP, 4 * lq), vb, Macc[kt] * dec);
            } }
        __syncthreads();
    }
}
constexpr int CVT_GRAB = 6;
static_assert((64 * 192) % CVT_GRAB == 0, "tile split");
__device__ __forceinline__ void phase_scan(const P& p, int l, LAS unsigned char* lds) {
    const int tix = opaque_tid();
    for (int ch = blockIdx.x; ch < 256; ch += gridDim.x) {
        const int x = ch & 7, m = ch >> 3; int dir, hd16, b;
        if (m < 16) { const int gidx = x + 8 * (m >> 3), r8 = m & 7; b = gidx >> 1; hd16 = (gidx & 1) * 4 + (r8 >> 1); dir = r8 & 1; }
        else { const int idx = x * 8 + (m & 7); b = idx >> 3; hd16 = (m < 24 ? 8 : 12) + ((idx >> 1) & 3); dir = idx & 1; }
        if (hd16 < 8) scan_ssd_mma(p, l, b, hd16, dir, lds);
        else if (hd16 < 12) scan_hgrn_mma(p, l, b, hd16 - 8, dir, lds);
        else scan_gdn_mma(p, l, b, hd16 - 12, dir, lds);
        __syncthreads();
        unsigned* qhead = (unsigned*)(p.ws + OFF_CVTQ) + 64 * l;
        for (;;) {
            if (tix == 0) *(LAS int*)(lds + LDS_TAB) = (int)__hip_atomic_fetch_add(qhead, (unsigned)CVT_GRAB, __ATOMIC_RELAXED, __HIP_MEMORY_SCOPE_AGENT);
            __syncthreads();
            const int t0 = *(const LAS int*)(lds + LDS_TAB);
            __syncthreads();
            if (t0 >= 64 * 192) break;
            phase_expert_cvt(p, l, lds, t0, t0 + CVT_GRAB, 1);
        }
    }
}

__device__ __forceinline__ void phase_post(const P& p, int l, bool lat_only) {
    const int tix = opaque_tid();
    const bf16_t* U = (const bf16_t*)(p.ws + OFF_UB); bf16_t* Y1 = (bf16_t*)(p.ws + OFF_AB); const bf16_t* Y2 = (const bf16_t*)(p.ws + OFF_Y2);
    const int gw = blockIdx.x * 8 + (tix >> 6), lane = tix & 63;
    const int col = 16 * lane;
    const int gc = lane < 32 ? col : (lane < 48 ? C_HG + (col - 512) : C_GG + (col - 768));
    float nw[16];
#pragma unroll
    for (int j = 0; j < 16; ++j) nw[j] = lane < 32 ? p.ssd_norm[l * 512 + col + j] : (lane < 48 ? p.hgrn_norm[l * 64 + ((col + j) & 63)] : p.gdn_norm[l * 64 + ((col + j) & 63)]);
    u32x4 cur[6], nxt[6], nx2[6];
    auto valid = [&](int row) { return !(lat_only && (row % TPS) < CTXL); };
    auto load = [&](int row, u32x4 (&r)[6]) {
#pragma unroll
        for (int i = 0; i < 2; ++i) { r[i] = *(const u32x4*)(Y1 + (size_t)row * D + col + i * 8); r[2 + i] = *(const u32x4*)(Y2 + (size_t)row * D + col + i * 8); r[4 + i] = *(const u32x4*)(U + (size_t)row * UC + gc + i * 8); }
    };
    const int end = gw * 33 + 33;
    int row = gw * 33;
    while (row < end && !valid(row)) ++row;
    if (row < end) load(row, cur);
    int nrow = row + 1;
    while (nrow < end && !valid(nrow)) ++nrow;
    if (nrow < end) load(nrow, nxt);
    while (row < end) {
        int n2row = nrow + 1;
        while (n2row < end && !valid(n2row)) ++n2row;
        if (n2row < end) load(n2row, nx2);
        float y[16], gt[16];
#pragma unroll
        for (int i = 0; i < 2; ++i) { float a[8], c[8], g8[8];
            unpack8(cur[i], a); unpack8(cur[2 + i], c); unpack8(cur[4 + i], g8);
#pragma unroll
            for (int j = 0; j < 8; ++j) { y[i * 8 + j] = a[j] + c[j]; gt[i * 8 + j] = siluf_(g8[j]); } }
        if (lane < 32) {
#pragma unroll
            for (int j = 0; j < 16; ++j) y[j] *= gt[j]; }
        float ss = 0.f;
#pragma unroll
        for (int j = 0; j < 16; ++j) ss += y[j] * y[j];
        ss += __shfl_xor(ss, 1); ss += __shfl_xor(ss, 2);
        float s16 = ss; s16 += __shfl_xor(s16, 4); s16 += __shfl_xor(s16, 8);
        const float rstd = lane < 32 ? rsqrtf(s16 * (1.f / 256.f) + EPS) : rsqrtf(ss * (1.f / 64.f) + EPS);
#pragma unroll
        for (int i = 0; i < 2; ++i) { float f[8];
#pragma unroll
            for (int j = 0; j < 8; ++j) { const float t = y[i * 8 + j] * rstd * nw[i * 8 + j]; f[j] = lane < 32 ? t : t * gt[i * 8 + j]; }
            *(u32x4*)(Y1 + (size_t)row * D + col + i * 8) = pack8(f); }
#pragma unroll
        for (int i = 0; i < 6; ++i) { cur[i] = nxt[i]; nxt[i] = nx2[i]; }
        row = nrow; nrow = n2row;
    }
}

__device__ __forceinline__ void phase_topk(const P& p, int l, bool lat_only, LAS unsigned char* lds) {
    const int tix = opaque_tid();
    unsigned char* ws = p.ws;
    LAS int* hist = (LAS int*)lds;
    for (int i = tix; i < 256; i += NTHR) hist[i] = 0;
    __syncthreads();
    const int t = tix;
    if (t < 264) {
        const int row = blockIdx.x * 264 + t;
        const bool active = !(lat_only && (row % TPS) < CTXL);
        if (active) {
            const float* sp = (const float*)(ws + OFF_SC) + (size_t)row * 64;
            float sc[64], sel[64];
#pragma unroll
            for (int i = 0; i < 16; ++i) { const f32x4 v = *(const f32x4*)(sp + 4 * i); sc[4 * i] = v[0]; sc[4 * i + 1] = v[1]; sc[4 * i + 2] = v[2]; sc[4 * i + 3] = v[3]; }
#pragma unroll
            for (int e = 0; e < 64; ++e) sel[e] = sc[e] + p.router_bias[l * 64 + e];
            int idx[8]; float gv[8]; float gs = 0.f;
#pragma unroll
            for (int r = 0; r < 8; ++r) { float best = -3.0e38f, bs = 0.f; int bi = 0;
#pragma unroll
                for (int e = 0; e < 64; ++e) { const bool gt = sel[e] > best; best = gt ? sel[e] : best; bs = gt ? sc[e] : bs; bi = gt ? e : bi; }
#pragma unroll
                for (int e = 0; e < 64; ++e) sel[e] = (e == bi) ? -3.0e38f : sel[e];
                idx[r] = bi; gv[r] = bs; gs += bs; }
            const float inv = 2.5f / gs;
            int* te = (int*)(ws + OFF_TOKE) + (size_t)row * 8; float* tg = (float*)(ws + OFF_TOKG) + (size_t)row * 8; int* tl = (int*)(ws + OFF_TOKLR) + (size_t)row * 12;
#pragma unroll
            for (int r = 0; r < 8; ++r) { const int s = idx[r]; const int lr = atomicAdd((int*)&hist[s], 1); te[r] = idx[r]; tg[r] = gv[r] * inv; tl[r] = lr; }
            tl[8] = atomicAdd((int*)&hist[64], 1);
        }
    }
    __syncthreads();
    for (int i = tix; i < 256; i += NTHR) ((int*)(ws + OFF_BCNT))[blockIdx.x * 256 + i] = (i < NSEG) ? hist[i] : 0;
}
__device__ __forceinline__ void phase_lists(const P& p, int l, bool lat_only, LAS unsigned char* lds) {
    const int tix = opaque_tid();
    unsigned char* ws = p.ws;
    LAS int* tot = (LAS int*)lds; LAS int* base = tot + 256; LAS int* segp = base + 256;
    const int* bc = (const int*)(ws + OFF_BCNT);
    const int t = tix;
    { LAS int* pa = (LAS int*)lds + 1024; LAS int* pb = pa + 512;
        const int sg = t & 127, part = t >> 7; int a = 0, bs = 0;
        if (sg < NSEG) {
#pragma unroll 16
            for (int k = 0; k < GRID / 4; ++k) { const int bb = part * (GRID / 4) + k; const int v = bc[bb * 256 + sg]; a += v; bs += bb < (int)blockIdx.x ? v : 0; } }
        pa[t] = a; pb[t] = bs;
        __syncthreads();
        if (t < 256) { const bool in = t < NSEG; tot[t] = in ? pa[t] + pa[128 + t] + pa[256 + t] + pa[384 + t] : 0; base[t] = in ? pb[t] + pb[128 + t] + pb[256 + t] + pb[384 + t] : 0; } }
    __syncthreads();
    if (t == 0) { int acc = 0; for (int s = 0; s < NSEG; ++s) { segp[s] = acc; acc += (tot[s] + 255) >> 8; } segp[NSEG] = acc; }
    __syncthreads();
    int* rinfo = (int*)(ws + OFF_RINFO); float* rgate = (float*)(ws + OFF_RGATE);
    if (t < 264) {
        const int row = blockIdx.x * 264 + t;
        const bool active = !(lat_only && (row % TPS) < CTXL);
        if (active) {
            const int* te = (const int*)(ws + OFF_TOKE) + (size_t)row * 8; const float* tg = (const float*)(ws + OFF_TOKG) + (size_t)row * 8; const int* tl = (const int*)(ws + OFF_TOKLR) + (size_t)row * 12;
#pragma unroll
            for (int r = 0; r < 8; ++r) { const int s = te[r]; const int slot = 256 * segp[s] + base[s] + tl[r]; rinfo[slot] = row * 16 + r; rgate[slot] = tg[r]; }
            const int slot = 256 * segp[64] + base[64] + tl[8]; rinfo[slot] = row * 16 + 8; rgate[slot] = 1.f;
        }
    }
    for (int s = blockIdx.x; s < NSEG; s += gridDim.x) { const int n = tot[s], e = ((n + 255) >> 8) << 8; for (int r = n + t; r < e; r += NTHR) { rinfo[256 * segp[s] + r] = -1; rgate[256 * segp[s] + r] = 0.f; } }
    if (blockIdx.x == 0 && t <= NSEG) ((int*)(ws + OFF_SEGP))[t] = segp[t];
}
__device__ __forceinline__ const LAS int* load_segp(const P& p, LAS unsigned char* lds, bool build) {
    const int tix = opaque_tid();
    LAS int* segp = (LAS int*)(lds + LDS_TAB);
    __syncthreads();
    if (tix <= NSEG) segp[tix] = ((const int*)(p.ws + OFF_SEGP))[tix];
    __syncthreads();
    if (build) { LAS unsigned char* segt = lds + LDS_SEGT; const int np = segp[NSEG];
        for (int pp = tix; pp < np; pp += NTHR) { int lo = 0, hi = NSEG; while (hi - lo > 1) { const int mid = (lo + hi) >> 1; if (segp[mid] <= pp) lo = mid; else hi = mid; } segt[pp] = (unsigned char)lo; } }
    __syncthreads();
    return segp;
}

enum { PH_PRO = 0, PH_NORM1, PH_WIN, PH_PREP, PH_SCAN, PH_POST, PH_WOUT, PH_NORM2, PH_ROUTER, PH_TOPK, PH_LISTS, PH_MOE, PH_FINAL };

__device__ __forceinline__ P launder_params(const P& p0) {
    P p;
    p.x = launder_ptr(p0.x); p.c = launder_ptr(p0.c); p.ctx = launder_ptr(p0.ctx); p.c_ctx = launder_ptr(p0.c_ctx); p.w_mod = launder_ptr(p0.w_mod); p.b_mod = launder_ptr(p0.b_mod);
    p.norm_mix = launder_ptr(p0.norm_mix); p.w_in = launder_ptr(p0.w_in); p.ssd_conv_w = launder_ptr(p0.ssd_conv_w); p.ssd_conv_b = launder_ptr(p0.ssd_conv_b);
    p.ssd_dt_bias = launder_ptr(p0.ssd_dt_bias); p.ssd_a_log = launder_ptr(p0.ssd_a_log); p.ssd_d = launder_ptr(p0.ssd_d); p.ssd_norm = launder_ptr(p0.ssd_norm);
    p.hgrn_lb = launder_ptr(p0.hgrn_lb); p.hgrn_norm = launder_ptr(p0.hgrn_norm); p.gdn_conv_w = launder_ptr(p0.gdn_conv_w); p.gdn_dt_bias = launder_ptr(p0.gdn_dt_bias);
    p.gdn_a_log = launder_ptr(p0.gdn_a_log); p.gdn_norm = launder_ptr(p0.gdn_norm); p.w_out = launder_ptr(p0.w_out); p.norm_ffn = launder_ptr(p0.norm_ffn);
    p.router_w = launder_ptr(p0.router_w); p.router_bias = launder_ptr(p0.router_bias); p.exp_gate = launder_ptr(p0.exp_gate); p.exp_up = launder_ptr(p0.exp_up);
    p.exp_down = launder_ptr(p0.exp_down); p.sh_gate = launder_ptr(p0.sh_gate); p.sh_up = launder_ptr(p0.sh_up); p.sh_down = launder_ptr(p0.sh_down);
    p.norm_final = launder_ptr(p0.norm_final); p.out = launder_ptr(p0.out); p.ws = launder_ptr(p0.ws);
    return p;
}
template <int PH>
__device__ __forceinline__ void run_phase(const P& p0, const int l0, LAS unsigned char* lds, const int step = 0) {
    const P p = launder_params(p0);
    int l = l0; asm volatile("" : "+s"(l));
    unsigned char* ws = p.ws;
    const float* mod = (const float*)(ws + OFF_MOD) + (size_t)l * 9 * 6144;
    const bool lat_only = (l == 1);
    if constexpr (PH == PH_PRO) phase_prologue(p, lds);
    if constexpr (PH == PH_NORM1) { if (l == 0) { phase_norm<0, false>(p, l, p.norm_mix + l * D, 1024, 0, false); phase_transposes(p, lds); } else phase_norm<2, false>(p, l, p.norm_mix + l * D, 1024, 0, false); }
    if constexpr (PH == PH_WIN) { SchedDense S{(const bf16_t*)(ws + OFF_WINT + (size_t)l * NWIN * D), D, NWIN / 256, NPAN * (NWIN / 256), (int)gridDim.x, (int)blockIdx.x, 0, 1};
        EpiU E{(bf16_t*)(ws + OFF_UB), p.hgrn_lb, (const float*)(ws + OFF_SCL) + SCL_RA, (const float*)(ws + OFF_SCL) + SCL_WIN + l * 4096, l, lds}; pg8::gemm_phase<EpiU, SchedDense, 2>(lds, ws + OFF_AB, D, S, E); }
    if constexpr (PH == PH_PREP) phase_prep(p, l);
    if constexpr (PH == PH_SCAN) phase_scan(p, l, lds);
    if constexpr (PH == PH_POST) phase_post(p, l, lat_only);
    if constexpr (PH == PH_WOUT) { SchedDense S{(const bf16_t*)(ws + OFF_WOUTT) + (size_t)l * D * D, D, 4, (lat_only ? 256 : NPAN) * 4, (int)gridDim.x, (int)blockIdx.x, lat_only ? 1 : 0, 2};
        EpiRes E{p.x, p.ctx, (bf16_t*)(ws + OFF_HB), mod, l}; pg8::gemm_phase(lds, (const bf16_t*)(ws + OFF_AB), D, S, E);
        }
    if constexpr (PH == PH_NORM2) phase_norm<1, false>(p, l, p.norm_ffn + l * D, 4096, 3072, lat_only);
    if constexpr (PH == PH_ROUTER) { SchedDense S{(const bf16_t*)(ws + OFF_RT) + (size_t)l * 256 * D, D, 1, (lat_only ? 256 : NPAN), (int)gridDim.x, (int)blockIdx.x, lat_only ? 1 : 0, 2};
        EpiRouter E{(float*)(ws + OFF_SC)}; pg8::gemm_phase(lds, (const bf16_t*)(ws + OFF_AB), D, S, E); }
    if constexpr (PH == PH_TOPK) phase_topk(p, l, lat_only, lds);
    if constexpr (PH == PH_LISTS) phase_lists(p, l, lat_only, lds);
    if constexpr (PH == PH_MOE) {
        const LAS int* segp = load_segp(p, lds, step == 0 || !MK_ONE_LAUNCH);
        const int G = (int)gridDim.x, bid = (int)blockIdx.x;
        if (step > 0) {
            SchedS2 S{segp, (const bf16_t*)(ws + OFF_W2T), (const bf16_t*)(ws + OFF_SH2T + (size_t)l * D * 256), 0, 4 * segp[NSEG], G, bid, 4 * segp[NSEG - 1]};
            EpiMoE E{(const int*)(ws + OFF_RINFO), mod, ws, lds + LDS_XS};
            pg8::gemm_phase<EpiMoE, SchedS2, 1>(lds, ws + OFF_HACT, 256, S, E); }
        else { SchedS1 S{segp, (const int*)(ws + OFF_RINFO), (const bf16_t*)(ws + OFF_W1T), (const bf16_t*)(ws + OFF_SH1T + (size_t)l * 512 * D), 0, 2 * segp[NSEG], G, bid};
            EpiGLU E{(bf16_t*)(ws + OFF_HACT), (const float*)(ws + OFF_RGATE), (const int*)(ws + OFF_RINFO), lds}; pg8::gemm_phase<EpiGLU, SchedS1, 1>(lds, ws + OFF_F8, D, S, E); }
    }
    if constexpr (PH == PH_FINAL) phase_norm<2, true>(p, l, p.norm_final, 0, 0, true);
}

template <int PH>
__global__ void __launch_bounds__(NTHR, 2) k_phase(P p, int l, int step) {
    extern __shared__ __attribute__((aligned(16))) unsigned char smem[];
    run_phase<PH>(p, l, (LAS unsigned char*)smem, step);
}

#if MK_ONE_LAUNCH
__global__ void __launch_bounds__(NTHR, 2) k_mega(P p) {
    extern __shared__ __attribute__((aligned(16))) unsigned char smem[];
    LAS unsigned char* lds = (LAS unsigned char*)smem;
    if (threadIdx.x < 4) ((LAS unsigned*)(lds + LDS_BARW))[threadIdx.x] = 0u;
    __syncthreads();
    XcdBarrier bar = xcd_barrier_post((unsigned*)(p.ws + OFF_BAR), (volatile LAS unsigned*)(lds + LDS_BARW));
    run_phase<PH_PRO>(p, 0, lds); xcd_barrier(bar);
    for (int l = 0; l < 2; ++l) {
        run_phase<PH_NORM1>(p, l, lds); xcd_barrier(bar);
        run_phase<PH_WIN>(p, l, lds); xcd_barrier(bar);
        run_phase<PH_PREP>(p, l, lds); xcd_barrier(bar);
        run_phase<PH_SCAN>(p, l, lds); xcd_barrier(bar);
        run_phase<PH_POST>(p, l, lds); xcd_barrier(bar);
        run_phase<PH_WOUT>(p, l, lds); xcd_barrier(bar);
        run_phase<PH_NORM2>(p, l, lds); xcd_barrier(bar);
        run_phase<PH_ROUTER>(p, l, lds); xcd_barrier(bar);
        run_phase<PH_TOPK>(p, l, lds); xcd_barrier(bar);
        run_phase<PH_LISTS>(p, l, lds); xcd_barrier(bar);
        for (int st = 0; st < 2; ++st) { run_phase<PH_MOE>(p, l, lds, st); xcd_barrier(bar); }
    }
    run_phase<PH_FINAL>(p, 1, lds);
}
#endif

template <int PH> static void launch_phase(const P& p, int l, hipStream_t stream, int step = 0) {
    static bool attr = false;
    if (!attr) { (void)hipFuncSetAttribute((const void*)k_phase<PH>, hipFuncAttributeMaxDynamicSharedMemorySize, LDS_BYTES); attr = true; }
    hipLaunchKernelGGL(k_phase<PH>, dim3(GRID), dim3(NTHR), LDS_BYTES, stream, p, l, step);
}

extern "C" void kernel_launch(void* const* d_in, const int* in_sizes, int n_in, void* d_out, int out_size, void* d_ws, size_t ws_size, hipStream_t stream) {
    if (n_in != 31 || ws_size < WS_END || out_size != NBATCH * SEQ * D) { fprintf(stderr, "kernel_launch: unexpected shapes: n_in %d ws %zu (need %zu) out %d\n", n_in, ws_size, (size_t)WS_END, out_size); return; }
    P p{};
    const float** f = (const float**)&p;
    for (int i = 0; i < 31; ++i) f[i] = (const float*)d_in[i];
    p.out = (float*)d_out; p.ws = (unsigned char*)d_ws;
#if MK_ONE_LAUNCH
    static bool attr = false;
    if (!attr) { (void)hipFuncSetAttribute((const void*)k_mega, hipFuncAttributeMaxDynamicSharedMemorySize, LDS_BYTES); attr = true; }
    (void)hipMemsetAsync(d_ws, 0, 16384, stream);
    hipLaunchKernelGGL(k_mega, dim3(GRID), dim3(NTHR), LDS_BYTES, stream, p);
#else
    launch_phase<PH_PRO>(p, 0, stream);
    for (int l = 0; l < 2; ++l) {
        launch_phase<PH_NORM1>(p, l, stream); launch_phase<PH_WIN>(p, l, stream); launch_phase<PH_PREP>(p, l, stream); launch_phase<PH_SCAN>(p, l, stream);
        launch_phase<PH_POST>(p, l, stream); launch_phase<PH_WOUT>(p, l, stream); launch_phase<PH_NORM2>(p, l, stream); launch_phase<PH_ROUTER>(p, l, stream);
        launch_phase<PH_TOPK>(p, l, stream); launch_phase<PH_LISTS>(p, l, stream);
        for (int st = 0; st < 2; ++st) launch_phase<PH_MOE>(p, l, stream, st);
    }
    launch_phase<PH_FINAL>(p, 1, stream);
#endif
}
```

```cpp
#include <hip/hip_runtime.h>
#include <stdint.h>
#include <stdio.h>

#ifndef MK_ONE_LAUNCH
#define MK_ONE_LAUNCH 1
#endif

#define LAS __attribute__((address_space(3)))
typedef unsigned short bf16_t;
typedef short bf16x8 __attribute__((ext_vector_type(8)));
typedef float f32x4 __attribute__((ext_vector_type(4)));
typedef unsigned u32x4 __attribute__((ext_vector_type(4)));
typedef unsigned u32x2 __attribute__((ext_vector_type(2)));

constexpr int D = 1024, NBATCH = 8, SEQ = 8192, CTXL = 256, TPS = SEQ + CTXL;
constexpr int NROW = NBATCH * TPS;
constexpr int NPAN = NROW / 256;
constexpr int UC = 3872;
constexpr int NWIN = 4096;
constexpr int GRID = 256, NTHR = 512;
constexpr float EPS = 1e-6f;
constexpr int C_Z = 0, C_X = 512, C_B = 1024, C_C = 1280, C_DT = 1536;
constexpr int C_HQ = 1552, C_HF = 1808, C_HI = 2320, C_HG = 2576;
constexpr int C_GQ = 2832, C_GK = 3088, C_GV = 3344, C_GA = 3600, C_GB = 3608, C_GG = 3616;
constexpr int NSEG = 65;
constexpr int MAXPROWS = 9 * NROW + NSEG * 256;
static_assert(MAXPROWS / 256 <= 4096, "panel table");

constexpr size_t al256(size_t x) { return (x + 255) & ~(size_t)255; }
constexpr size_t OFF_BAR = 0;
constexpr size_t OFF_CVTQ = 14336;
constexpr size_t OFF_MOD = 16384;
constexpr size_t OFF_WINT = al256(OFF_MOD + (size_t)2 * 9 * 6144 * 4);
constexpr size_t OFF_WOUTT = OFF_WINT + (size_t)2 * NWIN * D * 2;
constexpr size_t OFF_SH1T = OFF_WOUTT + (size_t)2 * D * D * 2;
constexpr size_t OFF_SH2T = OFF_SH1T + (size_t)2 * 512 * D * 2;
constexpr size_t OFF_RT = OFF_SH2T + (size_t)2 * D * 256 * 2;
constexpr size_t OFF_SCL = OFF_RT + (size_t)2 * 256 * D * 2;
constexpr size_t SCL_BYTES = (size_t)2 << 20;
constexpr size_t ACT_BYTES = (size_t)NROW * D * 2;
constexpr size_t OFF_HB = OFF_SCL + SCL_BYTES;
constexpr size_t OFF_AB = OFF_HB + ACT_BYTES;
constexpr size_t OFF_Y2 = OFF_AB + ACT_BYTES;
constexpr size_t OFF_UB = OFF_Y2 + ACT_BYTES;
constexpr size_t UB_BYTES = (size_t)NROW * UC * 2;
constexpr size_t OFF_XW = OFF_UB + UB_BYTES;
constexpr size_t OFF_W1T = OFF_XW;
constexpr size_t OFF_W2T = OFF_W1T + (size_t)64 * 512 * D * 2;
constexpr size_t WS_END = OFF_W2T + (size_t)64 * D * 256 * 2;
constexpr size_t OFF_F8 = OFF_Y2;
constexpr size_t OFF_SEGP = OFF_UB;
constexpr size_t OFF_RINFO = OFF_SEGP + 1024;
constexpr size_t OFF_RGATE = al256(OFF_RINFO + (size_t)MAXPROWS * 4);
constexpr size_t OFF_HACT = al256(OFF_RGATE + (size_t)MAXPROWS * 4);
constexpr size_t OFF_SLOTU = al256(OFF_HACT + (size_t)MAXPROWS * 256);
constexpr size_t SLOT_BYTES = (size_t)NROW * D;
static_assert(OFF_SLOTU + 5 * SLOT_BYTES <= OFF_XW, "MoE scratch overflow");
constexpr size_t OFF_SC = OFF_SLOTU;
constexpr size_t OFF_TOKE = OFF_SC + (size_t)NROW * 64 * 4;
constexpr size_t OFF_TOKG = OFF_TOKE + (size_t)NROW * 8 * 4;
constexpr size_t OFF_TOKLR = OFF_TOKG + (size_t)NROW * 8 * 4;
constexpr size_t OFF_BCNT = OFF_TOKLR + (size_t)NROW * 12 * 4;
static_assert(WS_END < ((size_t)1 << 32), "32-bit workspace offsets");
constexpr float SLOT_SCALE = 32.f;
constexpr float HACT_SCALE = 8.f, W2_SCALE = 4.f;
static_assert(HACT_SCALE * W2_SCALE == SLOT_SCALE, "slot scale");
__host__ __device__ constexpr size_t slot_off(int k) { return k == 0 ? OFF_AB + SLOT_BYTES : (k < 3 ? OFF_Y2 + (size_t)(k - 1) * SLOT_BYTES : OFF_SLOTU + (size_t)(k - 3) * SLOT_BYTES); }

constexpr int SCL_WIN = 0;
constexpr int SCL_WOUT = SCL_WIN + 2 * 4096;
constexpr int SCL_SH1 = SCL_WOUT + 2 * 1024;
constexpr int SCL_W1 = SCL_SH1 + 2 * 512;
constexpr int SCL_RA = SCL_W1 + 64 * 512;
constexpr int SCL_RF = SCL_RA + NROW;
constexpr int SCL_RY = SCL_RF + NROW;
static_assert((size_t)(SCL_RY + NROW) * 4 <= SCL_BYTES, "scale region overflow");
constexpr int LDS_STAGE = 131072;
constexpr int LDS_BARW = LDS_STAGE;
constexpr int LDS_TAB = LDS_STAGE + 1024;
constexpr int LDS_XS = LDS_STAGE + 2048;
constexpr int XS_WAVE = 2304;
constexpr int LDS_AUX = LDS_XS + 8 * XS_WAVE;
constexpr int LDS_SEGT = LDS_AUX + 4096;
constexpr int LDS_BYTES = LDS_SEGT + 4096;

struct P {
    const float *x, *c, *ctx, *c_ctx, *w_mod, *b_mod, *norm_mix, *w_in, *ssd_conv_w, *ssd_conv_b, *ssd_dt_bias, *ssd_a_log, *ssd_d, *ssd_norm,
        *hgrn_lb, *hgrn_norm, *gdn_conv_w, *gdn_dt_bias, *gdn_a_log, *gdn_norm, *w_out, *norm_ffn, *router_w, *router_bias, *exp_gate, *exp_up,
        *exp_down, *sh_gate, *sh_up, *sh_down, *norm_final;
    float* out;
    unsigned char* ws;
};

__device__ __forceinline__ float bf2f(bf16_t v) { return __uint_as_float((unsigned)v << 16); }
__device__ __forceinline__ float bflo(unsigned v) { return __uint_as_float(v << 16); }
__device__ __forceinline__ float bfhi(unsigned v) { return __uint_as_float(v & 0xffff0000u); }
typedef float f32x2_t __attribute__((ext_vector_type(2)));
typedef __bf16 bf16x2_t __attribute__((ext_vector_type(2)));
__device__ __forceinline__ unsigned pk2(float lo, float hi) { const f32x2_t v = {lo, hi}; const bf16x2_t b = __builtin_convertvector(v, bf16x2_t); return __builtin_bit_cast(unsigned, b); }
__device__ __forceinline__ unsigned pk4_fp8(float a, float b, float c, float d) { int w = 0; w = __builtin_amdgcn_cvt_pk_fp8_f32(a, b, w, false); w = __builtin_amdgcn_cvt_pk_fp8_f32(c, d, w, true); return (unsigned)w; }
__device__ __forceinline__ u32x2 pack8_fp8(const float (&f)[8], float sc) { u32x2 o; o.x = pk4_fp8(f[0] * sc, f[1] * sc, f[2] * sc, f[3] * sc); o.y = pk4_fp8(f[4] * sc, f[5] * sc, f[6] * sc, f[7] * sc); return o; }
__device__ __forceinline__ unsigned pk4_i8(float a, float b, float c, float d, float inv) {
    unsigned w = 0;
    w = __builtin_amdgcn_cvt_pk_u8_f32(__builtin_rintf(a * inv) + 128.f, 0, w); w = __builtin_amdgcn_cvt_pk_u8_f32(__builtin_rintf(b * inv) + 128.f, 1, w);
    w = __builtin_amdgcn_cvt_pk_u8_f32(__builtin_rintf(c * inv) + 128.f, 2, w); w = __builtin_amdgcn_cvt_pk_u8_f32(__builtin_rintf(d * inv) + 128.f, 3, w);
    return w ^ 0x80808080u; }
__device__ __forceinline__ u32x2 pack8_i8(const float (&f)[8], float inv) { u32x2 o; o.x = pk4_i8(f[0], f[1], f[2], f[3], inv); o.y = pk4_i8(f[4], f[5], f[6], f[7], inv); return o; }
__device__ __forceinline__ float wave_max(float v) {
#pragma unroll
    for (int o = 1; o < 64; o <<= 1) v = fmaxf(v, __shfl_xor(v, o));
    return v;
}
__device__ __forceinline__ bf16_t f2bf(float f) { return (bf16_t)(pk2(f, 0.f) & 0xffffu); }
__device__ __forceinline__ float sigmoidf_(float x) { return __builtin_amdgcn_rcpf(1.f + __expf(-x)); }
__device__ __forceinline__ float siluf_(float x) { return x * __builtin_amdgcn_rcpf(1.f + __expf(-x)); }
__device__ __forceinline__ float softplusf_(float x) { return fmaxf(x, 0.f) + log1pf(__expf(-fabsf(x))); }
__device__ __forceinline__ int opaque_tid() { int t = threadIdx.x; asm volatile("" : "+v"(t)); return t; }
__device__ __forceinline__ float wave_sum(float v) {
#pragma unroll
    for (int o = 1; o < 64; o <<= 1) v += __shfl_xor(v, o);
    return v;
}
__device__ __forceinline__ int row_b(int row) { return row / TPS; }
__device__ __forceinline__ int row_pos(int row) { return row % TPS; }
__device__ __forceinline__ int mod_idx(int row) { return (row % TPS) < CTXL ? 8 : row / TPS; }
__device__ __forceinline__ const float* src_row_f32(const P& p, int row) {
    const int b = row / TPS, pos = row - b * TPS;
    return pos < CTXL ? p.ctx + ((size_t)b * CTXL + pos) * D : p.x + ((size_t)b * SEQ + (pos - CTXL)) * D;
}
__device__ __forceinline__ void unpack8(const u32x4 v, float (&f)[8]) {
    f[0] = bflo(v.x); f[1] = bfhi(v.x); f[2] = bflo(v.y); f[3] = bfhi(v.y); f[4] = bflo(v.z); f[5] = bfhi(v.z); f[6] = bflo(v.w); f[7] = bfhi(v.w);
}
__device__ __forceinline__ u32x4 pack8(const float (&f)[8]) { u32x4 o; o.x = pk2(f[0], f[1]); o.y = pk2(f[2], f[3]); o.z = pk2(f[4], f[5]); o.w = pk2(f[6], f[7]); return o; }

#define GAS __attribute__((address_space(1)))
template <class T> __device__ __forceinline__ T* launder_ptr(T* ptr) { unsigned long long v = (unsigned long long)ptr; asm volatile("" : "+s"(v)); return (T*)(GAS T*)v; }
#define XB_TMO      128
#define XB_XCNT(j)  (256  + 64 * (j))
#define XB_XSUB(j)  (1280 + 64 * (j))
#define XB_XGEN(j)  (2304 + 64 * (j))
#define XB_TOP      3328
#define XB_TOPGEN   3392
#define XCD_BAR_WORDS 3456
#define XB_SPIN_CAP (1u << 18)
__device__ __forceinline__ unsigned xb_ld(unsigned* p)              { return __hip_atomic_load(p, __ATOMIC_RELAXED, __HIP_MEMORY_SCOPE_AGENT); }
__device__ __forceinline__ unsigned xb_add(unsigned* p, unsigned v) { return __hip_atomic_fetch_add(p, v, __ATOMIC_RELAXED, __HIP_MEMORY_SCOPE_AGENT); }
__device__ __forceinline__ unsigned xb_xcc_id() { return (unsigned)__builtin_amdgcn_s_getreg((3 << 11) | 20) & 0xFu; }
#define XB_SPIN(cond, bar) do { unsigned _sp = 0; while (cond) { __builtin_amdgcn_s_sleep(1); \
    if ((++_sp & 255u) == 0u) { if (xb_ld(&(bar)[XB_TMO])) break; if (_sp > XB_SPIN_CAP) { atomicAdd(&(bar)[XB_TMO], 1u); break; } } } } while (0)
struct XcdBarrier { unsigned* bar; unsigned x; volatile LAS unsigned* st; };
__device__ __forceinline__ XcdBarrier xcd_barrier_post(unsigned* bar, volatile LAS unsigned* st) {
    XcdBarrier b; b.bar = bar; b.x = xb_xcc_id(); b.st = st;
    if (threadIdx.x == 0) (void)xb_add(&bar[XB_XCNT(b.x)], 1u);
    return b;
}
__device__ __forceinline__ void xcd_barrier_complete(unsigned* bar, unsigned x, unsigned& nloc, unsigned& nx) {
    const unsigned G = gridDim.x * gridDim.y * gridDim.z;
    unsigned sum, cnt, mine, sp = 0u;
    for (;;) {
        sum = 0u; cnt = 0u; mine = 0u;
#pragma unroll
        for (unsigned j = 0; j < 16; ++j) { const unsigned c = xb_ld(&bar[XB_XCNT(j)]); sum += c; cnt += (c > 0u) ? 1u : 0u; mine = (j == x) ? c : mine; }
        if (sum == G) break;
        __builtin_amdgcn_s_sleep(1);
        if ((++sp & 255u) == 0u) { if (xb_ld(&bar[XB_TMO])) break; if (sp > XB_SPIN_CAP) { atomicAdd(&bar[XB_TMO], 1u); break; } }
    }
    nloc = mine > 0u ? mine : 1u; nx = cnt > 0u ? cnt : 1u;
}
__device__ __forceinline__ void xcd_barrier(const XcdBarrier& b) {
    asm volatile("s_waitcnt vmcnt(0)" ::: "memory");
    __syncthreads();
    if (threadIdx.x == 0) {
        unsigned* bar = launder_ptr(b.bar);
        __builtin_amdgcn_s_waitcnt(0);
        const unsigned bx = xb_xcc_id();
        unsigned nloc = b.st[0], nx = b.st[1];
        if (nloc == 0u) { xcd_barrier_complete(bar, bx, nloc, nx); b.st[0] = nloc; b.st[1] = nx; }
        const unsigned old = xb_add(&bar[XB_XSUB(bx)], 1u);
        const unsigned gen = old / nloc;
        if (old + 1u == (gen + 1u) * nloc) {
            __builtin_amdgcn_fence(__ATOMIC_RELEASE, "agent");
            asm volatile("s_waitcnt vmcnt(0)" ::: "memory");
            const unsigned og = xb_add(&bar[XB_TOP], 1u);
            const unsigned tg = og / nx;
            if (og + 1u == (tg + 1u) * nx) xb_add(&bar[XB_TOPGEN], 1u);
            else XB_SPIN(xb_ld(&bar[XB_TOPGEN]) == tg, bar);
            __builtin_amdgcn_fence(__ATOMIC_ACQUIRE, "agent");
            xb_add(&bar[XB_XGEN(bx)], 1u);
            asm volatile("s_waitcnt vmcnt(0)" ::: "memory");
        } else {
            XB_SPIN(xb_ld(&bar[XB_XGEN(bx)]) == gen, bar);
            __builtin_amdgcn_fence(__ATOMIC_ACQUIRE, "agent");
            asm volatile("s_waitcnt vmcnt(0)" ::: "memory");
        }
    }
    __syncthreads();
}

namespace pg8 {
constexpr int BM = 256, BK = 64, HALF = 128, HTB = HALF * BK * 2, STAGE_BYTES = 8 * HTB;
__device__ __forceinline__ int lds_byte(int r, int c) { const int st = (r >> 4) * 2 + (c >> 5), rr = r & 15, cc = c & 31, ob = rr * 64 + cc * 2; return st * 1024 + (ob ^ (((ob >> 9) & 1) << 5)); }
__device__ __forceinline__ void stage_rc(int b, int& R, int& C) { const int st = b / 1024, sb = b % 1024, swz = sb ^ (((sb >> 9) & 1) << 5); R = (st >> 1) * 16 + swz / 64; C = (st & 1) * 32 + (swz % 64) / 2; }
__device__ __forceinline__ int perm32(int rho) { const int n = rho >> 4, i = rho & 15; return 8 * (i >> 2) + 4 * n + (i & 3); }
constexpr bool GEMM_SP2 = true;
constexpr bool GEMM_ALIGN = true;
struct Unit { int pm, pn, aux; };
typedef int i32x8 __attribute__((ext_vector_type(8)));
typedef int i32x8a __attribute__((ext_vector_type(8), aligned(16)));
typedef int i32x4 __attribute__((ext_vector_type(4)));
__device__ __forceinline__ i32x8 cat8(const bf16x8 lo, const bf16x8 hi) { const i32x4 a = __builtin_bit_cast(i32x4, lo), b = __builtin_bit_cast(i32x4, hi); return (i32x8){a[0], a[1], a[2], a[3], b[0], b[1], b[2], b[3]}; }
constexpr float W8_SCALE = 16.f;

template <class Epi, class Sched, int MODE = 0, bool SP2 = GEMM_SP2, bool ALIGN_EPI = GEMM_ALIGN>
__device__ __forceinline__ void gemm_phase(LAS unsigned char* lds, const void* Abase, const int K, const Sched& S, const Epi& E) {
    const int tid = opaque_tid(), wid = __builtin_amdgcn_readfirstlane(tid >> 6), lane = tid & 63, wr = wid >> 2, wc = wid & 3, fr = lane & 15, fq = lane >> 4;
    constexpr bool FP8 = (MODE == 1); constexpr int ESZ = MODE ? 1 : 2;
    const int nt = K * ESZ / (BK * 2);
    constexpr int PM = (int)Epi::PERM;
    unsigned voffB[2], voffB1[2];
#pragma unroll
    for (int i = 0; i < 2; ++i) { int R, C; stage_rc(tid * 16 + i * 8192, R, C);
        if constexpr (PM == 2) { const int w_ = R >> 5, n_ = (R >> 4) & 1, i_ = R & 15, rb = 64 * w_ + 16 * (i_ >> 2) + 4 * n_ + (i_ & 3);
            voffB[i] = (unsigned)(rb * K * ESZ + C * 2); voffB1[i] = (unsigned)((rb + 8) * K * ESZ + C * 2); }
        else { const int Rb = PM ? ((R & ~31) + perm32(R & 31)) : R;
            voffB[i] = (unsigned)(Rb * K * ESZ + C * 2); voffB1[i] = 0u; } }
    const size_t kstep = (size_t)(BK * 2);
    const size_t hstep = PM == 2 ? (size_t)0 : (size_t)HALF * K * ESZ;
#define PG8_VB1 (PM == 2 ? voffB1 : voffB)
    const unsigned ldsw = (unsigned)wid * 1024u;
    const int aoff = lds_byte(wr * 64 + fr, fq * 8), boff = lds_byte(wc * 32 + fr, fq * 8);
#define PG8_SA(b, h) (((b) * 2 + (h)) * HTB)
#define PG8_SB(b, h) ((4 + (b) * 2 + (h)) * HTB)
#define PG8_STAGE(bufoff, gbase, voff) do { _Pragma("unroll") for (int _i = 0; _i < 2; ++_i) \
        __builtin_amdgcn_global_load_lds((const unsigned*)((const char*)(gbase) + (voff)[_i]), (LAS unsigned*)(lds + (bufoff) + ldsw + _i * 8192), 16, 0, 0); } while (0)
#define PG8_LDA(dst, b, h) do { _Pragma("unroll") for (int m = 0; m < 4; ++m) { \
        if constexpr (FP8) dst##8[m] = cat8(*(const LAS bf16x8*)(lds + PG8_SA(b, h) + aoff + m * 2048), *(const LAS bf16x8*)(lds + PG8_SA(b, h) + aoff + m * 2048 + 1024));   \
        else { _Pragma("unroll") for (int k = 0; k < 2; ++k) dst[m][k] = *(const LAS bf16x8*)(lds + PG8_SA(b, h) + aoff + m * 2048 + k * 1024); } } } while (0)
#define PG8_LDB(dst, b, h) do { _Pragma("unroll") for (int n = 0; n < 2; ++n) { \
        if constexpr (FP8) dst##8[n] = cat8(*(const LAS bf16x8*)(lds + PG8_SB(b, h) + boff + n * 2048), *(const LAS bf16x8*)(lds + PG8_SB(b, h) + boff + n * 2048 + 1024)); \
        else { _Pragma("unroll") for (int k = 0; k < 2; ++k) dst[n][k] = *(const LAS bf16x8*)(lds + PG8_SB(b, h) + boff + n * 2048 + k * 1024); } } } while (0)
#define PG8_MMA(ai, bj, At, Bt) do { __builtin_amdgcn_s_setprio(1); _Pragma("unroll") for (int m = 0; m < 4; ++m) _Pragma("unroll") for (int n = 0; n < 2; ++n) { \
        if constexpr (FP8) asm volatile("v_mfma_f32_16x16x128_f8f6f4 %0, %1, %2, %0" : "+v"(acc[ai][bj][m][n]) : "v"(Bt##8[n]), "v"(At##8[m]));   \
        else if constexpr (MODE == 2) { _Pragma("unroll") for (int k = 0; k < 2; ++k) acc[ai][bj][m][n] = __builtin_bit_cast(f32x4, __builtin_amdgcn_mfma_i32_16x16x64_i8(__builtin_bit_cast(i32x4, Bt[n][k]), __builtin_bit_cast(i32x4, At[m][k]), __builtin_bit_cast(i32x4, acc[ai][bj][m][n]), 0, 0, 0)); } \
        else { _Pragma("unroll") for (int k = 0; k < 2; ++k) acc[ai][bj][m][n] = __builtin_amdgcn_mfma_f32_16x16x32_bf16(Bt[n][k], At[m][k], acc[ai][bj][m][n], 0, 0, 0); } } \
        __builtin_amdgcn_s_setprio(0); } while (0)
#define PG8_WAIT_V(n) asm volatile("s_waitcnt vmcnt(" #n ")" ::: "memory")
#define PG8_WAIT_L(n) asm volatile("s_waitcnt lgkmcnt(" #n ")" ::: "memory")
#define PG8_BAR __builtin_amdgcn_s_barrier()
#define PG8_SCHED __builtin_amdgcn_sched_barrier(0)
    Unit cur, nxt; int ui = 0;
    if (!S.next(0, cur)) return;
    f32x4 acc[2][2][4][2];
#pragma unroll
    for (int a = 0; a < 2; ++a)
#pragma unroll
        for (int b = 0; b < 2; ++b)
#pragma unroll
            for (int m = 0; m < 4; ++m)
#pragma unroll
                for (int n = 0; n < 2; ++n) acc[a][b][m][n] = (f32x4){0.f, 0.f, 0.f, 0.f};
    bf16x8 At[4][2], B0[2][2], B1[2][2];
    i32x8 At8[4], B08[2], B18[2];
    unsigned cvA[2][2], nvA[2][2];
    S.avoff(cur, cvA);
    const char* gA = (const char*)Abase;
    const char* cB = S.bptr(cur);
    if constexpr (Epi::AUX) E.stage_aux(lds, cur, 0);
    if constexpr (SP2) {
        PG8_STAGE(PG8_SB(0, 0), cB, voffB); PG8_STAGE(PG8_SB(0, 1), cB + hstep, PG8_VB1); PG8_STAGE(PG8_SA(0, 0), gA, cvA[0]); PG8_STAGE(PG8_SA(0, 1), gA, cvA[1]);
        if (wr == 1) PG8_BAR;
        PG8_WAIT_V(2); PG8_BAR;
        PG8_STAGE(PG8_SB(1, 0), cB + kstep, voffB); PG8_STAGE(PG8_SA(1, 0), gA + kstep, cvA[0]); PG8_STAGE(PG8_SB(1, 1), cB + hstep + kstep, PG8_VB1);
        PG8_WAIT_V(6); PG8_BAR;
    } else {
    PG8_STAGE(PG8_SB(0, 0), cB, voffB); PG8_STAGE(PG8_SA(0, 0), gA, cvA[0]); PG8_STAGE(PG8_SB(0, 1), cB + hstep, PG8_VB1); PG8_STAGE(PG8_SA(0, 1), gA, cvA[1]);
    if (wr == 1) PG8_BAR;
    PG8_WAIT_V(4); PG8_BAR;
    PG8_STAGE(PG8_SB(1, 0), cB + kstep, voffB); PG8_STAGE(PG8_SA(1, 0), gA + kstep, cvA[0]); PG8_STAGE(PG8_SB(1, 1), cB + hstep + kstep, PG8_VB1);
    PG8_WAIT_V(6); PG8_BAR;
    }
    for (;;) {
        const bool has_next = S.next(ui + 1, nxt);
        const char* nB = has_next ? S.bptr(nxt) : cB;
        if (has_next && !Sched::TAB_AVOFF) S.avoff(nxt, nvA);
        else {
#pragma unroll
            for (int h = 0; h < 2; ++h)
#pragma unroll
                for (int i = 0; i < 2; ++i) nvA[h][i] = cvA[h][i];
        }
#pragma unroll 1
        for (int t = 0; t < nt; t += 2) {
            const bool last = (t == nt - 2);
            if constexpr (Sched::TAB_AVOFF) { if (last && has_next) S.avoff_tab(nvA, (const LAS int*)(lds + LDS_AUX + ((ui + 1) & 1) * 2048)); }
            const char* a1 = gA + (size_t)(t + 1) * kstep;
            const char* a2 = last ? gA : gA + (size_t)(t + 2) * kstep; const char* b2 = last ? nB : cB + (size_t)(t + 2) * kstep;
            const char* a3 = a2 + kstep; const char* b3 = b2 + kstep;
            unsigned v2[2][2];
#pragma unroll
            for (int h = 0; h < 2; ++h)
#pragma unroll
                for (int i = 0; i < 2; ++i) v2[h][i] = last ? nvA[h][i] : cvA[h][i];
            if constexpr (SP2) {
            PG8_LDB(B0, 0, 0); PG8_LDB(B1, 0, 1); PG8_SCHED; PG8_LDA(At, 0, 0); PG8_STAGE(PG8_SA(1, 1), a1, cvA[1]);
            PG8_WAIT_V(8); PG8_WAIT_L(0); PG8_BAR; PG8_MMA(0, 0, At, B0); PG8_MMA(0, 1, At, B1); PG8_BAR; PG8_SCHED;
            if constexpr (Epi::AUX) { if (t == 0) E.stage_aux(lds, has_next ? nxt : cur, (ui + 1) & 1); }
            PG8_LDA(At, 0, 1); PG8_STAGE(PG8_SB(0, 0), b2, voffB); PG8_STAGE(PG8_SB(0, 1), b2 + hstep, PG8_VB1); PG8_STAGE(PG8_SA(0, 0), a2, v2[0]);
            PG8_WAIT_V(8); PG8_WAIT_L(0); PG8_BAR; PG8_MMA(1, 0, At, B0); PG8_MMA(1, 1, At, B1); PG8_BAR; PG8_SCHED;
            PG8_LDB(B0, 1, 0); PG8_LDB(B1, 1, 1); PG8_SCHED; PG8_LDA(At, 1, 0); PG8_STAGE(PG8_SA(0, 1), a2, v2[1]);
            PG8_WAIT_V(8); PG8_WAIT_L(0); PG8_BAR; PG8_MMA(0, 0, At, B0); PG8_MMA(0, 1, At, B1); PG8_BAR; PG8_SCHED;
            PG8_LDA(At, 1, 1); PG8_STAGE(PG8_SB(1, 0), b3, voffB); PG8_STAGE(PG8_SB(1, 1), b3 + hstep, PG8_VB1); PG8_STAGE(PG8_SA(1, 0), a3, v2[0]);
            PG8_WAIT_V(8); PG8_WAIT_L(0); PG8_BAR; PG8_MMA(1, 0, At, B0); PG8_MMA(1, 1, At, B1); PG8_BAR; PG8_SCHED;
            } else {
            PG8_LDB(B0, 0, 0); PG8_SCHED; PG8_LDA(At, 0, 0); PG8_STAGE(PG8_SA(1, 1), a1, cvA[1]);
            PG8_WAIT_L(8); PG8_BAR; PG8_WAIT_L(0); PG8_MMA(0, 0, At, B0); PG8_BAR; PG8_SCHED;
            PG8_LDB(B1, 0, 1); PG8_STAGE(PG8_SB(0, 0), b2, voffB);
            PG8_BAR; PG8_WAIT_L(0); PG8_MMA(0, 1, At, B1); PG8_BAR;
            PG8_LDA(At, 0, 1); PG8_STAGE(PG8_SA(0, 0), a2, v2[0]);
            PG8_BAR; PG8_WAIT_L(0); PG8_MMA(1, 0, At, B0); PG8_BAR; PG8_SCHED;
            PG8_STAGE(PG8_SB(0, 1), b2 + hstep, PG8_VB1);
            PG8_WAIT_V(6); PG8_BAR; PG8_MMA(1, 1, At, B1); PG8_BAR;
            PG8_LDB(B0, 1, 0); PG8_SCHED; PG8_LDA(At, 1, 0); PG8_STAGE(PG8_SA(0, 1), a2, v2[1]);
            PG8_WAIT_L(8); PG8_BAR; PG8_WAIT_L(0); PG8_MMA(0, 0, At, B0); PG8_BAR; PG8_SCHED;
            PG8_LDB(B1, 1, 1); PG8_STAGE(PG8_SB(1, 0), b3, voffB);
            PG8_BAR; PG8_WAIT_L(0); PG8_MMA(0, 1, At, B1); PG8_BAR;
            PG8_LDA(At, 1, 1); PG8_STAGE(PG8_SA(1, 0), a3, v2[0]);
            PG8_BAR; PG8_WAIT_L(0); PG8_MMA(1, 0, At, B0); PG8_BAR; PG8_SCHED;
            PG8_STAGE(PG8_SB(1, 1), b3 + hstep, PG8_VB1);
            PG8_WAIT_V(6); PG8_BAR; PG8_MMA(1, 1, At, B1); PG8_BAR;
            }
        }
        if constexpr (ALIGN_EPI) { if (wr == 0) PG8_BAR; }
        if constexpr (FP8) asm volatile("s_nop 15\n\ts_nop 15" ::: "memory");
        E(acc, cur, wr, wc, ui, fq);
        if (!has_next) break;
#pragma unroll
        for (int a = 0; a < 2; ++a)
#pragma unroll
            for (int b = 0; b < 2; ++b)
#pragma unroll
                for (int m = 0; m < 4; ++m)
#pragma unroll
                    for (int n = 0; n < 2; ++n) acc[a][b][m][n] = (f32x4){0.f, 0.f, 0.f, 0.f};
        cur = nxt; cB = nB; ++ui;
#pragma unroll
        for (int h = 0; h < 2; ++h)
#pragma unroll
            for (int i = 0; i < 2; ++i) cvA[h][i] = nvA[h][i];
        if constexpr (ALIGN_EPI) { if (wr == 1) PG8_BAR; }
    }
    PG8_WAIT_V(0);
    if constexpr (!ALIGN_EPI) { if (wr == 0) PG8_BAR; }
    PG8_BAR;
#undef PG8_SA
#undef PG8_VB1
#undef PG8_SB
#undef PG8_STAGE
#undef PG8_LDA
#undef PG8_LDB
#undef PG8_MMA
#undef PG8_WAIT_V
#undef PG8_WAIT_L
#undef PG8_BAR
#undef PG8_SCHED
}
}
using pg8::Unit; using pg8::W8_SCALE; using pg8::i32x4;

struct SchedDense {
    static constexpr bool TAB_AVOFF = false;
    const bf16_t* Bt; int K, nN, nUnits, G, c, latOnly, esz;
    __device__ __forceinline__ bool next(int i, Unit& u) const {
        const int L = i * G + c; if (L >= nUnits) return false;
        int wgid = L; { const int qq = nUnits / 8, rr = nUnits % 8, xcd = wgid % 8, off = wgid / 8; wgid = (xcd < rr ? xcd * (qq + 1) : rr * (qq + 1) + (xcd - rr) * qq) + off; }
        const int nM = nUnits / nN, nig = 8 * nN, gid = wgid / nig, fm = gid * 8, gsz = (nM - fm) < 8 ? (nM - fm) : 8;
        const int q = fm + ((wgid % nig) % gsz); u.pn = (wgid % nig) / gsz;
        u.pm = latOnly ? (q >> 5) * 33 + 1 + (q & 31) : q; u.aux = 0; return true;
    }
    __device__ __forceinline__ void avoff(const Unit& u, unsigned (&v)[2][2]) const {
        int R[2], C[2]; { const int t_ = opaque_tid(); pg8::stage_rc(t_ * 16, R[0], C[0]); pg8::stage_rc(t_ * 16 + 8192, R[1], C[1]); }
#pragma unroll
        for (int h = 0; h < 2; ++h)
#pragma unroll
            for (int i = 0; i < 2; ++i) v[h][i] = (unsigned)((u.pm * 256 + h * 128 + R[i]) * K * esz + C[i] * 2);
    }
    __device__ __forceinline__ const char* bptr(const Unit& u) const { return (const char*)Bt + (size_t)u.pn * 256 * K * esz; }
};
__device__ __forceinline__ int seg_find(const LAS int* segpan, int pp) { return ((const LAS unsigned char*)segpan)[(LDS_SEGT - LDS_TAB) + pp]; }
struct SchedS1 {
    static constexpr bool TAB_AVOFF = true;
    const LAS int* segpan; const int* rinfo; const bf16_t* w1t; const bf16_t* sh1t; int P0, nUnits, G, c;
    __device__ __forceinline__ bool next(int i, Unit& u) const {
        int L = i * G + c; if (L >= nUnits || c < 0) return false;
        { const int qq = nUnits / 8, rr = nUnits % 8, xcd = L % 8, off = L / 8; L = (xcd < rr ? xcd * (qq + 1) : rr * (qq + 1) + (xcd - rr) * qq) + off; }
        const int pp = P0 + (L >> 1); u.pn = L & 1; u.pm = pp; const int s = seg_find(segpan, pp); u.aux = s; return true;
    }
    __device__ __forceinline__ void avoff(const Unit& u, unsigned (&v)[2][2]) const {
        int R[2], C[2]; { const int t_ = opaque_tid(); pg8::stage_rc(t_ * 16, R[0], C[0]); pg8::stage_rc(t_ * 16 + 8192, R[1], C[1]); }
#pragma unroll
        for (int h = 0; h < 2; ++h)
#pragma unroll
            for (int i = 0; i < 2; ++i) { const int info = rinfo[u.pm * 256 + h * 128 + R[i]]; const int tok = info < 0 ? 0 : (info >> 4); v[h][i] = (unsigned)(tok * D + 2 * C[i]); }
    }
    __device__ __forceinline__ void avoff_tab(unsigned (&v)[2][2], const LAS int* tab) const {
        int R[2], C[2]; { const int t_ = opaque_tid(); pg8::stage_rc(t_ * 16, R[0], C[0]); pg8::stage_rc(t_ * 16 + 8192, R[1], C[1]); }
#pragma unroll
        for (int h = 0; h < 2; ++h)
#pragma unroll
            for (int i = 0; i < 2; ++i) { const int info = tab[h * 128 + R[i]]; const int tok = info < 0 ? 0 : (info >> 4); v[h][i] = (unsigned)(tok * D + 2 * C[i]); }
    }
    __device__ __forceinline__ const char* bptr(const Unit& u) const {
        return u.aux < 64 ? (const char*)w1t + ((size_t)u.aux * 512 + u.pn * 256) * D : (const char*)sh1t + (size_t)u.pn * 256 * D;
    }
};
struct SchedS2 {
    static constexpr bool TAB_AVOFF = false;
    const LAS int* segpan; const bf16_t* w2t; const bf16_t* sh2t; int P0, nUnits, G, c, nR;
    __device__ __forceinline__ bool next(int i, Unit& u) const {
        int L = i * G + c; if (L >= nUnits || c < 0) return false;
        { const int qq = nUnits / 8, rr = nUnits % 8, qr = nR / 8, rq = nR % 8, xcd = L % 8, off = L / 8;
            const int t0 = xcd * qq + (xcd < rr ? xcd : rr), r0 = xcd * qr + (xcd < rq ? xcd : rq);
            const int cS = (qq + (xcd < rr ? 1 : 0)) - (qr + (xcd < rq ? 1 : 0));
            L = off < cS ? nR + (t0 - r0) + off : r0 + (off - cS); }
        const int pp = P0 + (L >> 2); u.pn = L & 3; u.pm = pp; const int s = seg_find(segpan, pp); u.aux = s; return true;
    }
    __device__ __forceinline__ void avoff(const Unit& u, unsigned (&v)[2][2]) const {
        int R[2], C[2]; { const int t_ = opaque_tid(); pg8::stage_rc(t_ * 16, R[0], C[0]); pg8::stage_rc(t_ * 16 + 8192, R[1], C[1]); }
#pragma unroll
        for (int h = 0; h < 2; ++h)
#pragma unroll
            for (int i = 0; i < 2; ++i) v[h][i] = (unsigned)((u.pm * 256 + h * 128 + R[i]) * 256 + C[i] * 2);
    }
    __device__ __forceinline__ const char* bptr(const Unit& u) const {
        return u.aux < 64 ? (const char*)w2t + ((size_t)u.aux * 1024 + u.pn * 256) * 256 : (const char*)sh2t + (size_t)u.pn * 256 * 256;
    }
};

struct EpiU {
    static constexpr bool AUX = true; static constexpr bool PERM = true;
    bf16_t* U; const float* hgrn_lb; const float* rs; const float* cs; int layer; LAS unsigned char* ldsb;
    __device__ __forceinline__ void stage_aux(LAS unsigned char* lds, const Unit& u, int par) const {
        const int tid_ = opaque_tid(), w_ = __builtin_amdgcn_readfirstlane(tid_ >> 6);
        if (w_ < 4) __builtin_amdgcn_global_load_lds((const unsigned*)(rs + u.pm * 256 + w_ * 64 + (tid_ & 63)), (LAS unsigned*)(lds + LDS_AUX + par * 2048 + w_ * 256), 4, 0, 0);
        else __builtin_amdgcn_global_load_lds((const unsigned*)(cs + u.pn * 256 + (w_ - 4) * 64 + (tid_ & 63)), (LAS unsigned*)(lds + LDS_AUX + par * 2048 + 1024 + (w_ - 4) * 256), 4, 0, 0);
    }
    __device__ __forceinline__ void operator()(const f32x4 (&acc)[2][2][4][2], const Unit& u, int wr, int wc, int ui, int) const {
        const int ln_ = opaque_tid() & 63, fr = ln_ & 15, fq = ln_ >> 4;
        const int row0 = u.pm * 256 + wr * 64 + fr, col0 = u.pn * 256 + wc * 32 + 8 * fq;
        const LAS float* tabr = (const LAS float*)(ldsb + LDS_AUX + (ui & 1) * 2048); const LAS float* tabc = tabr + 256;
        float rsv[8];
#pragma unroll
        for (int i = 0; i < 8; ++i) rsv[i] = tabr[wr * 64 + fr + (i >> 2) * 128 + (i & 3) * 16];
#pragma unroll
        for (int bj = 0; bj < 2; ++bj) { const int col = col0 + bj * 128;
            if (col < UC) {
                const int kind = (col >= C_HQ && col < C_HF) ? 1 : ((col >= C_HF && col < C_HI) ? 2 : 0);
                const f32x4 cs0 = *(const LAS f32x4*)(tabc + (col - u.pn * 256)), cs1 = *(const LAS f32x4*)(tabc + (col - u.pn * 256) + 4);
                float om[8];
#pragma unroll
                for (int j = 0; j < 8; ++j) om[j] = 1.f;
                if (kind == 2 && layer == 1) { const int ch = (col - C_HF) & 255;
#pragma unroll
                    for (int j = 0; j < 8; ++j) om[j] = 1.f - 1.f / (1.f + __expf(hgrn_lb[ch + j] - hgrn_lb[256 + ch + j])); }
#pragma unroll
                for (int ai = 0; ai < 2; ++ai)
#pragma unroll
                    for (int m = 0; m < 4; ++m) { bf16_t* rowp = U + (size_t)(row0 + ai * 128 + m * 16) * UC;
                        float v[8];
                        { const i32x4 q0 = __builtin_bit_cast(i32x4, acc[ai][bj][m][0]), q1 = __builtin_bit_cast(i32x4, acc[ai][bj][m][1]); const float rr = rsv[ai * 4 + m];
#pragma unroll
                            for (int j = 0; j < 4; ++j) { v[j] = (float)q0[j] * (rr * cs0[j]); v[4 + j] = (float)q1[j] * (rr * cs1[j]); } }
                        if (kind == 1) {
#pragma unroll
                            for (int j = 0; j < 8; ++j) v[j] = siluf_(v[j]); }
                        else if (kind == 2) {
#pragma unroll
                            for (int j = 0; j < 8; ++j) v[j] = om[j] * sigmoidf_(-v[j]); }
                        *(u32x4*)(rowp + col) = pack8(v); } } }
    }
};
struct EpiRes {
    static constexpr bool AUX = false; static constexpr bool PERM = true;
    const float* xin; const float* cin; bf16_t* HB; const float* mod;
    int layer;
    __device__ __forceinline__ void operator()(const f32x4 (&acc)[2][2][4][2], const Unit& u, int wr, int wc, int, int) const {
        const int ln_ = opaque_tid() & 63, fr = ln_ & 15, fq = ln_ >> 4;
        const int row0 = u.pm * 256 + wr * 64 + fr, col0 = u.pn * 256 + wc * 32 + 8 * fq;
        const int mi = (u.pm % 33 == 0) ? 8 : u.pm / 33;
        const float* gm = mod + (size_t)mi * 6144 + 2048;
#pragma unroll
        for (int bj = 0; bj < 2; ++bj) { const int col = col0 + bj * 128;
            const f32x4 g0 = *(const f32x4*)(gm + col), g1 = *(const f32x4*)(gm + col + 4);
#pragma unroll
            for (int ai = 0; ai < 2; ++ai) {
                f32x4 ra[4], rb[4];
                if (layer == 0) {
#pragma unroll
                    for (int m = 0; m < 4; ++m) { const int row = row0 + ai * 128 + m * 16; const int b_ = row / TPS, pos_ = row - b_ * TPS;
                        const float* xr = (pos_ < CTXL ? cin + ((size_t)b_ * CTXL + pos_) * D : xin + ((size_t)b_ * SEQ + (pos_ - CTXL)) * D) + col; ra[m] = *(const f32x4*)xr; rb[m] = *(const f32x4*)(xr + 4); } }
                else {
#pragma unroll
                    for (int m = 0; m < 4; ++m) { const int row = row0 + ai * 128 + m * 16; const u32x4 hv = *(const u32x4*)(HB + (size_t)row * D + col); float o[8]; unpack8(hv, o);
                        ra[m] = (f32x4){o[0], o[1], o[2], o[3]}; rb[m] = (f32x4){o[4], o[5], o[6], o[7]}; } }
#pragma unroll
                for (int m = 0; m < 4; ++m) { const int row = row0 + ai * 128 + m * 16;
                    float o[8];
                    const f32x4 v0 = acc[ai][bj][m][0], v1 = acc[ai][bj][m][1];
#pragma unroll
                    for (int j = 0; j < 4; ++j) { o[j] = ra[m][j] + g0[j] * v0[j]; o[4 + j] = rb[m][j] + g1[j] * v1[j]; }
                    *(u32x4*)(HB + (size_t)row * D + col) = pack8(o); } } }
    }
};
struct EpiRouter {
    static constexpr bool AUX = false; static constexpr bool PERM = false;
    float* SC;
    __device__ __forceinline__ void operator()(const f32x4 (&acc)[2][2][4][2], const Unit& u, int wr, int wc, int, int) const {
        const int ln_ = opaque_tid() & 63, fr = ln_ & 15, fq = ln_ >> 4;
        if (wc >= 2) return;
        const int row0 = u.pm * 256 + wr * 64 + fr, col0 = wc * 32 + 4 * fq;
#pragma unroll
        for (int ai = 0; ai < 2; ++ai)
#pragma unroll
            for (int m = 0; m < 4; ++m)
#pragma unroll
                for (int n = 0; n < 2; ++n) { const f32x4 v = acc[ai][0][m][n]; f32x4 o;
#pragma unroll
                    for (int j = 0; j < 4; ++j) o[j] = sigmoidf_(v[j]);
                    *(f32x4*)(SC + (size_t)(row0 + ai * 128 + m * 16) * 64 + col0 + n * 16) = o; }
    }
};
struct EpiGLU {
    static constexpr bool AUX = true; static constexpr bool PERM = true;
    bf16_t* H; const float* rgate; const int* rinfo; LAS unsigned char* ldsb;
    __device__ __forceinline__ void stage_aux(LAS unsigned char* lds, const Unit& u, int par) const {
        const int tid_ = opaque_tid(), w_ = __builtin_amdgcn_readfirstlane(tid_ >> 6);
        if (w_ < 4) __builtin_amdgcn_global_load_lds((const unsigned*)(rinfo + u.pm * 256 + w_ * 64 + (tid_ & 63)), (LAS unsigned*)(lds + LDS_AUX + par * 2048 + w_ * 256), 4, 0, 0);
        else __builtin_amdgcn_global_load_lds((const unsigned*)(rgate + u.pm * 256 + (w_ - 4) * 64 + (tid_ & 63)), (LAS unsigned*)(lds + LDS_AUX + par * 2048 + 1024 + (w_ - 4) * 256), 4, 0, 0);
    }
    __device__ __forceinline__ void operator()(const f32x4 (&acc)[2][2][4][2], const Unit& u, int wr, int wc, int ui, int) const {
        const int ln_ = opaque_tid() & 63, fr = ln_ & 15, fq = ln_ >> 4;
        const int row0 = u.pm * 256 + wr * 64 + fr, col0 = u.pn * 128 + wc * 32 + 8 * fq;
        const LAS float* tab = (const LAS float*)(ldsb + LDS_AUX + (ui & 1) * 2048 + 1024);
        float rg[8];
#pragma unroll
        for (int i = 0; i < 8; ++i) rg[i] = tab[wr * 64 + fr + (i >> 2) * 128 + (i & 3) * 16];
        float rgs[8];
#pragma unroll
        for (int i = 0; i < 8; ++i) rgs[i] = rg[i] * (HACT_SCALE / (W8_SCALE * W8_SCALE));
#pragma unroll
        for (int ai = 0; ai < 2; ++ai)
#pragma unroll
            for (int m = 0; m < 4; ++m) { float o[8];
#pragma unroll
                for (int n = 0; n < 2; ++n)
#pragma unroll
                    for (int j = 0; j < 4; ++j) { const float g = acc[ai][0][m][n][j], up = acc[ai][1][m][n][j];
                        o[n * 4 + j] = (rgs[ai * 4 + m] * g) * up * __builtin_amdgcn_rcpf(1.f + __builtin_amdgcn_exp2f(g * (-1.4426950408889634f / W8_SCALE))); }
                *(u32x2*)((unsigned char*)H + (size_t)(row0 + ai * 128 + m * 16) * 256 + col0) = pack8_fp8(o, 1.f); }
    }
};
struct EpiMoE {
    static constexpr int PERM = 2;
    static constexpr bool AUX = true;
    const int* rinfo; const float* mod; unsigned char* ws; LAS unsigned char* xs;
    __device__ __forceinline__ void stage_aux(LAS unsigned char* lds, const Unit& u, int par) const {
        const int tid_ = opaque_tid(), w_ = __builtin_amdgcn_readfirstlane(tid_ >> 6);
        if (w_ < 4) __builtin_amdgcn_global_load_lds((const unsigned*)(rinfo + u.pm * 256 + w_ * 64 + (tid_ & 63)), (LAS unsigned*)(lds + LDS_AUX + par * 2048 + w_ * 256), 4, 0, 0);
    }
    __device__ __forceinline__ void operator()(const f32x4 (&acc)[2][2][4][2], const Unit& u, int wr, int wc, int ui, int) const {
        const int tid_ = opaque_tid(), ln_ = tid_ & 63, fr = ln_ & 15, fq = ln_ >> 4;
        const LAS int* tab = (const LAS int*)(xs - LDS_XS + LDS_AUX + (ui & 1) * 2048);
        if (u.aux < 64) {
            LAS unsigned char* sx = xs + (tid_ >> 6) * XS_WAVE;
            const int tr = ln_ >> 2, tc = ln_ & 3;
            int inf[8];
#pragma unroll
            for (int i = 0; i < 8; ++i) inf[i] = tab[wr * 64 + tr + (i >> 2) * 128 + (i & 3) * 16];
#pragma unroll
            for (int ai = 0; ai < 2; ++ai)
#pragma unroll
                for (int m = 0; m < 4; ++m) { u32x4 w;
#pragma unroll
                    for (int bj = 0; bj < 2; ++bj)
#pragma unroll
                        for (int n = 0; n < 2; ++n) { const f32x4 v = acc[ai][bj][m][n];
                            w[bj * 2 + n] = pk4_fp8(v[0], v[1], v[2], v[3]); }
                    *(LAS u32x4*)(sx + fr * 80 + fq * 16) = w;
                    const u32x4 t = *(const LAS u32x4*)(sx + tr * 80 + tc * 16);
                    const int info = inf[ai * 4 + m];
                    if (info >= 0) { const unsigned tok = (unsigned)info >> 4, k = (unsigned)info & 15u;
                        const unsigned base = k == 0u ? (unsigned)(OFF_AB + SLOT_BYTES) : (k < 3u ? (unsigned)(OFF_Y2 - SLOT_BYTES) : (unsigned)(OFF_SLOTU - 3 * SLOT_BYTES));
                        *(u32x4*)(ws + (base + k * (unsigned)SLOT_BYTES + tok * (unsigned)D + (unsigned)(u.pn * 256 + wc * 64 + tc * 16))) = t; } }
        } else {
            const int col0 = u.pn * 256 + wc * 64 + 16 * fq;
            int inf[8];
#pragma unroll
            for (int i = 0; i < 8; ++i) inf[i] = tab[wr * 64 + fr + (i >> 2) * 128 + (i & 3) * 16];
            int bcur = -1; f32x4 gq[2][2];
#pragma unroll
            for (int bj = 0; bj < 2; ++bj) { gq[bj][0] = (f32x4){0.f, 0.f, 0.f, 0.f}; gq[bj][1] = (f32x4){0.f, 0.f, 0.f, 0.f}; }
#pragma unroll
            for (int ai = 0; ai < 2; ++ai) {
                u32x4 old[4][2];
#pragma unroll
                for (int m = 0; m < 4; ++m) { const int info = inf[ai * 4 + m];
                    old[m][0] = (u32x4){0u, 0u, 0u, 0u}; old[m][1] = (u32x4){0u, 0u, 0u, 0u};
                    if (info >= 0) { const int tok = info >> 4;
                        const bf16_t* src = (const bf16_t*)(ws + OFF_HB) + (size_t)tok * D + col0;
                        old[m][0] = *(const u32x4*)src; old[m][1] = *(const u32x4*)(src + 8); } }
#pragma unroll
                for (int m = 0; m < 4; ++m) { const int info = inf[ai * 4 + m];
                    if (info >= 0) { const int tok = info >> 4;
                        bf16_t* dst = (bf16_t*)(ws + OFF_HB) + (size_t)tok * D + col0;
                        const int bb = mod_idx(tok);
                        if (bb != bcur) { const float* gf = mod + (size_t)bb * 6144 + 5120 + col0;
#pragma unroll
                            for (int bj = 0; bj < 2; ++bj) { gq[bj][0] = *(const f32x4*)(gf + bj * 8); gq[bj][1] = *(const f32x4*)(gf + bj * 8 + 4); }
                            bcur = bb; }
#pragma unroll
                        for (int bj = 0; bj < 2; ++bj) { float o[8]; unpack8(old[m][bj], o);
                            const f32x4 v0 = acc[ai][bj][m][0], v1 = acc[ai][bj][m][1];
#pragma unroll
                            for (int j = 0; j < 4; ++j) { o[j] += gq[bj][0][j] * (v0[j] * (1.f / SLOT_SCALE)); o[4 + j] += gq[bj][1][j] * (v1[j] * (1.f / SLOT_SCALE)); }
                            *(u32x4*)(dst + bj * 8) = pack8(o); } } }
            }
            __builtin_amdgcn_s_waitcnt(0x0F70);
        }
    }
};

__device__ __forceinline__ void transpose_load(const float* src, int K, int N, int tile, float (&r)[8]) {
    const int t = opaque_tid();
    const int nTn = (N + 63) / 64, kb = tile / nTn, nb = tile - kb * nTn, k0 = kb * 64, n0 = nb * 64, n = t & 63;
#pragma unroll
    for (int q = 0; q < 8; ++q) r[q] = (n0 + n < N) ? src[(size_t)(k0 + q * 8 + (t >> 6)) * N + n0 + n] : 0.f;
}
__device__ __forceinline__ void transpose_store(LAS float* scr, int K, int N, bf16_t* dst, int mode, int tile, float fp8scale, const float* qs) {
    const int t = opaque_tid();
    const int nTn = (N + 63) / 64, kb = tile / nTn, nb = tile - kb * nTn, k0 = kb * 64, n0 = nb * 64;
    { const int n = t >> 3, kc = t & 7;
        if (n0 + n < N) { float f[8];
#pragma unroll
            for (int j = 0; j < 8; ++j) f[j] = scr[(kc * 8 + j) * 65 + n];
            const int gn = n0 + n; const int row = mode == 0 ? gn : ((gn >> 7) * 256 + (mode == 2 ? 128 : 0) + (gn & 127));
            if (qs) *(u32x2*)((unsigned char*)dst + (size_t)row * K + k0 + kc * 8) = pack8_i8(f, 1.f / qs[row]);
            else if (fp8scale > 0.f) *(u32x2*)((unsigned char*)dst + (size_t)row * K + k0 + kc * 8) = pack8_fp8(f, fp8scale);
            else *(u32x4*)(dst + (size_t)row * K + k0 + kc * 8) = pack8(f); } }
}
__device__ __forceinline__ void transpose_job(const float* src, int K, int N, bf16_t* dst, int mode, LAS float* scr, float fp8scale = 0.f, const float* qs = nullptr) {
    const int t = opaque_tid();
    const int nt = (K / 64) * ((N + 63) / 64), G = (int)gridDim.x;
    float cur[8], nxt[8];
    int tile = blockIdx.x;
    if (tile < nt) transpose_load(src, K, N, tile, cur);
    for (; tile < nt; tile += G) {
#pragma unroll
        for (int q = 0; q < 8; ++q) scr[(q * 8 + (t >> 6)) * 65 + (t & 63)] = cur[q];
        __syncthreads();
        if (tile + G < nt) transpose_load(src, K, N, tile + G, nxt);
        transpose_store(scr, K, N, dst, mode, tile, fp8scale, qs);
        __syncthreads();
#pragma unroll
        for (int q = 0; q < 8; ++q) cur[q] = nxt[q];
    }
}

__device__ __forceinline__ void phase_transposes(const P& p, LAS unsigned char* lds) {
    const int tix = opaque_tid();
    unsigned char* ws = p.ws;
    LAS float* scr = (LAS float*)lds;
    __syncthreads();
    for (int l = 0; l < 2; ++l) {
        transpose_job(p.w_in + (size_t)l * D * UC, D, UC, (bf16_t*)(ws + OFF_WINT + (size_t)l * NWIN * D), 0, scr, 0.f, (const float*)(ws + OFF_SCL) + SCL_WIN + l * 4096);
        transpose_job(p.w_out + (size_t)l * D * D, D, D, (bf16_t*)(ws + OFF_WOUTT) + (size_t)l * D * D, 0, scr);
        transpose_job(p.sh_gate + (size_t)l * D * 256, D, 256, (bf16_t*)(ws + OFF_SH1T + (size_t)l * 512 * D), 1, scr, W8_SCALE);
        transpose_job(p.sh_up + (size_t)l * D * 256, D, 256, (bf16_t*)(ws + OFF_SH1T + (size_t)l * 512 * D), 2, scr, W8_SCALE);
        transpose_job(p.sh_down + (size_t)l * 256 * D, 256, D, (bf16_t*)(ws + OFF_SH2T + (size_t)l * D * 256), 0, scr, W2_SCALE);
        transpose_job(p.router_w + (size_t)l * D * 64, D, 64, (bf16_t*)(ws + OFF_RT) + (size_t)l * 256 * D, 0, scr);
        { u32x4* z = (u32x4*)(ws + OFF_WINT + ((size_t)l * NWIN + UC) * D); const int n = (NWIN - UC) * D / 16;
            for (int i = blockIdx.x * NTHR + tix; i < n; i += gridDim.x * NTHR) z[i] = (u32x4){0u, 0u, 0u, 0u}; }
        { u32x4* z = (u32x4*)((bf16_t*)(ws + OFF_RT) + ((size_t)l * 256 + 64) * D); const int n = 192 * D / 8;
            for (int i = blockIdx.x * NTHR + tix; i < n; i += gridDim.x * NTHR) z[i] = (u32x4){0u, 0u, 0u, 0u}; }
    }
}
__device__ __forceinline__ void colscale_job(const float* src, int K, int N, float* cs, int Npad, LAS unsigned char* lds, int wg0) {
    const int tix = opaque_tid(), w = tix >> 6, lane = tix & 63;
    LAS float* red = (LAS float*)lds;
    for (int g = ((int)blockIdx.x - wg0 + (int)gridDim.x) % (int)gridDim.x; g < Npad / 64; g += gridDim.x) { const int n = g * 64 + lane; float m = 0.f;
        if (n < N) { const int k0 = w * (K / 8);
#pragma unroll 1
            for (int kk = k0; kk < k0 + K / 8; kk += 32) { float wv[32];
#pragma unroll
                for (int j = 0; j < 32; ++j) wv[j] = src[(size_t)(kk + j) * N + n];
#pragma unroll
                for (int j = 0; j < 32; ++j) m = fmaxf(m, fabsf(wv[j])); } }
        red[w * 64 + lane] = m;
        __syncthreads();
        if (w == 0) {
#pragma unroll
            for (int ww = 1; ww < 8; ++ww) m = fmaxf(m, red[ww * 64 + lane]);
            cs[n] = fmaxf(m, 1e-20f) * (1.f / 127.f); }
        __syncthreads(); }
}
__device__ __forceinline__ void phase_prologue(const P& p, LAS unsigned char* lds) {
    const int tix = opaque_tid();
    unsigned char* ws = p.ws;
    for (int l = 0; l < 2; ++l) colscale_job(p.w_in + (size_t)l * D * UC, D, UC, (float*)(ws + OFF_SCL) + SCL_WIN + l * 4096, 4096, lds, 192 - 64 * l);
    __syncthreads();
    LAS float* sc = (LAS float*)lds;
    LAS float* part = (LAS float*)(lds + 9 * 1024 * 4);
    __syncthreads();
    { float cv[18];
#pragma unroll
        for (int q = 0; q < 18; ++q) { const int i = tix + q * NTHR, s = i >> 10, k = i & 1023; cv[q] = s < 8 ? p.c[s * 1024 + k] : p.c_ctx[k]; }
#pragma unroll
        for (int q = 0; q < 18; ++q) sc[tix + q * NTHR] = siluf_(cv[q]); }
    __syncthreads();
    const int w = tix >> 6, lane = tix & 63;
    for (int item = blockIdx.x; item < 2 * 96; item += gridDim.x) {
        const int l = item / 96, cg = item - l * 96, col = cg * 64 + lane;
        const float* wm = p.w_mod + (size_t)l * D * 6144 + col;
        float a[9];
#pragma unroll
        for (int s = 0; s < 9; ++s) a[s] = 0.f;
#pragma unroll 1
        for (int k0 = w * 128; k0 < w * 128 + 128; k0 += 32) { float wv[32];
#pragma unroll
            for (int j = 0; j < 32; ++j) wv[j] = wm[(size_t)(k0 + j) * 6144];
#pragma unroll
            for (int j = 0; j < 32; ++j)
#pragma unroll
                for (int s = 0; s < 9; ++s) a[s] += sc[s * 1024 + k0 + j] * wv[j]; }
#pragma unroll
        for (int s = 0; s < 9; ++s) part[(w * 9 + s) * 64 + lane] = a[s];
        __syncthreads();
        for (int i = tix; i < 9 * 64; i += NTHR) { const int s = i >> 6, ln = i & 63; float v = p.b_mod[(size_t)l * 6144 + cg * 64 + ln];
#pragma unroll
            for (int ww = 0; ww < 8; ++ww) v += part[(ww * 9 + s) * 64 + ln];
            ((float*)(ws + OFF_MOD))[((size_t)l * 9 + s) * 6144 + cg * 64 + ln] = v; }
        __syncthreads();
    }
}

__device__ __forceinline__ void cvt_load_tile(const float* src, int N, int tile, int tix, float (&r)[8]) {
    const int nTn = N / 64, kb = tile / nTn, nb = tile - kb * nTn;
#pragma unroll
    for (int q = 0; q < 8; ++q) r[q] = src[(size_t)(kb * 64 + q * 8 + (tix >> 6)) * N + nb * 64 + (tix & 63)];
}
__device__ __forceinline__ void cvt_store_tile(const LAS float* scr, bf16_t* dst, int K, int N, int mode, int tile, int tix, float fp8scale) {
    const int nTn = N / 64, kb = tile / nTn, nb = tile - kb * nTn, n = tix >> 3, kc = tix & 7; float f[8];
#pragma unroll
    for (int j = 0; j < 8; ++j) f[j] = scr[(kc * 8 + j) * 65 + n];
    const int gn = nb * 64 + n; const int row = mode == 0 ? gn : ((gn >> 7) * 256 + (mode == 2 ? 128 : 0) + (gn & 127));
    if (fp8scale > 0.f) *(u32x2*)((unsigned char*)dst + (size_t)row * K + kb * 64 + kc * 8) = pack8_fp8(f, fp8scale);
    else *(u32x4*)(dst + (size_t)row * K + kb * 64 + kc * 8) = pack8(f);
}
__device__ __forceinline__ void phase_expert_cvt(const P& p, int l, LAS unsigned char* lds, int it0, int it1, int stride) {
    const int tix = opaque_tid();
    bf16_t* w1t = (bf16_t*)(p.ws + OFF_W1T); bf16_t* w2t = (bf16_t*)(p.ws + OFF_W2T);
    float cur[8], nxt[8];
#define CVT_LOAD(itv, regs) do { const int e_ = (itv) / 192, r_ = (itv) - e_ * 192, wh_ = r_ >> 6, tl_ = r_ & 63; const size_t eo_ = ((size_t)l * 64 + e_) * D * 256; \
        if (wh_ == 0) cvt_load_tile(p.exp_gate + eo_, 256, tl_, tix, regs); else if (wh_ == 1) cvt_load_tile(p.exp_up + eo_, 256, tl_, tix, regs); else cvt_load_tile(p.exp_down + eo_, D, tl_, tix, regs); } while (0)
    int it = it0, buf = 0;
    if (it < it1) CVT_LOAD(it, cur);
    for (; it < it1; it += stride) {
        LAS float* scr = (LAS float*)lds + buf * (64 * 65);
#pragma unroll
        for (int q = 0; q < 8; ++q) scr[(q * 8 + (tix >> 6)) * 65 + (tix & 63)] = cur[q];
        __syncthreads();
        if (it + stride < it1) CVT_LOAD(it + stride, nxt);
        { const int e = it / 192, r = it - e * 192, which = r >> 6, tile = r & 63;
            if (which == 0) cvt_store_tile(scr, (bf16_t*)((unsigned char*)w1t + (size_t)e * 512 * D), D, 256, 1, tile, tix, W8_SCALE);
            else if (which == 1) cvt_store_tile(scr, (bf16_t*)((unsigned char*)w1t + (size_t)e * 512 * D), D, 256, 2, tile, tix, W8_SCALE);
            else cvt_store_tile(scr, (bf16_t*)((unsigned char*)w2t + (size_t)e * D * 256), 256, D, 0, tile, tix, W2_SCALE); }
#pragma unroll
        for (int q = 0; q < 8; ++q) cur[q] = nxt[q];
        buf ^= 1;
    }
#undef CVT_LOAD
    __syncthreads();
}

template <int SRC, bool FINAL>
__device__ __forceinline__ void phase_norm(const P& p, int l, const float* normw, int sc_off, int sh_off, bool lat_only) {
    const int tix = opaque_tid();
    unsigned char* ws = p.ws;
    const int gw = blockIdx.x * 8 + (tix >> 6), lane = tix & 63;
#define CB(i) (SRC == 2 ? lane * 16 + (i) * 8 : (i) * 512 + lane * 8)
    const bf16_t* HB = (const bf16_t*)(ws + OFF_HB);
    const float* modg = (const float*)(ws + OFF_MOD) + (size_t)(FINAL ? l : l - 1) * 9 * 6144 + 5120;
    bf16_t* dst = (bf16_t*)(ws + OFF_AB);
    const float* mod = (const float*)(ws + OFF_MOD) + (size_t)l * 9 * 6144;
    float nw[16];
#pragma unroll
    for (int i = 0; i < 2; ++i)
#pragma unroll
        for (int j = 0; j < 8; ++j) nw[i * 8 + j] = normw[CB(i) + j];
    constexpr int NRAW = SRC == 0 ? 4 : (SRC == 1 ? 2 : 10);
    constexpr bool D3 = (SRC != 2);
    u32x4 cur[NRAW], nxt[NRAW], nx2[D3 ? NRAW : 1];
    auto valid = [&](int row) { return !((lat_only || FINAL) && (row % TPS) < CTXL); };
    auto load = [&](int row, u32x4 (&r)[NRAW]) {
        if (SRC == 0) { const float* xr = src_row_f32(p, row);
#pragma unroll
            for (int i = 0; i < 2; ++i) { r[2 * i] = __builtin_nontemporal_load((const u32x4*)(xr + CB(i))); r[2 * i + 1] = __builtin_nontemporal_load((const u32x4*)(xr + CB(i) + 4)); } }
        else {
#pragma unroll
            for (int i = 0; i < 2; ++i) { const size_t o = (size_t)row * D + CB(i); r[i] = *(const u32x4*)(HB + o); }
            if (SRC == 2) {
#pragma unroll
                for (int k = 0; k < 8; ++k) r[2 + k] = __builtin_nontemporal_load((const u32x4*)(ws + slot_off(k) + (size_t)row * D + lane * 16)); } }
    };
    int mcur = -1; f32x4 msc[2][2], msh[2][2];
#pragma unroll
    for (int i = 0; i < 2; ++i)
#pragma unroll
        for (int h = 0; h < 2; ++h) { msc[i][h] = (f32x4){0.f, 0.f, 0.f, 0.f}; msh[i][h] = (f32x4){0.f, 0.f, 0.f, 0.f}; }
    int gcur = -1; f32x4 mgf[2][2];
#pragma unroll
    for (int i = 0; i < 2; ++i) { mgf[i][0] = (f32x4){0.f, 0.f, 0.f, 0.f}; mgf[i][1] = (f32x4){0.f, 0.f, 0.f, 0.f}; }
    const int end = gw * 33 + 33;
    int row = gw * 33;
    while (row < end && !valid(row)) ++row;
    if (row < end) load(row, cur);
    int nrow = row + 1;
    while (nrow < end && !valid(nrow)) ++nrow;
    if (nrow < end) load(nrow, nxt);
    while (row < end) {
        int n2row = nrow + 1;
        while (n2row < end && !valid(n2row)) ++n2row;
        if constexpr (D3) { if (n2row < end) load(n2row, nx2); }
        const int b = row / TPS, pos = row - b * TPS;
        float v[16];
        if (SRC == 0) {
#pragma unroll
            for (int i = 0; i < 2; ++i)
#pragma unroll
                for (int j = 0; j < 4; ++j) { v[i * 8 + j] = __uint_as_float(cur[2 * i][j]); v[i * 8 + 4 + j] = __uint_as_float(cur[2 * i + 1][j]); } }
        else {
            if (SRC == 2) { const int gi = pos < CTXL ? 8 : b;
                if (gi != gcur) { const float* grow = modg + (size_t)gi * 6144;
#pragma unroll
                    for (int i = 0; i < 2; ++i) { mgf[i][0] = *(const f32x4*)(grow + CB(i)) * (1.f / SLOT_SCALE); mgf[i][1] = *(const f32x4*)(grow + CB(i) + 4) * (1.f / SLOT_SCALE); }
                    gcur = gi; } }
#pragma unroll
            for (int i = 0; i < 2; ++i) { float f[8]; unpack8(cur[i], f);
                if (SRC == 2) { float sm[8];
#pragma unroll
                    for (int j = 0; j < 8; ++j) sm[j] = 0.f;
#pragma unroll
                    for (int k = 0; k < 8; ++k) { const int w0 = (int)cur[2 + k][2 * i], w1 = (int)cur[2 + k][2 * i + 1];
                        const f32x2_t q0 = __builtin_amdgcn_cvt_pk_f32_fp8(w0, false), q1 = __builtin_amdgcn_cvt_pk_f32_fp8(w0, true), q2 = __builtin_amdgcn_cvt_pk_f32_fp8(w1, false), q3 = __builtin_amdgcn_cvt_pk_f32_fp8(w1, true);
                        sm[0] += q0[0]; sm[1] += q0[1]; sm[2] += q1[0]; sm[3] += q1[1]; sm[4] += q2[0]; sm[5] += q2[1]; sm[6] += q3[0]; sm[7] += q3[1]; }
#pragma unroll
                    for (int j = 0; j < 4; ++j) { f[j] += mgf[i][0][j] * sm[j]; f[4 + j] += mgf[i][1][j] * sm[4 + j]; } }
#pragma unroll
                for (int j = 0; j < 8; ++j) v[i * 8 + j] = f[j]; }
            if (SRC == 2 && !FINAL) {
#pragma unroll
                for (int i = 0; i < 2; ++i) { float f[8];
#pragma unroll
                    for (int j = 0; j < 8; ++j) f[j] = v[i * 8 + j];
                    *(u32x4*)((bf16_t*)(ws + OFF_HB) + (size_t)row * D + CB(i)) = pack8(f); } } }
        float ss = 0.f;
#pragma unroll
        for (int j = 0; j < 16; ++j) ss += v[j] * v[j];
        ss = wave_sum(ss);
        const float rstd = rsqrtf(ss * (1.f / D) + EPS);
        if (FINAL) { float* o = p.out + ((size_t)b * SEQ + (pos - CTXL)) * D;
#pragma unroll
            for (int i = 0; i < 2; ++i) { f32x4 a, c;
#pragma unroll
                for (int j = 0; j < 4; ++j) { a[j] = v[i * 8 + j] * rstd * nw[i * 8 + j]; c[j] = v[i * 8 + 4 + j] * rstd * nw[i * 8 + 4 + j]; }
                *(f32x4*)(o + CB(i)) = a; *(f32x4*)(o + CB(i) + 4) = c; } }
        else { const int mi = pos < CTXL ? 8 : b;
            if (mi != mcur) { const float* mrow = mod + (size_t)mi * 6144;
#pragma unroll
                for (int i = 0; i < 2; ++i) { const int col = CB(i);
                    msc[i][0] = *(const f32x4*)(mrow + sc_off + col); msc[i][1] = *(const f32x4*)(mrow + sc_off + col + 4);
                    msh[i][0] = *(const f32x4*)(mrow + sh_off + col); msh[i][1] = *(const f32x4*)(mrow + sh_off + col + 4); }
                mcur = mi; }
            float fo[2][8]; float amax = 0.f;
#pragma unroll
            for (int i = 0; i < 2; ++i)
#pragma unroll
                for (int j = 0; j < 4; ++j) { fo[i][j] = v[i * 8 + j] * rstd * nw[i * 8 + j] * (1.f + msc[i][0][j]) + msh[i][0][j]; fo[i][4 + j] = v[i * 8 + 4 + j] * rstd * nw[i * 8 + 4 + j] * (1.f + msc[i][1][j]) + msh[i][1][j];
                    amax = fmaxf(amax, fmaxf(fabsf(fo[i][j]), fabsf(fo[i][4 + j]))); }
            if (SRC == 1) {
#pragma unroll
                for (int i = 0; i < 2; ++i) { const int col = CB(i); *(u32x4*)(dst + (size_t)row * D + col) = pack8(fo[i]); *(u32x2*)(ws + OFF_F8 + (size_t)row * D + col) = pack8_fp8(fo[i], 1.f); } }
            else {
                amax = fmaxf(wave_max(amax), 1e-20f); const float inv = 127.f / amax;
                if (lane == 0) ((float*)(ws + OFF_SCL))[SCL_RA + row] = amax * (1.f / 127.f);
#pragma unroll
                for (int i = 0; i < 2; ++i) *(u32x2*)(ws + OFF_AB + (size_t)row * D + CB(i)) = pack8_i8(fo[i], inv); } }
        if constexpr (D3) {
#pragma unroll
            for (int i = 0; i < NRAW; ++i) { cur[i] = nxt[i]; nxt[i] = nx2[i]; }
        } else {
#pragma unroll
            for (int i = 0; i < NRAW; ++i) cur[i] = nxt[i];
            if (n2row < end) load(n2row, nxt); }
        row = nrow; nrow = n2row;
    }
}
#undef CB

__device__ __forceinline__ void prep_run(const P& p, int l, bf16_t* U, int row0, int nblk, int g, int lane) {
    const int tix = opaque_tid();
    int colbase, kind;
    const float* cw = nullptr; const float* cb = nullptr; int cstride = 0, cc = 0;
    if (g < 8) { kind = 0; colbase = C_X + 128 * g; cc = 128 * g + 2 * lane; cw = p.ssd_conv_w + (size_t)l * 5 * 1024; cb = p.ssd_conv_b + (size_t)l * 1024; cstride = 1024; }
    else if (g < 14) { kind = 1; colbase = C_GQ + 128 * (g - 8); cc = 128 * (g - 8) + 2 * lane; cw = p.gdn_conv_w + (size_t)l * 5 * 768; cstride = 768; }
    else if (g < 16) { kind = 2; colbase = C_HQ + 128 * (g - 14); }
    else { kind = 3; colbase = C_HF + 128 * (g - 16); cc = (128 * (g - 16) + 2 * lane) & 255; }
    bf16_t* base = U + (size_t)row0 * UC + colbase + 2 * lane;
    if (kind >= 2) {
        float lo0 = 0.f, lo1 = 0.f;
        if (kind == 3 && l == 1) { const float a0 = p.hgrn_lb[cc], a1 = p.hgrn_lb[256 + cc], b0 = p.hgrn_lb[cc + 1], b1 = p.hgrn_lb[256 + cc + 1];
            lo0 = 1.f / (1.f + __expf(a0 - a1)); lo1 = 1.f / (1.f + __expf(b0 - b1)); }
        for (int blk = 0; blk < nblk; ++blk) { bf16_t* bb = base + (size_t)blk * 64 * UC; unsigned raw[64];
#pragma unroll
            for (int t = 0; t < 64; ++t) raw[t] = *(const unsigned*)(bb + (size_t)t * UC);
#pragma unroll
            for (int t = 0; t < 64; ++t) { float a = bflo(raw[t]), b = bfhi(raw[t]);
                if (kind == 2) { a = siluf_(a); b = siluf_(b); } else { a = (1.f - lo0) * sigmoidf_(-a); b = (1.f - lo1) * sigmoidf_(-b); }
                *(unsigned*)(bb + (size_t)t * UC) = pk2(a, b); } }
        return;
    }
    float w0[5], w1[5], bias0 = 0.f, bias1 = 0.f;
#pragma unroll
    for (int j = 0; j < 5; ++j) { w0[j] = cw[j * cstride + cc]; w1[j] = cw[j * cstride + cc + 1]; }
    if (kind == 0) { bias0 = cb[cc]; bias1 = cb[cc + 1]; }
    const bool l2 = (kind == 1) && (g < 12); const float l2s = (g < 10) ? 0.125f : 1.f;
    float pa0 = 0.f, pa1 = 0.f, pb0 = 0.f, pb1 = 0.f;
    for (int blk = 0; blk < nblk; ++blk) {
        float r0[68], r1[68];
        r0[0] = pa0; r1[0] = pa1; r0[1] = pb0; r1[1] = pb1;
        bf16_t* bb = base + (size_t)blk * 64 * UC;
#pragma unroll
        for (int t = 0; t < 64; ++t) { const unsigned v = *(const unsigned*)(bb + (size_t)t * UC); r0[2 + t] = bflo(v); r1[2 + t] = bfhi(v); }
        if (blk + 1 < nblk) {
#pragma unroll
            for (int t = 64; t < 66; ++t) { const unsigned v = *(const unsigned*)(bb + (size_t)t * UC); r0[2 + t] = bflo(v); r1[2 + t] = bfhi(v); } }
        else { r0[66] = r0[67] = r1[66] = r1[67] = 0.f; }
#pragma unroll
        for (int t = 0; t < 64; ++t) {
            float a = bias0, b = bias1;
#pragma unroll
            for (int j = 0; j < 5; ++j) { a += r0[t + j] * w0[j]; b += r1[t + j] * w1[j]; }
            a = siluf_(a); b = siluf_(b);
            if (l2) { float ss = a * a + b * b;
#pragma unroll
                for (int o = 1; o < 32; o <<= 1) ss += __shfl_xor(ss, o);
                const float f = rsqrtf(ss + 1e-6f) * l2s; a *= f; b *= f; }
            *(unsigned*)(bb + (size_t)t * UC) = pk2(a, b);
        }
        pa0 = r0[64]; pa1 = r1[64]; pb0 = r0[65]; pb1 = r1[65];
    }
}
__device__ __forceinline__ void phase_prep(const P& p, int l) {
    const int tix = opaque_tid();
    bf16_t* U = (bf16_t*)(p.ws + OFF_UB);
    const int gw = blockIdx.x * 8 + (tix >> 6), lane = tix & 63, NW = gridDim.x * 8;
    constexpr int NG = 14;
    constexpr int NCTX = NBATCH * NG, NLAT = NBATCH * 128 * NG;
    if (gw < NCTX) { const int b = gw / NG, g = gw - b * NG; prep_run(p, l, U, b * TPS, 4, g, lane); }
    const int nfree = NW - NCTX;
    for (int slot = 0; ; ++slot) {
        int j;
        if (slot < 4) { if (gw < NCTX) continue; j = slot * nfree + (gw - NCTX); }
        else j = 4 * nfree + (slot - 4) * NW + gw;
        if (j >= NLAT) break;
        const int g = j % NG, rr = j / NG, b = rr >> 7, gr = rr & 127; prep_run(p, l, U, b * TPS + CTXL + gr * 64, 1, g, lane);
    }
}

__device__ __forceinline__ int chain_row(int b, int dir, int i) { const int pos = dir == 0 ? i : (i < CTXL ? (CTXL - 1 - i) : (TPS + CTXL - 1 - i)); return b * TPS + pos; }
__device__ __forceinline__ bf16x8 ldfrag(const LAS unsigned char* base, int row, int stride, int k0) { return *(const LAS bf16x8*)(base + (size_t)(row * stride + k0) * 2); }
#define DPP_SHR_ADD(v, ctrl, rmask) (v) += __builtin_bit_cast(float, __builtin_amdgcn_update_dpp(0, __builtin_bit_cast(int, (v)), (ctrl), (rmask), 0xf, true))
__device__ __forceinline__ float row16_incl_scan(float v) {
    DPP_SHR_ADD(v, 0x111, 0xf); DPP_SHR_ADD(v, 0x112, 0xf); DPP_SHR_ADD(v, 0x114, 0xf); DPP_SHR_ADD(v, 0x118, 0xf);
    return v;
}
__device__ __forceinline__ float wave_incl_scan(float v) {
    v = row16_incl_scan(v);
    DPP_SHR_ADD(v, 0x142, 0xa);
    DPP_SHR_ADD(v, 0x143, 0xc);
    return v;
}
typedef short bf16x4 __attribute__((ext_vector_type(4)));
__device__ __forceinline__ bf16x4 ldfrag4(const LAS unsigned char* base, int row, int stride, int k0) { return *(const LAS bf16x4*)(base + (size_t)(row * stride + k0) * 2); }
__device__ __forceinline__ bf16x4 accfrag(const f32x4 a) { u32x2 o; o.x = pk2(a[0], a[1]); o.y = pk2(a[2], a[3]); return __builtin_bit_cast(bf16x4, o); }
#define MFMA16(a, b, c) __builtin_amdgcn_mfma_f32_16x16x16bf16_1k((a), (b), (c), 0, 0, 0)
__device__ __forceinline__ void scan_ssd_mma(const P& p, int l, int b, int hd, int dir, LAS unsigned char* lds) {
    const int tix = opaque_tid();
    const bf16_t* U = (const bf16_t*)(p.ws + OFF_UB); bf16_t* Y = (bf16_t*)(p.ws + (dir == 0 ? OFF_AB : OFF_Y2));
    const int w = __builtin_amdgcn_readfirstlane(tix >> 6), lane = tix & 63, l15 = lane & 15, lq = lane >> 4, g = hd >> 2;
    const float A = -__expf(p.ssd_a_log[(l * 2 + dir) * 8 + hd]), dtb = p.ssd_dt_bias[(l * 2 + dir) * 8 + hd], Dk = p.ssd_d[l * 8 + hd];
    constexpr int SC = 136, SX = 72;
    constexpr int SB = 44544;
    LAS unsigned char* BT = lds + 2 * SB;
    LAS unsigned char* XT = BT + 18432;
    LAS unsigned char* LS = XT + 9216;
    constexpr int NCH = TPS / 64;
    f32x4 Ht[8];
#pragma unroll
    for (int j = 0; j < 8; ++j) Ht[j] = (f32x4){0.f, 0.f, 0.f, 0.f};
    u32x4 preA[5], preB[5]; bf16_t pdtA = 0, pdtB = 0;
    auto issue = [&](int c, u32x4 (&pre)[5], bf16_t& pdt) {
#pragma unroll
        for (int j = 0; j < 5; ++j) { const int q = tix + NTHR * j, t = q / 40, pc = q - t * 40;
            const bf16_t* r = U + (size_t)chain_row(b, dir, c * 64 + t) * UC;
            const int col = pc < 8 ? (C_X + hd * 64 + pc * 8) : (pc < 24 ? (C_B + g * 128 + (pc - 8) * 8) : (C_C + g * 128 + (pc - 24) * 8));
            pre[j] = *(const u32x4*)(r + col); }
        if (w == 0) pdt = U[(size_t)chain_row(b, dir, c * 64 + lane) * UC + C_DT + dir * 8 + hd];
    };
    issue(0, preA, pdtA); issue(1, preB, pdtB);
    const int pt = w & 3, th = w >> 2;
    static_assert(NCH % 2 == 0, "chunk loop is unrolled by two");
    auto chunk = [&](int c, u32x4 (&pre)[5], bf16_t& pdt) {
        LAS unsigned char* CS = lds + (c & 1) * SB; LAS unsigned char* BS = CS + 17408; LAS unsigned char* XS = CS + 34816;
        LAS float* CUM = (LAS float*)(CS + 44032); LAS float* DTV = CUM + 64;
#pragma unroll
        for (int j = 0; j < 5; ++j) { const int q = tix + NTHR * j, t = q / 40, pc = q - t * 40;
            LAS unsigned char* dst = pc < 8 ? (XS + (size_t)(t * SX + pc * 8) * 2) : (pc < 24 ? (BS + (size_t)(t * SC + (pc - 8) * 8) * 2) : (CS + (size_t)(t * SC + (pc - 24) * 8) * 2));
            *(LAS u32x4*)dst = pre[j]; }
        if (w == 0) { const float dt = softplusf_(bf2f(pdt) + dtb); float a = dt * A;
            a = wave_incl_scan(a);
            CUM[lane] = a; DTV[lane] = dt; }
        __syncthreads();
        if (c + 2 < NCH) issue(c + 2, pre, pdt);
        const float cum63 = CUM[63];
        { const int s = tix & 63, pb = tix >> 6; float f[8]; unpack8(*(const LAS u32x4*)(XS + (size_t)(s * SX + pb * 8) * 2), f); const float dt = DTV[s];
#pragma unroll
            for (int j = 0; j < 8; ++j) *(LAS bf16_t*)(XT + (size_t)((pb * 8 + j) * SX + s) * 2) = f2bf(f[j] * dt);
            const float sc = __expf(cum63 - CUM[s]);
#pragma unroll
            for (int h2 = 0; h2 < 2; ++h2) { unpack8(*(const LAS u32x4*)(BS + (size_t)(s * SC + pb * 16 + h2 * 8) * 2), f);
#pragma unroll
                for (int j = 0; j < 8; ++j) *(LAS bf16_t*)(BT + (size_t)((pb * 16 + h2 * 8 + j) * SX + s) * 2) = f2bf(f[j] * sc); } }
        { const int tm = w >> 1;
            float ct[4];
#pragma unroll
            for (int r = 0; r < 4; ++r) ct[r] = CUM[tm * 16 + 4 * lq + r];
#pragma unroll
            for (int tt = 0; tt < 2; ++tt) { const int tn = 2 * (w & 1) + tt; f32x4 acc = (f32x4){0.f, 0.f, 0.f, 0.f};
#pragma unroll
                for (int kk = 0; kk < 4; ++kk) acc = __builtin_amdgcn_mfma_f32_16x16x32_bf16(ldfrag(CS, tm * 16 + l15, SC, kk * 32 + 8 * lq), ldfrag(BS, tn * 16 + l15, SC, kk * 32 + 8 * lq), acc, 0, 0, 0);
                const int s = tn * 16 + l15; const float cs = CUM[s];
#pragma unroll
                for (int r = 0; r < 4; ++r) { const int t = tm * 16 + 4 * lq + r; const float v = (s <= t) ? acc[r] * __expf(ct[r] - cs) : 0.f;
                    *(LAS bf16_t*)(LS + (size_t)(t * SX + s) * 2) = f2bf(v); } } }
        __syncthreads();
        { bf16x4 hb[8]; const int yrow0 = chain_row(b, dir, c * 64);
#pragma unroll
            for (int nt = 0; nt < 8; ++nt) hb[nt] = accfrag(Ht[nt]);
#pragma unroll
            for (int tt = 0; tt < 2; ++tt) { const int tm = 2 * th + tt; f32x4 acc = (f32x4){0.f, 0.f, 0.f, 0.f};
#pragma unroll
                for (int nt = 0; nt < 8; ++nt) acc = MFMA16(ldfrag4(CS, tm * 16 + l15, SC, nt * 16 + 4 * lq), hb[nt], acc);
#pragma unroll
                for (int r = 0; r < 4; ++r) acc[r] *= __expf(CUM[tm * 16 + 4 * lq + r]);
#pragma unroll
                for (int kk = 0; kk < 2; ++kk) acc = __builtin_amdgcn_mfma_f32_16x16x32_bf16(ldfrag(LS, tm * 16 + l15, SX, kk * 32 + 8 * lq), ldfrag(XT, pt * 16 + l15, SX, kk * 32 + 8 * lq), acc, 0, 0, 0);
                const int pcol = pt * 16 + l15;
#pragma unroll
                for (int r = 0; r < 4; ++r) { const int t = tm * 16 + 4 * lq + r; float y = acc[r];
                    if (dir == 0) y += Dk * bf2f(*(const LAS bf16_t*)(XS + (size_t)(t * SX + pcol) * 2));
                    Y[(size_t)(yrow0 + (dir == 0 ? t : -t)) * D + hd * 64 + pcol] = f2bf(y); } }
            const float dec = __expf(cum63);
            const bf16x8 xf0 = ldfrag(XT, pt * 16 + l15, SX, 8 * lq), xf1 = ldfrag(XT, pt * 16 + l15, SX, 32 + 8 * lq);
#pragma unroll
            for (int nt = 0; nt < 8; ++nt) { f32x4 acc = Ht[nt] * dec;
                acc = __builtin_amdgcn_mfma_f32_16x16x32_bf16(ldfrag(BT, nt * 16 + l15, SX, 8 * lq), xf0, acc, 0, 0, 0);
                acc = __builtin_amdgcn_mfma_f32_16x16x32_bf16(ldfrag(BT, nt * 16 + l15, SX, 32 + 8 * lq), xf1, acc, 0, 0, 0);
                Ht[nt] = acc; } }
    };
#pragma unroll 1
    for (int c = 0; c < NCH; c += 2) { chunk(c, preA, pdtA); chunk(c + 1, preB, pdtB); }
    __syncthreads();
}
__device__ __forceinline__ void scan_hgrn_mma(const P& p, int l, int b, int hd, int dir, LAS unsigned char* lds) {
    const int tix = opaque_tid();
    const bf16_t* U = (const bf16_t*)(p.ws + OFF_UB); bf16_t* Y = (bf16_t*)(p.ws + (dir == 0 ? OFF_AB : OFF_Y2));
    const int w = __builtin_amdgcn_readfirstlane(tix >> 6), lane = tix & 63, l15 = lane & 15, lq = lane >> 4;
    constexpr int SX = 72, SP = 40;
    LAS unsigned char* QS = lds;
    LAS unsigned char* KS = lds + 9216;
    LAS unsigned char* VS = lds + 18432;
    LAS unsigned char* KE = lds + 27648;
    LAS unsigned char* VT = lds + 48128;
    LAS unsigned char* ATT = lds + 68608;
    LAS float* ER = (LAS float*)(lds + 73728);
    LAS unsigned char* ST = lds + 74752;
    constexpr int NCH = TPS / 64;
    for (int i = tix; i < (74752 + 9216 - 27648) / 4; i += NTHR) ((LAS unsigned*)KE)[i] = 0u;
    f32x4 Sacc[4];
#pragma unroll
    for (int i = 0; i < 4; ++i) Sacc[i] = (f32x4){0.f, 0.f, 0.f, 0.f};
    u32x4 preA[3], preB[3];
    auto issue = [&](int c, u32x4 (&pre)[3]) {
#pragma unroll
        for (int j = 0; j < 3; ++j) { const int q = tix + NTHR * j, t = q / 24, pc = q - t * 24;
            const bf16_t* r = U + (size_t)chain_row(b, dir, c * 64 + t) * UC;
            const int col = pc < 8 ? (C_HQ + hd * 64 + pc * 8) : (pc < 16 ? (C_HF + dir * 256 + hd * 64 + (pc - 8) * 8) : (C_HI + hd * 64 + (pc - 16) * 8));
            pre[j] = *(const u32x4*)(r + col); }
    };
    issue(0, preA); issue(1, preB);
    static_assert(NCH % 2 == 0, "chunk loop is unrolled by two");
#pragma unroll 1
    for (int cc = 0; cc < NCH; cc += 2)
#pragma unroll
    for (int half = 0; half < 2; ++half) { const int c = cc + half; u32x4 (&pre)[3] = half ? preB : preA;
#pragma unroll
        for (int j = 0; j < 3; ++j) { const int q = tix + NTHR * j, t = q / 24, pc = q - t * 24;
            LAS unsigned char* dst = (pc < 8 ? QS : (pc < 16 ? KS : VS)) + (size_t)(t * SX + (pc & 7) * 8) * 2;
            *(LAS u32x4*)dst = pre[j]; }
        __syncthreads();
        if (c + 2 < NCH) issue(c + 2, pre);
        if (tix < 256) { const int k = tix & 63, j = tix >> 6; float r = 0.f, rr[16], kv[16], qv[16];
#pragma unroll
            for (int t = 0; t < 16; ++t) { kv[t] = bf2f(*(const LAS bf16_t*)(KS + (size_t)((16 * j + t) * SX + k) * 2)); qv[t] = bf2f(*(const LAS bf16_t*)(QS + (size_t)((16 * j + t) * SX + k) * 2)); }
#pragma unroll
            for (int t = 0; t < 16; ++t) { r += __logf(fmaxf(1.f - kv[t], 1e-30f)); rr[t] = r; }
#pragma unroll
            for (int t = 0; t < 16; ++t) { *(LAS bf16_t*)(QS + (size_t)((16 * j + t) * SX + k) * 2) = f2bf(qv[t] * __expf(rr[t])); *(LAS bf16_t*)(KS + (size_t)((16 * j + t) * SX + k) * 2) = f2bf(kv[t] * __expf(-fmaxf(rr[t], -80.f))); }
            ER[j * 64 + k] = __expf(r);
#pragma unroll
            for (int t = 0; t < 16; ++t) *(LAS bf16_t*)(KE + (size_t)((j * 64 + k) * SP + t) * 2) = f2bf(kv[t] * __expf(r - rr[t])); }
        else { const int v = (tix - 256) & 63, j = (tix - 256) >> 6; bf16_t tv[16];
#pragma unroll
            for (int t = 0; t < 16; ++t) tv[t] = *(const LAS bf16_t*)(VS + (size_t)((16 * j + t) * SX + v) * 2);
            u32x4 o0, o1; o0.x = tv[0] | ((unsigned)tv[1] << 16); o0.y = tv[2] | ((unsigned)tv[3] << 16); o0.z = tv[4] | ((unsigned)tv[5] << 16); o0.w = tv[6] | ((unsigned)tv[7] << 16);
            o1.x = tv[8] | ((unsigned)tv[9] << 16); o1.y = tv[10] | ((unsigned)tv[11] << 16); o1.z = tv[12] | ((unsigned)tv[13] << 16); o1.w = tv[14] | ((unsigned)tv[15] << 16);
            *(LAS u32x4*)(VT + (size_t)((j * 64 + v) * SP) * 2) = o0; *(LAS u32x4*)(VT + (size_t)((j * 64 + v) * SP + 8) * 2) = o1; }
        __syncthreads();
        if (w < 4) { const int j = w; f32x4 acc = (f32x4){0.f, 0.f, 0.f, 0.f};
#pragma unroll
            for (int kk = 0; kk < 2; ++kk) acc = __builtin_amdgcn_mfma_f32_16x16x32_bf16(ldfrag(QS, 16 * j + l15, SX, kk * 32 + 8 * lq), ldfrag(KS, 16 * j + l15, SX, kk * 32 + 8 * lq), acc, 0, 0, 0);
#pragma unroll
            for (int r = 0; r < 4; ++r) { const int t = 4 * lq + r; *(LAS bf16_t*)(ATT + (size_t)((j * 16 + t) * SP + l15) * 2) = f2bf(l15 <= t ? acc[r] : 0.f); } }
        __syncthreads();
        if (w < 4) { const int vt = w; const int yrow0 = chain_row(b, dir, c * 64), ysg = dir == 0 ? 1 : -1;
#pragma unroll
            for (int j = 0; j < 4; ++j) {
                bf16x4 sb[4];
#pragma unroll
                for (int kt = 0; kt < 4; ++kt) sb[kt] = accfrag(Sacc[kt]);
                const bf16x4 vfr = ldfrag4(VT, j * 64 + vt * 16 + l15, SP, 4 * lq);
                f32x4 o = (f32x4){0.f, 0.f, 0.f, 0.f};
#pragma unroll
                for (int kt = 0; kt < 4; ++kt) o = MFMA16(ldfrag4(QS, 16 * j + l15, SX, 16 * kt + 4 * lq), sb[kt], o);
                o = MFMA16(ldfrag4(ATT, j * 16 + l15, SP, 4 * lq), vfr, o);
#pragma unroll
                for (int r = 0; r < 4; ++r) Y[(size_t)(yrow0 + ysg * (16 * j + 4 * lq + r)) * D + 512 + hd * 64 + vt * 16 + l15] = f2bf(o[r]);
#pragma unroll
                for (int kt = 0; kt < 4; ++kt) { f32x4 acc = Sacc[kt];
#pragma unroll
                    for (int r = 0; r < 4; ++r) acc[r] *= ER[j * 64 + kt * 16 + 4 * lq + r];
                    Sacc[kt] = MFMA16(ldfrag4(KE, j * 64 + kt * 16 + l15, SP, 4 * lq), vfr, acc); }
            } }
        __syncthreads();
    }
}
__device__ __forceinline__ void scan_gdn_mma(const P& p, int l, int b, int hd, int dir, LAS unsigned char* lds) {
    const int tix = opaque_tid();
    const bf16_t* U = (const bf16_t*)(p.ws + OFF_UB); bf16_t* Y = (bf16_t*)(p.ws + (dir == 0 ? OFF_AB : OFF_Y2));
    const int w = __builtin_amdgcn_readfirstlane(tix >> 6), lane = tix & 63, l15 = lane & 15, lq = lane >> 4;
    const float Aa = __expf(p.gdn_a_log[(l * 2 + dir) * 4 + hd]), dtb = p.gdn_dt_bias[(l * 2 + dir) * 4 + hd];
    constexpr int SX = 72, SP = 40;
    LAS unsigned char* QS = lds;
    LAS unsigned char* KS = lds + 9216;
    LAS unsigned char* VS = lds + 18432;
    LAS unsigned char* QG = lds + 27648;
    LAS unsigned char* KE = lds + 36864;
    LAS float* AM = (LAS float*)(lds + 57344);
    LAS unsigned char* QKM = lds + 61952;
    LAS unsigned char* TM = lds + 67072;
    LAS unsigned char* RT = lds + 72192;
    LAS unsigned char* VNT = lds + 77312;
    LAS unsigned char* MT = lds + 82432;
    LAS float* GAM = (LAS float*)(lds + 100864); LAS float* BETA = (LAS float*)(lds + 101120); LAS float* EGAM = (LAS float*)(lds + 101376);
    constexpr int NCH = TPS / 64;
    for (int i = tix; i < (82432 + 9216 - 36864) / 4; i += NTHR) ((LAS unsigned*)KE)[i] = 0u;
    f32x4 Macc[4];
#pragma unroll
    for (int i = 0; i < 4; ++i) Macc[i] = (f32x4){0.f, 0.f, 0.f, 0.f};
    u32x4 preA[3], preB[3]; bf16_t paA = 0, pbA = 0, paB = 0, pbB = 0;
    auto issue = [&](int c, u32x4 (&pre)[3], bf16_t& pa, bf16_t& pb) {
#pragma unroll
        for (int j = 0; j < 3; ++j) { const int q = tix + NTHR * j, t = q / 24, pc = q - t * 24;
            const bf16_t* r = U + (size_t)chain_row(b, dir, c * 64 + t) * UC;
            const int col = pc < 8 ? (C_GQ + hd * 64 + pc * 8) : (pc < 16 ? (C_GK + hd * 64 + (pc - 8) * 8) : (C_GV + hd * 64 + (pc - 16) * 8));
            pre[j] = *(const u32x4*)(r + col); }
        if (w == 0) { const bf16_t* r = U + (size_t)chain_row(b, dir, c * 64 + lane) * UC; pa = r[C_GA + dir * 4 + hd]; pb = r[C_GB + dir * 4 + hd]; }
    };
    issue(0, preA, paA, pbA); issue(1, preB, paB, pbB);
    static_assert(NCH % 2 == 0, "chunk loop is unrolled by two");
#pragma unroll 1
    for (int cc = 0; cc < NCH; cc += 2)
#pragma unroll
    for (int half = 0; half < 2; ++half) { const int c = cc + half; u32x4 (&pre)[3] = half ? preB : preA; bf16_t& pa = half ? paB : paA; bf16_t& pb = half ? pbB : pbA;
        const int tix = opaque_tid(), lane = tix & 63, l15 = lane & 15, lq = lane >> 4;
#pragma unroll
        for (int j = 0; j < 3; ++j) { const int q = tix + NTHR * j, t = q / 24, pc = q - t * 24;
            LAS unsigned char* dst = (pc < 8 ? QS : (pc < 16 ? KS : VS)) + (size_t)(t * SX + (pc & 7) * 8) * 2;
            *(LAS u32x4*)dst = pre[j]; }
        if (w == 0) { float g = -Aa * softplusf_(bf2f(pa) + dtb); const float be = sigmoidf_(bf2f(pb));
            g = row16_incl_scan(g);
            GAM[lane] = g; BETA[lane] = be; EGAM[lane] = __expf(g); }
        __syncthreads();
        if (c + 2 < NCH) issue(c + 2, pre, pa, pb);
        { const int t = tix >> 3, kb = tix & 7; float f[8]; unpack8(*(const LAS u32x4*)(QS + (size_t)(t * SX + kb * 8) * 2), f); const float eg = EGAM[t];
#pragma unroll
            for (int i = 0; i < 8; ++i) f[i] *= eg;
            *(LAS u32x4*)(QG + (size_t)(t * SX + kb * 8) * 2) = pack8(f);
            unpack8(*(const LAS u32x4*)(KS + (size_t)(t * SX + kb * 8) * 2), f); const float ek = __expf(GAM[(t & 48) + 15] - GAM[t]);
#pragma unroll
            for (int i = 0; i < 8; ++i) *(LAS bf16_t*)(KE + (size_t)(((t >> 4) * 64 + kb * 8 + i) * SP + (t & 15)) * 2) = f2bf(f[i] * ek); }
        { const int j = w & 3, which = w >> 2;
            if (which == 0) {
                f32x4 kk = (f32x4){0.f, 0.f, 0.f, 0.f};
#pragma unroll
                for (int q = 0; q < 2; ++q) kk = __builtin_amdgcn_mfma_f32_16x16x32_bf16(ldfrag(KS, 16 * j + l15, SX, q * 32 + 8 * lq), ldfrag(KS, 16 * j + l15, SX, q * 32 + 8 * lq), kk, 0, 0, 0);
                const float gs = GAM[16 * j + l15], bs = BETA[16 * j + l15];
                f32x4 Q, QT, ST;
#pragma unroll
                for (int r = 0; r < 4; ++r) { const int t = 4 * lq + r; const float gt = GAM[16 * j + t], bt = BETA[16 * j + t];
                    Q[r] = (l15 < t) ? -bt * kk[r] * __expf(gt - gs) : 0.f;
                    QT[r] = (t < l15) ? -bs * kk[r] * __expf(gs - gt) : 0.f;
                    ST[r] = QT[r] + ((t == l15) ? 1.f : 0.f); }
#pragma unroll
                for (int lv = 0; lv < 3; ++lv) { const bf16x4 qa = accfrag(QT), qb = accfrag(Q);
                    const f32x4 Q2 = MFMA16(qa, qb, ((f32x4){0.f, 0.f, 0.f, 0.f}));
                    if (lv < 2) QT = MFMA16(qb, qa, ((f32x4){0.f, 0.f, 0.f, 0.f}));
                    Q = Q2;
                    ST = MFMA16(accfrag(Q), accfrag(ST), ST); }
                *(LAS bf16x4*)(TM + (size_t)(j * 64 + lane) * 8) = accfrag(ST);
            } else {
                f32x4 qk = (f32x4){0.f, 0.f, 0.f, 0.f};
#pragma unroll
                for (int q = 0; q < 2; ++q) qk = __builtin_amdgcn_mfma_f32_16x16x32_bf16(ldfrag(KS, 16 * j + l15, SX, q * 32 + 8 * lq), ldfrag(QS, 16 * j + l15, SX, q * 32 + 8 * lq), qk, 0, 0, 0);
                const float gt = GAM[16 * j + l15];
#pragma unroll
                for (int r = 0; r < 4; ++r) { const int s2 = 4 * lq + r; qk[r] = (s2 <= l15) ? qk[r] * __expf(gt - GAM[16 * j + s2]) : 0.f; }
                *(LAS bf16x4*)(QKM + (size_t)(j * 64 + lane) * 8) = accfrag(qk);
            } }
        __syncthreads();
        if (w < 4) { const int vt = w; const int yrow0 = chain_row(b, dir, c * 64), ysg = dir == 0 ? 1 : -1;
#pragma unroll
            for (int j = 0; j < 4; ++j) {
                bf16x4 mb[4];
#pragma unroll
                for (int kt = 0; kt < 4; ++kt) mb[kt] = accfrag(Macc[kt]);
                f32x4 km = (f32x4){0.f, 0.f, 0.f, 0.f}, o = (f32x4){0.f, 0.f, 0.f, 0.f};
#pragma unroll
                for (int kt = 0; kt < 4; ++kt) km = MFMA16(ldfrag4(KS, 16 * j + l15, SX, 16 * kt + 4 * lq), mb[kt], km);
#pragma unroll
                for (int kt = 0; kt < 4; ++kt) o = MFMA16(ldfrag4(QG, 16 * j + l15, SX, 16 * kt + 4 * lq), mb[kt], o);
                f32x4 rv;
#pragma unroll
                for (int r = 0; r < 4; ++r) { const int s2 = 16 * j + 4 * lq + r; const float vv = bf2f(*(const LAS bf16_t*)(VS + (size_t)(s2 * SX + vt * 16 + l15) * 2));
                    rv[r] = BETA[s2] * (vv - EGAM[s2] * km[r]); }
                const f32x4 vn = MFMA16(*(const LAS bf16x4*)(TM + (size_t)(j * 64 + lane) * 8), accfrag(rv), ((f32x4){0.f, 0.f, 0.f, 0.f}));
                const bf16x4 vb = accfrag(vn);
                o = MFMA16(*(const LAS bf16x4*)(QKM + (size_t)(j * 64 + lane) * 8), vb, o);
#pragma unroll
                for (int r = 0; r < 4; ++r) Y[(size_t)(yrow0 + ysg * (16 * j + 4 * lq + r)) * D + 768 + hd * 64 + vt * 16 + l15] = f2bf(o[r]);
                const float dec = EGAM[16 * j + 15];
#pragma unroll
                for (int kt = 0; kt < 4; ++kt) Macc[kt] = MFMA16(ldfrag4(KE, j * 64 + kt * 16 + l15, SP, 4 * lq), vb, Macc[kt] * dec);
            } }
        __syncthreads();
    }
}
constexpr int CVT_GRAB = 6;
static_assert((64 * 192) % CVT_GRAB == 0, "tile split");
__device__ __forceinline__ void phase_scan(const P& p, int l, LAS unsigned char* lds) {
    const int tix = opaque_tid();
    for (int ch = blockIdx.x; ch < 256; ch += gridDim.x) {
        const int x = ch & 7, m = ch >> 3; int dir, hd16, b;
        if (m < 16) { const int gidx = x + 8 * (m >> 3), r8 = m & 7; b = gidx >> 1; hd16 = (gidx & 1) * 4 + (r8 >> 1); dir = r8 & 1; }
        else { const int idx = x * 8 + (m & 7); b = idx >> 3; hd16 = (m < 24 ? 8 : 12) + ((idx >> 1) & 3); dir = idx & 1; }
        if (hd16 < 8) scan_ssd_mma(p, l, b, hd16, dir, lds);
        else if (hd16 < 12) scan_hgrn_mma(p, l, b, hd16 - 8, dir, lds);
        else scan_gdn_mma(p, l, b, hd16 - 12, dir, lds);
        __syncthreads();
        unsigned* qhead = (unsigned*)(p.ws + OFF_CVTQ) + 64 * l;
        for (;;) {
            if (tix == 0) *(LAS int*)(lds + LDS_TAB) = (int)__hip_atomic_fetch_add(qhead, (unsigned)CVT_GRAB, __ATOMIC_RELAXED, __HIP_MEMORY_SCOPE_AGENT);
            __syncthreads();
            const int t0 = *(const LAS int*)(lds + LDS_TAB);
            __syncthreads();
            if (t0 >= 64 * 192) break;
            phase_expert_cvt(p, l, lds, t0, t0 + CVT_GRAB, 1);
        }
    }
}

__device__ __forceinline__ void phase_post(const P& p, int l, bool lat_only) {
    const int tix = opaque_tid();
    const bf16_t* U = (const bf16_t*)(p.ws + OFF_UB); bf16_t* Y1 = (bf16_t*)(p.ws + OFF_AB); const bf16_t* Y2 = (const bf16_t*)(p.ws + OFF_Y2);
    const int gw = blockIdx.x * 8 + (tix >> 6), lane = tix & 63;
    const int col = 16 * lane;
    const int gc = lane < 32 ? col : (lane < 48 ? C_HG + (col - 512) : C_GG + (col - 768));
    float nw[16];
#pragma unroll
    for (int j = 0; j < 16; ++j) nw[j] = lane < 32 ? p.ssd_norm[l * 512 + col + j] : (lane < 48 ? p.hgrn_norm[l * 64 + ((col + j) & 63)] : p.gdn_norm[l * 64 + ((col + j) & 63)]);
    u32x4 cur[6], nxt[6], nx2[6];
    auto valid = [&](int row) { return !(lat_only && (row % TPS) < CTXL); };
    auto load = [&](int row, u32x4 (&r)[6]) {
#pragma unroll
        for (int i = 0; i < 2; ++i) { r[i] = *(const u32x4*)(Y1 + (size_t)row * D + col + i * 8); r[2 + i] = *(const u32x4*)(Y2 + (size_t)row * D + col + i * 8); r[4 + i] = *(const u32x4*)(U + (size_t)row * UC + gc + i * 8); }
    };
    const int end = gw * 33 + 33;
    int row = gw * 33;
    while (row < end && !valid(row)) ++row;
    if (row < end) load(row, cur);
    int nrow = row + 1;
    while (nrow < end && !valid(nrow)) ++nrow;
    if (nrow < end) load(nrow, nxt);
    while (row < end) {
        int n2row = nrow + 1;
        while (n2row < end && !valid(n2row)) ++n2row;
        if (n2row < end) load(n2row, nx2);
        float y[16], gt[16];
#pragma unroll
        for (int i = 0; i < 2; ++i) { float a[8], c[8], g8[8];
            unpack8(cur[i], a); unpack8(cur[2 + i], c); unpack8(cur[4 + i], g8);
#pragma unroll
            for (int j = 0; j < 8; ++j) { y[i * 8 + j] = a[j] + c[j]; gt[i * 8 + j] = siluf_(g8[j]); } }
        if (lane < 32) {
#pragma unroll
            for (int j = 0; j < 16; ++j) y[j] *= gt[j]; }
        float ss = 0.f;
#pragma unroll
        for (int j = 0; j < 16; ++j) ss += y[j] * y[j];
        ss += __shfl_xor(ss, 1); ss += __shfl_xor(ss, 2);
        float s16 = ss; s16 += __shfl_xor(s16, 4); s16 += __shfl_xor(s16, 8);
        const float rstd = lane < 32 ? rsqrtf(s16 * (1.f / 256.f) + EPS) : rsqrtf(ss * (1.f / 64.f) + EPS);
#pragma unroll
        for (int i = 0; i < 2; ++i) { float f[8];
#pragma unroll
            for (int j = 0; j < 8; ++j) { const float t = y[i * 8 + j] * rstd * nw[i * 8 + j]; f[j] = lane < 32 ? t : t * gt[i * 8 + j]; }
            *(u32x4*)(Y1 + (size_t)row * D + col + i * 8) = pack8(f); }
#pragma unroll
        for (int i = 0; i < 6; ++i) { cur[i] = nxt[i]; nxt[i] = nx2[i]; }
        row = nrow; nrow = n2row;
    }
}

__device__ __forceinline__ void phase_topk(const P& p, int l, bool lat_only, LAS unsigned char* lds) {
    const int tix = opaque_tid();
    unsigned char* ws = p.ws;
    LAS int* hist = (LAS int*)lds;
    for (int i = tix; i < 256; i += NTHR) hist[i] = 0;
    __syncthreads();
    const int t = tix;
    if (t < 264) {
        const int row = blockIdx.x * 264 + t;
        const bool active = !(lat_only && (row % TPS) < CTXL);
        if (active) {
            const float* sp = (const float*)(ws + OFF_SC) + (size_t)row * 64;
            float sc[64], sel[64];
#pragma unroll
            for (int i = 0; i < 16; ++i) { const f32x4 v = *(const f32x4*)(sp + 4 * i); sc[4 * i] = v[0]; sc[4 * i + 1] = v[1]; sc[4 * i + 2] = v[2]; sc[4 * i + 3] = v[3]; }
#pragma unroll
            for (int e = 0; e < 64; ++e) sel[e] = sc[e] + p.router_bias[l * 64 + e];
            int idx[8]; float gv[8]; float gs = 0.f;
#pragma unroll
            for (int r = 0; r < 8; ++r) { float best = -3.0e38f, bs = 0.f; int bi = 0;
#pragma unroll
                for (int e = 0; e < 64; ++e) { const bool gt = sel[e] > best; best = gt ? sel[e] : best; bs = gt ? sc[e] : bs; bi = gt ? e : bi; }
#pragma unroll
                for (int e = 0; e < 64; ++e) sel[e] = (e == bi) ? -3.0e38f : sel[e];
                idx[r] = bi; gv[r] = bs; gs += bs; }
            const float inv = 2.5f / gs;
            int* te = (int*)(ws + OFF_TOKE) + (size_t)row * 8; float* tg = (float*)(ws + OFF_TOKG) + (size_t)row * 8; int* tl = (int*)(ws + OFF_TOKLR) + (size_t)row * 12;
#pragma unroll
            for (int r = 0; r < 8; ++r) { const int s = idx[r]; const int lr = atomicAdd((int*)&hist[s], 1); te[r] = idx[r]; tg[r] = gv[r] * inv; tl[r] = lr; }
            tl[8] = atomicAdd((int*)&hist[64], 1);
        }
    }
    __syncthreads();
    for (int i = tix; i < 256; i += NTHR) ((int*)(ws + OFF_BCNT))[blockIdx.x * 256 + i] = (i < NSEG) ? hist[i] : 0;
}
__device__ __forceinline__ void phase_lists(const P& p, int l, bool lat_only, LAS unsigned char* lds) {
    const int tix = opaque_tid();
    unsigned char* ws = p.ws;
    LAS int* tot = (LAS int*)lds; LAS int* base = tot + 256; LAS int* segp = base + 256;
    const int* bc = (const int*)(ws + OFF_BCNT);
    const int t = tix;
    { LAS int* pa = (LAS int*)lds + 1024; LAS int* pb = pa + 512;
        const int sg = t & 127, part = t >> 7; int a = 0, bs = 0;
        if (sg < NSEG) {
#pragma unroll 16
            for (int k = 0; k < GRID / 4; ++k) { const int bb = part * (GRID / 4) + k; const int v = bc[bb * 256 + sg]; a += v; bs += bb < (int)blockIdx.x ? v : 0; } }
        pa[t] = a; pb[t] = bs;
        __syncthreads();
        if (t < 256) { const bool in = t < NSEG; tot[t] = in ? pa[t] + pa[128 + t] + pa[256 + t] + pa[384 + t] : 0; base[t] = in ? pb[t] + pb[128 + t] + pb[256 + t] + pb[384 + t] : 0; } }
    __syncthreads();
    if (t == 0) { int acc = 0; for (int s = 0; s < NSEG; ++s) { segp[s] = acc; acc += (tot[s] + 255) >> 8; } segp[NSEG] = acc; }
    __syncthreads();
    int* rinfo = (int*)(ws + OFF_RINFO); float* rgate = (float*)(ws + OFF_RGATE);
    if (t < 264) {
        const int row = blockIdx.x * 264 + t;
        const bool active = !(lat_only && (row % TPS) < CTXL);
        if (active) {
            const int* te = (const int*)(ws + OFF_TOKE) + (size_t)row * 8; const float* tg = (const float*)(ws + OFF_TOKG) + (size_t)row * 8; const int* tl = (const int*)(ws + OFF_TOKLR) + (size_t)row * 12;
#pragma unroll
            for (int r = 0; r < 8; ++r) { const int s = te[r]; const int slot = 256 * segp[s] + base[s] + tl[r]; rinfo[slot] = row * 16 + r; rgate[slot] = tg[r]; }
            const int slot = 256 * segp[64] + base[64] + tl[8]; rinfo[slot] = row * 16 + 8; rgate[slot] = 1.f;
        }
    }
    for (int s = blockIdx.x; s < NSEG; s += gridDim.x) { const int n = tot[s], e = ((n + 255) >> 8) << 8; for (int r = n + t; r < e; r += NTHR) { rinfo[256 * segp[s] + r] = -1; rgate[256 * segp[s] + r] = 0.f; } }
    if (blockIdx.x == 0 && t <= NSEG) ((int*)(ws + OFF_SEGP))[t] = segp[t];
}
__device__ __forceinline__ const LAS int* load_segp(const P& p, LAS unsigned char* lds, bool build) {
    const int tix = opaque_tid();
    LAS int* segp = (LAS int*)(lds + LDS_TAB);
    __syncthreads();
    if (tix <= NSEG) segp[tix] = ((const int*)(p.ws + OFF_SEGP))[tix];
    __syncthreads();
    if (build) { LAS unsigned char* segt = lds + LDS_SEGT; const int np = segp[NSEG];
        for (int pp = tix; pp < np; pp += NTHR) { int lo = 0, hi = NSEG; while (hi - lo > 1) { const int mid = (lo + hi) >> 1; if (segp[mid] <= pp) lo = mid; else hi = mid; } segt[pp] = (unsigned char)lo; } }
    __syncthreads();
    return segp;
}

enum { PH_PRO = 0, PH_NORM1, PH_WIN, PH_PREP, PH_SCAN, PH_POST, PH_WOUT, PH_NORM2, PH_ROUTER, PH_TOPK, PH_LISTS, PH_MOE, PH_FINAL };

__device__ __forceinline__ P launder_params(const P& p0) {
    P p;
    p.x = launder_ptr(p0.x); p.c = launder_ptr(p0.c); p.ctx = launder_ptr(p0.ctx); p.c_ctx = launder_ptr(p0.c_ctx); p.w_mod = launder_ptr(p0.w_mod); p.b_mod = launder_ptr(p0.b_mod);
    p.norm_mix = launder_ptr(p0.norm_mix); p.w_in = launder_ptr(p0.w_in); p.ssd_conv_w = launder_ptr(p0.ssd_conv_w); p.ssd_conv_b = launder_ptr(p0.ssd_conv_b);
    p.ssd_dt_bias = launder_ptr(p0.ssd_dt_bias); p.ssd_a_log = launder_ptr(p0.ssd_a_log); p.ssd_d = launder_ptr(p0.ssd_d); p.ssd_norm = launder_ptr(p0.ssd_norm);
    p.hgrn_lb = launder_ptr(p0.hgrn_lb); p.hgrn_norm = launder_ptr(p0.hgrn_norm); p.gdn_conv_w = launder_ptr(p0.gdn_conv_w); p.gdn_dt_bias = launder_ptr(p0.gdn_dt_bias);
    p.gdn_a_log = launder_ptr(p0.gdn_a_log); p.gdn_norm = launder_ptr(p0.gdn_norm); p.w_out = launder_ptr(p0.w_out); p.norm_ffn = launder_ptr(p0.norm_ffn);
    p.router_w = launder_ptr(p0.router_w); p.router_bias = launder_ptr(p0.router_bias); p.exp_gate = launder_ptr(p0.exp_gate); p.exp_up = launder_ptr(p0.exp_up);
    p.exp_down = launder_ptr(p0.exp_down); p.sh_gate = launder_ptr(p0.sh_gate); p.sh_up = launder_ptr(p0.sh_up); p.sh_down = launder_ptr(p0.sh_down);
    p.norm_final = launder_ptr(p0.norm_final); p.out = launder_ptr(p0.out); p.ws = launder_ptr(p0.ws);
    return p;
}
template <int PH>
__device__ __forceinline__ void run_phase(const P& p0, const int l0, LAS unsigned char* lds, const int step = 0) {
    const P p = launder_params(p0);
    int l = l0; asm volatile("" : "+s"(l));
    unsigned char* ws = p.ws;
    const float* mod = (const float*)(ws + OFF_MOD) + (size_t)l * 9 * 6144;
    const bool lat_only = (l == 1);
    if constexpr (PH == PH_PRO) phase_prologue(p, lds);
    if constexpr (PH == PH_NORM1) { if (l == 0) { phase_norm<0, false>(p, l, p.norm_mix + l * D, 1024, 0, false); phase_transposes(p, lds); } else phase_norm<2, false>(p, l, p.norm_mix + l * D, 1024, 0, false); }
    if constexpr (PH == PH_WIN) { SchedDense S{(const bf16_t*)(ws + OFF_WINT + (size_t)l * NWIN * D), D, NWIN / 256, NPAN * (NWIN / 256), (int)gridDim.x, (int)blockIdx.x, 0, 1};
        EpiU E{(bf16_t*)(ws + OFF_UB), p.hgrn_lb, (const float*)(ws + OFF_SCL) + SCL_RA, (const float*)(ws + OFF_SCL) + SCL_WIN + l * 4096, l, lds}; pg8::gemm_phase<EpiU, SchedDense, 2>(lds, ws + OFF_AB, D, S, E); }
    if constexpr (PH == PH_PREP) phase_prep(p, l);
    if constexpr (PH == PH_SCAN) phase_scan(p, l, lds);
    if constexpr (PH == PH_POST) phase_post(p, l, lat_only);
    if constexpr (PH == PH_WOUT) { SchedDense S{(const bf16_t*)(ws + OFF_WOUTT) + (size_t)l * D * D, D, 4, (lat_only ? 256 : NPAN) * 4, (int)gridDim.x, (int)blockIdx.x, lat_only ? 1 : 0, 2};
        EpiRes E{p.x, p.ctx, (bf16_t*)(ws + OFF_HB), mod, l}; pg8::gemm_phase(lds, (const bf16_t*)(ws + OFF_AB), D, S, E);
        }
    if constexpr (PH == PH_NORM2) phase_norm<1, false>(p, l, p.norm_ffn + l * D, 4096, 3072, lat_only);
    if constexpr (PH == PH_ROUTER) { SchedDense S{(const bf16_t*)(ws + OFF_RT) + (size_t)l * 256 * D, D, 1, (lat_only ? 256 : NPAN), (int)gridDim.x, (int)blockIdx.x, lat_only ? 1 : 0, 2};
        EpiRouter E{(float*)(ws + OFF_SC)}; pg8::gemm_phase(lds, (const bf16_t*)(ws + OFF_AB), D, S, E); }
    if constexpr (PH == PH_TOPK) phase_topk(p, l, lat_only, lds);
    if constexpr (PH == PH_LISTS) phase_lists(p, l, lat_only, lds);
    if constexpr (PH == PH_MOE) {
        const LAS int* segp = load_segp(p, lds, step == 0 || !MK_ONE_LAUNCH);
        const int G = (int)gridDim.x, bid = (int)blockIdx.x;
        if (step > 0) {
            SchedS2 S{segp, (const bf16_t*)(ws + OFF_W2T), (const bf16_t*)(ws + OFF_SH2T + (size_t)l * D * 256), 0, 4 * segp[NSEG], G, bid, 4 * segp[NSEG - 1]};
            EpiMoE E{(const int*)(ws + OFF_RINFO), mod, ws, lds + LDS_XS};
            pg8::gemm_phase<EpiMoE, SchedS2, 1>(lds, ws + OFF_HACT, 256, S, E); }
        else { SchedS1 S{segp, (const int*)(ws + OFF_RINFO), (const bf16_t*)(ws + OFF_W1T), (const bf16_t*)(ws + OFF_SH1T + (size_t)l * 512 * D), 0, 2 * segp[NSEG], G, bid};
            EpiGLU E{(bf16_t*)(ws + OFF_HACT), (const float*)(ws + OFF_RGATE), (const int*)(ws + OFF_RINFO), lds}; pg8::gemm_phase<EpiGLU, SchedS1, 1>(lds, ws + OFF_F8, D, S, E); }
    }
    if constexpr (PH == PH_FINAL) phase_norm<2, true>(p, l, p.norm_final, 0, 0, true);
}

template <int PH>
__global__ void __launch_bounds__(NTHR, 2) k_phase(P p, int l, int step) {
    extern __shared__ __attribute__((aligned(16))) unsigned char smem[];
    run_phase<PH>(p, l, (LAS unsigned char*)smem, step);
}

#if MK_ONE_LAUNCH
__global__ void __launch_bounds__(NTHR, 2) k_mega(P p) {
    extern __shared__ __attribute__((aligned(16))) unsigned char smem[];
    LAS unsigned char* lds = (LAS unsigned char*)smem;
    if (threadIdx.x < 4) ((LAS unsigned*)(lds + LDS_BARW))[threadIdx.x] = 0u;
    __syncthreads();
    XcdBarrier bar = xcd_barrier_post((unsigned*)(p.ws + OFF_BAR), (volatile LAS unsigned*)(lds + LDS_BARW));
    run_phase<PH_PRO>(p, 0, lds); xcd_barrier(bar);
    for (int l = 0; l < 2; ++l) {
        run_phase<PH_NORM1>(p, l, lds); xcd_barrier(bar);
        run_phase<PH_WIN>(p, l, lds); xcd_barrier(bar);
        run_phase<PH_PREP>(p, l, lds); xcd_barrier(bar);
        run_phase<PH_SCAN>(p, l, lds); xcd_barrier(bar);
        run_phase<PH_POST>(p, l, lds); xcd_barrier(bar);
        run_phase<PH_WOUT>(p, l, lds); xcd_barrier(bar);
        run_phase<PH_NORM2>(p, l, lds); xcd_barrier(bar);
        run_phase<PH_ROUTER>(p, l, lds); xcd_barrier(bar);
        run_phase<PH_TOPK>(p, l, lds); xcd_barrier(bar);
        run_phase<PH_LISTS>(p, l, lds); xcd_barrier(bar);
        for (int st = 0; st < 2; ++st) { run_phase<PH_MOE>(p, l, lds, st); xcd_barrier(bar); }
    }
    run_phase<PH_FINAL>(p, 1, lds);
}
#endif

template <int PH> static void launch_phase(const P& p, int l, hipStream_t stream, int step = 0) {
    static bool attr = false;
    if (!attr) { (void)hipFuncSetAttribute((const void*)k_phase<PH>, hipFuncAttributeMaxDynamicSharedMemorySize, LDS_BYTES); attr = true; }
    hipLaunchKernelGGL(k_phase<PH>, dim3(GRID), dim3(NTHR), LDS_BYTES, stream, p, l, step);
}

extern "C" void kernel_launch(void* const* d_in, const int* in_sizes, int n_in, void* d_out, int out_size, void* d_ws, size_t ws_size, hipStream_t stream) {
    if (n_in != 31 || ws_size < WS_END || out_size != NBATCH * SEQ * D) { fprintf(stderr, "kernel_launch: unexpected shapes: n_in %d ws %zu (need %zu) out %d\n", n_in, ws_size, (size_t)WS_END, out_size); return; }
    P p{};
    const float** f = (const float**)&p;
    for (int i = 0; i < 31; ++i) f[i] = (const float*)d_in[i];
    p.out = (float*)d_out; p.ws = (unsigned char*)d_ws;
#if MK_ONE_LAUNCH
    static bool attr = false;
    if (!attr) { (void)hipFuncSetAttribute((const void*)k_mega, hipFuncAttributeMaxDynamicSharedMemorySize, LDS_BYTES); attr = true; }
    (void)hipMemsetAsync(d_ws, 0, 16384, stream);
    hipLaunchKernelGGL(k_mega, dim3(GRID), dim3(NTHR), LDS_BYTES, stream, p);
#else
    launch_phase<PH_PRO>(p, 0, stream);
    for (int l = 0; l < 2; ++l) {
        launch_phase<PH_NORM1>(p, l, stream); launch_phase<PH_WIN>(p, l, stream); launch_phase<PH_PREP>(p, l, stream); launch_phase<PH_SCAN>(p, l, stream);
        launch_phase<PH_POST>(p, l, stream); launch_phase<PH_WOUT>(p, l, stream); launch_phase<PH_NORM2>(p, l, stream); launch_phase<PH_ROUTER>(p, l, stream);
        launch_phase<PH_TOPK>(p, l, stream); launch_phase<PH_LISTS>(p, l, stream);
        for (int st = 0; st < 2; ++st) launch_phase<PH_MOE>(p, l, stream, st);
    }
    launch_phase<PH_FINAL>(p, 1, stream);
#endif
}
```
